# Optimizing an MI355X kernel written in HIP

```python
import math
import jax, jax.numpy as jnp
from jax import lax
import numpy as np

D_MODEL = 1024
BATCH = 2
SEQ = 8192
DEPTH = 1

HEAD_DIM = 64
DIL_GROUPS = ((128, 1), (512, 4), (2048, 16))
HEADS_PER_GROUP = 4
N_HEADS_A = HEADS_PER_GROUP * len(DIL_GROUPS)
MAX_WINDOW = 2048
N_HEADS_B = 8
QBLOCK = 128
REL_BUCKETS = 32
REL_MAX_DIST = 2048
N_EXPERTS = 64
TOP_K = 8
D_EXPERT = 256
D_SHARED = 256
ROUTE_SCALE = 2.5
TOKEN_BLOCK = 128
EPS = 1e-6

WIDTH_A = 3 * N_HEADS_A * HEAD_DIM
WIDTH_B = 3 * N_HEADS_B * HEAD_DIM
D_IN = WIDTH_A + WIDTH_B + N_HEADS_B
OUT_A = HEADS_PER_GROUP * HEAD_DIM
OUT_B = N_HEADS_B * HEAD_DIM

kernel_name = "hybrid_dilated_fox_moe_block"


def rmsnorm(x, g):
    xf = x.astype(jnp.float32)
    y = xf * lax.rsqrt(jnp.mean(xf * xf, axis=-1, keepdims=True) + EPS)
    return (y * g.astype(jnp.float32)).astype(x.dtype)


def rel_bucket(dist):
    max_exact = REL_BUCKETS // 2
    n = jnp.maximum(dist.astype(jnp.float32), 1.0)
    large = max_exact + (jnp.log(n / max_exact) / math.log(REL_MAX_DIST / max_exact)
                         * (REL_BUCKETS - max_exact)).astype(jnp.int32)
    large = jnp.minimum(large, REL_BUCKETS - 1)
    return jnp.where(dist < max_exact, dist, large)


def swiglu(x, w_g, w_u, w_d):
    return (jax.nn.silu(x @ w_g) * (x @ w_u)) @ w_d


def dilated_attention(q, k, v, rel_bias):
    b, _, s, dh = q.shape
    pad = ((0, 0), (0, 0), (MAX_WINDOW, 0), (0, 0))
    k_pad = jnp.pad(k, pad)
    v_pad = jnp.pad(v, pad)
    groups = []
    for g, (w, d) in enumerate(DIL_GROUPS):
        hs = slice(g * HEADS_PER_GROUP, (g + 1) * HEADS_PER_GROUP)
        offs = d * jnp.arange(w // d + 1, dtype=jnp.int32)
        bias = rel_bias[rel_bucket(offs)][:, hs].T.astype(jnp.float32)
        groups.append((q[:, hs], k_pad[:, hs], v_pad[:, hs], offs, bias))

    def block(n):
        t = n * QBLOCK + jnp.arange(QBLOCK, dtype=jnp.int32)
        outs, lses = [], []
        for qg, kg_all, vg_all, offs, bias in groups:
            q_blk = lax.dynamic_slice_in_dim(qg, n * QBLOCK, QBLOCK, axis=2)
            pos = t[:, None] - offs[None, :]
            idx = pos + MAX_WINDOW
            kg = kg_all[:, :, idx]
            vg = vg_all[:, :, idx]
            sc = jnp.einsum('bhqd,bhqjd->bhqj', q_blk, kg).astype(jnp.float32)
            sc = sc + bias[None, :, None, :]
            sc = jnp.where((pos >= 0)[None, None], sc, -jnp.inf)
            lse = jax.nn.logsumexp(sc, axis=-1)
            p = jnp.exp(sc - lse[..., None])
            outs.append(jnp.einsum('bhqj,bhqjd->bhqd', p.astype(vg.dtype), vg))
            lses.append(lse)
        wgt = jax.nn.softmax(jnp.stack(lses, 0), axis=0)
        o = jnp.sum(jnp.stack(outs, 0).astype(jnp.float32) * wgt[..., None], axis=0)
        return o.astype(q.dtype)

    o = lax.map(block, jnp.arange(s // QBLOCK))
    return o.transpose(1, 0, 3, 2, 4).reshape(b, s, OUT_A)


def forgetting_attention(q, k, v, cum_logf):
    b, _, s, dh = q.shape
    kpos = jnp.arange(s, dtype=jnp.int32)

    def block(n):
        t = n * QBLOCK + jnp.arange(QBLOCK, dtype=jnp.int32)
        q_blk = lax.dynamic_slice_in_dim(q, n * QBLOCK, QBLOCK, axis=2)
        c_q = lax.dynamic_slice_in_dim(cum_logf, n * QBLOCK, QBLOCK, axis=2)
        sc = jnp.einsum('bhqd,bhkd->bhqk', q_blk, k).astype(jnp.float32)
        sc = sc + c_q[..., None] - cum_logf[:, :, None, :]
        sc = jnp.where((t[:, None] >= kpos[None, :])[None, None], sc, -jnp.inf)
        p = jax.nn.softmax(sc, axis=-1)
        return jnp.einsum('bhqk,bhkd->bhqd', p.astype(v.dtype), v)

    o = lax.map(block, jnp.arange(s // QBLOCK))
    return o.transpose(1, 0, 3, 2, 4).reshape(b, s, OUT_B)


def moe_ffn(h, w_router, router_bias, w_gate_e, w_up_e, w_down_e, w_gate_s, w_up_s, w_down_s):
    n, d = h.shape
    scores = jax.nn.sigmoid(h.astype(jnp.float32) @ w_router.astype(jnp.float32))
    _, top_idx = lax.top_k(scores + router_bias.astype(jnp.float32), TOP_K)
    top_s = jnp.take_along_axis(scores, top_idx, axis=-1)
    top_w = top_s / jnp.sum(top_s, axis=-1, keepdims=True) * ROUTE_SCALE
    gates = jnp.sum(jax.nn.one_hot(top_idx, N_EXPERTS, dtype=jnp.float32) * top_w[..., None], axis=1)
    gates = gates.astype(h.dtype)

    def block(args):
        xb, gb = args
        hg = jnp.einsum('td,edf->tef', xb, w_gate_e)
        hu = jnp.einsum('td,edf->tef', xb, w_up_e)
        hmid = jax.nn.silu(hg) * hu * gb[..., None]
        return jnp.einsum('tef,efd->td', hmid, w_down_e)

    nb = n // TOKEN_BLOCK
    routed = lax.map(block, (h.reshape(nb, TOKEN_BLOCK, d), gates.reshape(nb, TOKEN_BLOCK, N_EXPERTS)))
    return routed.reshape(n, d) + swiglu(h, w_gate_s, w_up_s, w_down_s)


def setup_inputs(seed: int = 0) -> dict:
    key = jax.random.key(seed)
    ks = jax.random.split(key, 24)
    nrm = lambda k, shape, scale: jax.random.normal(k, shape, jnp.float32) * scale
    D = D_MODEL
    return {
        "x": nrm(ks[0], (BATCH, SEQ, D), 1.0),
        "g_mix": 1.0 + nrm(ks[1], (D,), 0.02),
        "w_in": nrm(ks[2], (D, D_IN), D ** -0.5),
        "q_norm_a": 1.0 + nrm(ks[3], (HEAD_DIM,), 0.02),
        "k_norm_a": 1.0 + nrm(ks[4], (HEAD_DIM,), 0.02),
        "q_norm_b": 1.0 + nrm(ks[5], (HEAD_DIM,), 0.02),
        "k_norm_b": 1.0 + nrm(ks[6], (HEAD_DIM,), 0.02),
        "rel_bias": nrm(ks[7], (REL_BUCKETS, N_HEADS_A), 0.5),
        "b_forget": 3.0 + nrm(ks[8], (N_HEADS_B,), 0.5),
        "w_gate": nrm(ks[9], (D, 2 * D), D ** -0.5),
        "b_gate": nrm(ks[10], (2 * D,), 0.02),
        "w_proj_a": nrm(ks[11], (OUT_A, D), OUT_A ** -0.5),
        "w_proj_b": nrm(ks[12], (OUT_B, D), OUT_B ** -0.5),
        "w_out": nrm(ks[13], (D, D), D ** -0.5),
        "g_ffn": 1.0 + nrm(ks[14], (D,), 0.02),
        "w_router": nrm(ks[15], (D, N_EXPERTS), D ** -0.5),
        "router_bias": nrm(ks[16], (N_EXPERTS,), 0.01),
        "w_gate_e": nrm(ks[17], (N_EXPERTS, D, D_EXPERT), D ** -0.5),
        "w_up_e": nrm(ks[18], (N_EXPERTS, D, D_EXPERT), D ** -0.5),
        "w_down_e": nrm(ks[19], (N_EXPERTS, D_EXPERT, D), D_EXPERT ** -0.5),
        "w_gate_s": nrm(ks[20], (D, D_SHARED), D ** -0.5),
        "w_up_s": nrm(ks[21], (D, D_SHARED), D ** -0.5),
        "w_down_s": nrm(ks[22], (D_SHARED, D), D_SHARED ** -0.5),
    }


def reference(x, g_mix, w_in, q_norm_a, k_norm_a, q_norm_b, k_norm_b, rel_bias, b_forget,
              w_gate, b_gate, w_proj_a, w_proj_b, w_out, g_ffn, w_router, router_bias,
              w_gate_e, w_up_e, w_down_e, w_gate_s, w_up_s, w_down_s):
    b, s, d = x.shape
    scale = HEAD_DIM ** -0.5
    for _ in range(DEPTH):
        h = rmsnorm(x, g_mix)
        proj = h @ w_in
        pa = proj[..., :WIDTH_A].reshape(b, s, 3, N_HEADS_A, HEAD_DIM)
        pb = proj[..., WIDTH_A:WIDTH_A + WIDTH_B].reshape(b, s, 3, N_HEADS_B, HEAD_DIM)
        f_logit = proj[..., WIDTH_A + WIDTH_B:]

        qa = (rmsnorm(pa[:, :, 0], q_norm_a) * scale).transpose(0, 2, 1, 3)
        ka = rmsnorm(pa[:, :, 1], k_norm_a).transpose(0, 2, 1, 3)
        va = pa[:, :, 2].transpose(0, 2, 1, 3)
        y_a = dilated_attention(qa, ka, va, rel_bias)

        qb = (rmsnorm(pb[:, :, 0], q_norm_b) * scale).transpose(0, 2, 1, 3)
        kb = rmsnorm(pb[:, :, 1], k_norm_b).transpose(0, 2, 1, 3)
        vb = pb[:, :, 2].transpose(0, 2, 1, 3)
        log_f = jax.nn.log_sigmoid(f_logit.astype(jnp.float32) + b_forget.astype(jnp.float32))
        cum_logf = jnp.cumsum(log_f, axis=1).transpose(0, 2, 1)
        y_b = forgetting_attention(qb, kb, vb, cum_logf)

        gates = jax.nn.sigmoid(h @ w_gate + b_gate)
        merged = gates[..., :d] * (y_a @ w_proj_a) + gates[..., d:] * (y_b @ w_proj_b)
        x = x + merged @ w_out

        h2 = rmsnorm(x, g_ffn).reshape(b * s, d)
        ffn = moe_ffn(h2, w_router, router_bias, w_gate_e, w_up_e, w_down_e,
                      w_gate_s, w_up_s, w_down_s)
        x = x + ffn.reshape(b, s, d)
    return x
```

```cpp
#include <hip/hip_runtime.h>
#include <cstdint>
#include <cstdio>

typedef unsigned short bf16_t;
typedef unsigned u32x4 __attribute__((ext_vector_type(4)));
typedef unsigned u32x2 __attribute__((ext_vector_type(2)));

constexpr int BATCH = 2, SEQ = 8192, M = BATCH * SEQ, D = 1024;
constexpr int HA = 12, HB = 8, HD = 64;
constexpr int WA = 3 * HA * HD, WB = 3 * HB * HD, DIN = WA + WB + HB;
constexpr int PA = HA * HD, PB = HB * HD;
constexpr int OUTA = 256, OUTB = 512;
constexpr int NE = 64, TOPK = 8, DE = 256;
constexpr int NLIST = 2 * NE;
constexpr float EPS = 1e-6f;
constexpr float LOG2E = 1.4426950408889634f;
constexpr float QSCALE = 0.125f * LOG2E;

constexpr size_t MiB = 1u << 20, KiB = 1u << 10;
constexpr size_t WS_CTL = 0;
constexpr size_t WS_LOGF = 1 * MiB;
constexpr size_t WS_C = 1 * MiB + 512 * KiB;
constexpr size_t WS_KAUG = 2 * MiB;
constexpr size_t WS_LIST = 4 * MiB;
constexpr size_t WS_GATEW = 12 * MiB;
constexpr size_t WS_BIAS = 12 * MiB + 512 * KiB;
constexpr size_t WS_W2 = 13 * MiB;
constexpr size_t WS_R1 = 45 * MiB + 512 * KiB;
constexpr size_t WS_W1 = WS_R1;
constexpr size_t WS_WIN = WS_R1 + 65 * MiB;
constexpr size_t WS_XN = WS_R1 + 80 * MiB;
constexpr size_t WS_YA = WS_XN;
constexpr size_t WS_YB = WS_XN + 8 * MiB;
constexpr size_t WS_H2 = WS_XN;
constexpr size_t WS_QB = WS_R1 + 112 * MiB;
constexpr size_t WS_R2 = WS_R1 + 128 * MiB;
constexpr size_t WS_QA = WS_R2;
constexpr size_t WS_KA = WS_R2 + 24 * MiB;
constexpr size_t WS_VA = WS_R2 + 48 * MiB;
constexpr size_t WS_KB = WS_R2 + 72 * MiB;
constexpr size_t WS_VB = WS_R2 + 88 * MiB;
constexpr size_t WS_MERGED = WS_R2;
constexpr size_t WS_H = WS_R2;
constexpr size_t WS_HS = WS_R2 + 64 * MiB;
constexpr size_t WS_END = WS_R2 + 104 * MiB;
constexpr int CW_CNT = 1024;

__device__ __forceinline__ float bf2f(bf16_t v) { return __uint_as_float((unsigned)v << 16); }
__device__ __forceinline__ unsigned f2bf(float f) { unsigned u = __float_as_uint(f); return (u + 0x7fffu + ((u >> 16) & 1u)) >> 16; }
__device__ __forceinline__ unsigned pk2(float lo, float hi) { return f2bf(lo) | (f2bf(hi) << 16); }
__device__ __forceinline__ float wave_sum(float v) {
#pragma unroll
    for (int o = 1; o < 64; o <<= 1) v += __shfl_xor(v, o);
    return v;
}
__device__ __forceinline__ float wave_max(float v) {
#pragma unroll
    for (int o = 1; o < 64; o <<= 1) v = fmaxf(v, __shfl_xor(v, o));
    return v;
}

__global__ void __launch_bounds__(256) k_rms_logf(const float* __restrict__ x, const float* __restrict__ g, const float* __restrict__ w_in, const float* __restrict__ b_forget,
                                                  bf16_t* __restrict__ XN, float* __restrict__ LOGF) {
    const int wave = threadIdx.x >> 6, lane = threadIdx.x & 63; const int m = blockIdx.x * 4 + wave;
    const float4* xr = (const float4*)(x + (size_t)m * D);
    float4 v[4]; float ss = 0.f;
#pragma unroll
    for (int j = 0; j < 4; ++j) { v[j] = xr[lane + 64 * j]; ss += v[j].x * v[j].x + v[j].y * v[j].y + v[j].z * v[j].z + v[j].w * v[j].w; }
    ss = wave_sum(ss);
    const float rinv = rsqrtf(ss * (1.f / D) + EPS);
    float f[8];
#pragma unroll
    for (int c = 0; c < 8; ++c) f[c] = 0.f;
#pragma unroll
    for (int j = 0; j < 4; ++j) {
        const float4 gg = ((const float4*)g)[lane + 64 * j];
        float y[4] = {v[j].x * rinv * gg.x, v[j].y * rinv * gg.y, v[j].z * rinv * gg.z, v[j].w * rinv * gg.w};
        u32x2 o; o.x = pk2(y[0], y[1]); o.y = pk2(y[2], y[3]);
        *(u32x2*)(XN + (size_t)m * D + 4 * (lane + 64 * j)) = o;
#pragma unroll
        for (int e = 0; e < 4; ++e) {
            const int i = 4 * (lane + 64 * j) + e;
            const float4 w0 = *(const float4*)(w_in + (size_t)i * DIN + (WA + WB));
            const float4 w1 = *(const float4*)(w_in + (size_t)i * DIN + (WA + WB) + 4);
            f[0] += y[e] * w0.x; f[1] += y[e] * w0.y; f[2] += y[e] * w0.z; f[3] += y[e] * w0.w;
            f[4] += y[e] * w1.x; f[5] += y[e] * w1.y; f[6] += y[e] * w1.z; f[7] += y[e] * w1.w;
        }
    }
#pragma unroll
    for (int c = 0; c < 8; ++c) f[c] = wave_sum(f[c]);
    float mine = f[0];
#pragma unroll
    for (int c = 1; c < 8; ++c) mine = (lane == c) ? f[c] : mine;
    if (lane < 8) {
        const float z = mine + b_forget[lane];
        LOGF[(size_t)m * 8 + lane] = fminf(z, 0.f) - log1pf(expf(-fabsf(z)));
    }
}

__global__ void __launch_bounds__(1024) k_cumsum(const float* __restrict__ LOGF, float* __restrict__ C, bf16_t* __restrict__ KAUG) {
    __shared__ float sc[1024];
    const int bh = blockIdx.x, b = bh >> 3, h = bh & 7, i = threadIdx.x;
    float loc[8]; float run = 0.f;
#pragma unroll
    for (int e = 0; e < 8; ++e) { run += LOGF[((size_t)b * SEQ + 8 * i + e) * 8 + h]; loc[e] = run; }
    sc[i] = run; __syncthreads();
    for (int o = 1; o < 1024; o <<= 1) { float t = (i >= o) ? sc[i - o] : 0.f; __syncthreads(); sc[i] += t; __syncthreads(); }
    const float base = sc[i] - run;
#pragma unroll
    for (int e = 0; e < 8; ++e) {
        const float c = base + loc[e]; const int t = 8 * i + e;
        C[(size_t)bh * SEQ + t] = c;
        const float vv = -c * LOG2E;
        const unsigned p0 = f2bf(vv); const float r1 = vv - __uint_as_float(p0 << 16);
        const unsigned p1 = f2bf(r1); const float r2 = r1 - __uint_as_float(p1 << 16);
        const unsigned p2 = f2bf(r2);
        u32x4 o; o.x = p0 | (p1 << 16); o.y = p2; o.z = 0u; o.w = 0u;
        *(u32x4*)(KAUG + (((size_t)b * SEQ + t) * 8 + h) * 8) = o;
    }
}

__global__ void k_bias_table(const float* __restrict__ rel_bias, float* __restrict__ BIAS) {
    const int i = blockIdx.x * blockDim.x + threadIdx.x; if (i >= HA * 129) return;
    const int head = i / 129, j = i % 129, g = head >> 2; const int d = (g == 0) ? 1 : (g == 1 ? 4 : 16);
    const int dist = d * j; int bucket;
    if (dist < 16) bucket = dist;
    else { const double n = (double)dist; int large = 16 + (int)(log(n / 16.0) / log(128.0) * 16.0); bucket = large < 31 ? large : 31; }
    BIAS[head * 129 + j] = rel_bias[bucket * HA + head] * LOG2E;
}

__device__ __forceinline__ void sg_accum(float (&acc)[4][4], const bf16_t* arow, int K, const float* w, int ldw, float* As, float* Ws) {
    const int tid = threadIdx.x, r = tid >> 2, kq = tid & 3, kk = tid >> 4, c4 = tid & 15, ty = tid >> 4, tx = tid & 15;
    for (int k0 = 0; k0 < K; k0 += 16) {
        const u32x2 av = *(const u32x2*)(arow + k0);
        const float4 wv = *(const float4*)(w + (size_t)(k0 + kk) * ldw + c4 * 4);
        As[(kq * 4 + 0) * 68 + r] = __uint_as_float(av.x << 16); As[(kq * 4 + 1) * 68 + r] = __uint_as_float(av.x & 0xffff0000u);
        As[(kq * 4 + 2) * 68 + r] = __uint_as_float(av.y << 16); As[(kq * 4 + 3) * 68 + r] = __uint_as_float(av.y & 0xffff0000u);
        *(float4*)(Ws + kk * 64 + c4 * 4) = wv;
        __syncthreads();
#pragma unroll
        for (int k = 0; k < 16; ++k) {
            const float4 a = *(const float4*)(As + k * 68 + ty * 4); const float4 b = *(const float4*)(Ws + k * 64 + tx * 4);
            const float aa[4] = {a.x, a.y, a.z, a.w}, bb[4] = {b.x, b.y, b.z, b.w};
#pragma unroll
            for (int i = 0; i < 4; ++i)
#pragma unroll
                for (int j = 0; j < 4; ++j) acc[i][j] += aa[i] * bb[j];
        }
        __syncthreads();
    }
}
#define SG_ZERO(acc) _Pragma("unroll") for (int i_ = 0; i_ < 4; ++i_) _Pragma("unroll") for (int j_ = 0; j_ < 4; ++j_) acc[i_][j_] = 0.f
#define SG_SMEM __shared__ __attribute__((aligned(16))) float As[16 * 68]; __shared__ __attribute__((aligned(16))) float Ws[16 * 64]

__global__ void __launch_bounds__(256) k_sg_qkv(const bf16_t* __restrict__ XN, const float* __restrict__ w_in, const float* __restrict__ qna, const float* __restrict__ kna, const float* __restrict__ qnb,
                                                const float* __restrict__ knb, unsigned char* __restrict__ ws) {
    SG_SMEM; __shared__ float Ct[64 * 65];
    const int ct = blockIdx.x, rt = blockIdx.y, tid = threadIdx.x, ty = tid >> 4, tx = tid & 15;
    float acc[4][4]; SG_ZERO(acc);
    sg_accum(acc, XN + (size_t)(rt * 64 + (tid >> 2)) * D + (tid & 3) * 4, D, w_in + ct * 64, DIN, As, Ws);
#pragma unroll
    for (int i = 0; i < 4; ++i)
#pragma unroll
        for (int j = 0; j < 4; ++j) Ct[(ty * 4 + i) * 65 + tx * 4 + j] = acc[i][j];
    __syncthreads();
    bf16_t* dst; int head, ld; const float* g = nullptr; float sc = 1.f;
    if (ct < 12) { dst = (bf16_t*)(ws + WS_QA); head = ct; ld = PA; g = qna; sc = QSCALE; }
    else if (ct < 24) { dst = (bf16_t*)(ws + WS_KA); head = ct - 12; ld = PA; g = kna; }
    else if (ct < 36) { dst = (bf16_t*)(ws + WS_VA); head = ct - 24; ld = PA; }
    else if (ct < 44) { dst = (bf16_t*)(ws + WS_QB); head = ct - 36; ld = PB; g = qnb; sc = QSCALE; }
    else if (ct < 52) { dst = (bf16_t*)(ws + WS_KB); head = ct - 44; ld = PB; g = knb; }
    else { dst = (bf16_t*)(ws + WS_VB); head = ct - 52; ld = PB; }
    const int r = tid >> 2, cq = (tid & 3) * 16;
    float v[16]; float ss = 0.f;
#pragma unroll
    for (int c = 0; c < 16; ++c) { v[c] = Ct[r * 65 + cq + c]; ss += v[c] * v[c]; }
    ss += __shfl_xor(ss, 1); ss += __shfl_xor(ss, 2);
    const float rinv = g ? rsqrtf(ss * (1.f / 64.f) + EPS) * sc : 1.f;
    bf16_t* o = dst + (size_t)(rt * 64 + r) * ld + head * 64 + cq;
#pragma unroll
    for (int c = 0; c < 16; c += 2) { const float g0 = g ? g[cq + c] : 1.f, g1 = g ? g[cq + c + 1] : 1.f; *(unsigned*)(o + c) = pk2(v[c] * rinv * g0, v[c + 1] * rinv * g1); }
}

__global__ void __launch_bounds__(256) k_sg_gate(const bf16_t* __restrict__ XN, const float* __restrict__ w_gate, const float* __restrict__ b_gate, bf16_t* __restrict__ G) {
    SG_SMEM;
    const int ct = blockIdx.x, rt = blockIdx.y, tid = threadIdx.x, ty = tid >> 4, tx = tid & 15;
    float acc[4][4]; SG_ZERO(acc);
    sg_accum(acc, XN + (size_t)(rt * 64 + (tid >> 2)) * D + (tid & 3) * 4, D, w_gate + ct * 64, 2 * D, As, Ws);
#pragma unroll
    for (int i = 0; i < 4; ++i) {
        const int row = rt * 64 + ty * 4 + i, col = ct * 64 + tx * 4; float s[4];
#pragma unroll
        for (int j = 0; j < 4; ++j) s[j] = 1.f / (1.f + expf(-(acc[i][j] + b_gate[col + j])));
        u32x2 o; o.x = pk2(s[0], s[1]); o.y = pk2(s[2], s[3]); *(u32x2*)(G + (size_t)row * 2 * D + col) = o;
    }
}

__global__ void __launch_bounds__(256) k_sg_merge(const bf16_t* __restrict__ YA, const bf16_t* __restrict__ YB, const float* __restrict__ wpa, const float* __restrict__ wpb, const bf16_t* __restrict__ G,
                                                  bf16_t* __restrict__ MG) {
    SG_SMEM;
    const int ct = blockIdx.x, rt = blockIdx.y, tid = threadIdx.x, ty = tid >> 4, tx = tid & 15;
    float a1[4][4], a2[4][4]; SG_ZERO(a1); SG_ZERO(a2);
    sg_accum(a1, YA + (size_t)(rt * 64 + (tid >> 2)) * OUTA + (tid & 3) * 4, OUTA, wpa + ct * 64, D, As, Ws);
    sg_accum(a2, YB + (size_t)(rt * 64 + (tid >> 2)) * OUTB + (tid & 3) * 4, OUTB, wpb + ct * 64, D, As, Ws);
#pragma unroll
    for (int i = 0; i < 4; ++i) {
        const int row = rt * 64 + ty * 4 + i, col = ct * 64 + tx * 4; float s[4];
#pragma unroll
        for (int j = 0; j < 4; ++j) s[j] = bf2f(G[(size_t)row * 2 * D + col + j]) * a1[i][j] + bf2f(G[(size_t)row * 2 * D + D + col + j]) * a2[i][j];
        u32x2 o; o.x = pk2(s[0], s[1]); o.y = pk2(s[2], s[3]); *(u32x2*)(MG + (size_t)row * D + col) = o;
    }
}

__global__ void __launch_bounds__(256) k_sg_x1(const bf16_t* __restrict__ MG, const float* __restrict__ w_out, const float* __restrict__ x, float* __restrict__ X1) {
    SG_SMEM;
    const int ct = blockIdx.x, rt = blockIdx.y, tid = threadIdx.x, ty = tid >> 4, tx = tid & 15;
    float acc[4][4]; SG_ZERO(acc);
    sg_accum(acc, MG + (size_t)(rt * 64 + (tid >> 2)) * D + (tid & 3) * 4, D, w_out + ct * 64, D, As, Ws);
#pragma unroll
    for (int i = 0; i < 4; ++i) {
        const size_t off = (size_t)(rt * 64 + ty * 4 + i) * D + ct * 64 + tx * 4;
        const float4 xv = *(const float4*)(x + off);
        *(float4*)(X1 + off) = make_float4(xv.x + acc[i][0], xv.y + acc[i][1], xv.z + acc[i][2], xv.w + acc[i][3]);
    }
}

__global__ void __launch_bounds__(256) k_attnA_slow(const bf16_t* __restrict__ QA, const bf16_t* __restrict__ KA, const bf16_t* __restrict__ VA, const float* __restrict__ BIAS, bf16_t* __restrict__ YA) {
    const int gid = blockIdx.x * 256 + threadIdx.x; const int hs = gid & 3, m = gid >> 2, b = m / SEQ, t = m % SEQ;
    float o[64]; float mx = -INFINITY, l = 0.f;
#pragma unroll
    for (int d = 0; d < 64; ++d) o[d] = 0.f;
    for (int g = 0; g < 3; ++g) {
        const int head = 4 * g + hs, dil = (g == 0) ? 1 : (g == 1 ? 4 : 16);
        float q[64];
        { const u32x4* qp = (const u32x4*)(QA + (size_t)m * PA + head * 64);
#pragma unroll
          for (int c = 0; c < 8; ++c) { const u32x4 u = qp[c]; const unsigned w[4] = {u.x, u.y, u.z, u.w};
#pragma unroll
              for (int e = 0; e < 4; ++e) { q[c * 8 + 2 * e] = __uint_as_float(w[e] << 16); q[c * 8 + 2 * e + 1] = __uint_as_float(w[e] & 0xffff0000u); } } }
        for (int j = 0; j <= 128; ++j) {
            const int pos = t - dil * j; if (pos < 0) break;
            const u32x4* kp = (const u32x4*)(KA + ((size_t)b * SEQ + pos) * PA + head * 64);
            float s = 0.f;
#pragma unroll
            for (int c = 0; c < 8; ++c) { const u32x4 u = kp[c]; const unsigned w[4] = {u.x, u.y, u.z, u.w};
#pragma unroll
                for (int e = 0; e < 4; ++e) { s += q[c * 8 + 2 * e] * __uint_as_float(w[e] << 16); s += q[c * 8 + 2 * e + 1] * __uint_as_float(w[e] & 0xffff0000u); } }
            s += BIAS[head * 129 + j];
            const float mn = fmaxf(mx, s), al = exp2f(mx - mn), p = exp2f(s - mn);
            l = l * al + p; mx = mn;
            const u32x4* vp = (const u32x4*)(VA + ((size_t)b * SEQ + pos) * PA + head * 64);
#pragma unroll
            for (int c = 0; c < 8; ++c) { const u32x4 u = vp[c]; const unsigned w[4] = {u.x, u.y, u.z, u.w};
#pragma unroll
                for (int e = 0; e < 4; ++e) { o[c * 8 + 2 * e] = o[c * 8 + 2 * e] * al + p * __uint_as_float(w[e] << 16); o[c * 8 + 2 * e + 1] = o[c * 8 + 2 * e + 1] * al + p * __uint_as_float(w[e] & 0xffff0000u); } }
        }
    }
    const float il = 1.f / l;
    unsigned* op = (unsigned*)(YA + (size_t)m * OUTA + hs * 64);
#pragma unroll
    for (int d = 0; d < 64; d += 2) op[d >> 1] = pk2(o[d] * il, o[d + 1] * il);
}

__global__ void __launch_bounds__(64) k_fox_slow(const bf16_t* __restrict__ QB, const bf16_t* __restrict__ KB, const bf16_t* __restrict__ VB, const float* __restrict__ C, const float* __restrict__ qnb,
                                                 const float* __restrict__ knb, bf16_t* __restrict__ YB) {
    const int lane = threadIdx.x; const int h = blockIdx.y, b = blockIdx.x / (SEQ / 64), t0 = (blockIdx.x % (SEQ / 64)) * 64, t = t0 + lane;
    const float gq = wave_max(fabsf(qnb[lane])), gk = wave_max(fabsf(knb[lane]));
    const float thr = (2.f * 8.f * gq * gk * 1.03f + 30.f);
    const float* Cb = C + (size_t)(b * 8 + h) * SEQ;
    const float c0 = Cb[t0];
    int lo = 0, hi = t0;
    while (lo < hi) { const int mid = (lo + hi) >> 1; if (c0 - Cb[mid] >= -thr) hi = mid; else lo = mid + 1; }
    const int s_start = __builtin_amdgcn_readfirstlane(lo & ~7);
    float q[64], o[64];
    { const u32x4* qp = (const u32x4*)(QB + ((size_t)b * SEQ + t) * PB + h * 64);
#pragma unroll
      for (int c = 0; c < 8; ++c) { const u32x4 u = qp[c]; const unsigned w[4] = {u.x, u.y, u.z, u.w};
#pragma unroll
          for (int e = 0; e < 4; ++e) { q[c * 8 + 2 * e] = __uint_as_float(w[e] << 16); q[c * 8 + 2 * e + 1] = __uint_as_float(w[e] & 0xffff0000u); } } }
#pragma unroll
    for (int d = 0; d < 64; ++d) o[d] = 0.f;
    const float ct2 = Cb[t] * LOG2E;
    float mx = -INFINITY, l = 0.f;
    for (int s = s_start; s <= t0 + 63; ++s) {
        const u32x4* kp = (const u32x4*)(KB + ((size_t)b * SEQ + s) * PB + h * 64);
        float sc = 0.f;
#pragma unroll
        for (int c = 0; c < 8; ++c) { const u32x4 u = kp[c]; const unsigned w[4] = {u.x, u.y, u.z, u.w};
#pragma unroll
            for (int e = 0; e < 4; ++e) { sc += q[c * 8 + 2 * e] * __uint_as_float(w[e] << 16); sc += q[c * 8 + 2 * e + 1] * __uint_as_float(w[e] & 0xffff0000u); } }
        sc += ct2 - Cb[s] * LOG2E;
        if (s > t) sc = -INFINITY;
        const float mn = fmaxf(mx, sc);
        const float al = (mn == -INFINITY) ? 1.f : exp2f(mx - mn), p = (mn == -INFINITY) ? 0.f : exp2f(sc - mn);
        l = l * al + p; mx = mn;
        const u32x4* vp = (const u32x4*)(VB + ((size_t)b * SEQ + s) * PB + h * 64);
#pragma unroll
        for (int c = 0; c < 8; ++c) { const u32x4 u = vp[c]; const unsigned w[4] = {u.x, u.y, u.z, u.w};
#pragma unroll
            for (int e = 0; e < 4; ++e) { o[c * 8 + 2 * e] = o[c * 8 + 2 * e] * al + p * __uint_as_float(w[e] << 16); o[c * 8 + 2 * e + 1] = o[c * 8 + 2 * e + 1] * al + p * __uint_as_float(w[e] & 0xffff0000u); } }
    }
    const float il = 1.f / l;
    unsigned* op = (unsigned*)(YB + ((size_t)b * SEQ + t) * OUTB + h * 64);
#pragma unroll
    for (int d = 0; d < 64; d += 2) op[d >> 1] = pk2(o[d] * il, o[d + 1] * il);
}

__global__ void __launch_bounds__(256) k_rms2_router(const float* __restrict__ X1, const float* __restrict__ g, const float* __restrict__ w_router, const float* __restrict__ router_bias,
                                                     bf16_t* __restrict__ H2, unsigned* __restrict__ CNT, unsigned* __restrict__ LIST, float* __restrict__ GATEW) {
    __shared__ float hrow[4][D];
    const int wave = threadIdx.x >> 6, lane = threadIdx.x & 63; const int m = blockIdx.x * 4 + wave;
    const float4* xr = (const float4*)(X1 + (size_t)m * D);
    float4 v[4]; float ss = 0.f;
#pragma unroll
    for (int j = 0; j < 4; ++j) { v[j] = xr[lane + 64 * j]; ss += v[j].x * v[j].x + v[j].y * v[j].y + v[j].z * v[j].z + v[j].w * v[j].w; }
    ss = wave_sum(ss);
    const float rinv = rsqrtf(ss * (1.f / D) + EPS);
#pragma unroll
    for (int j = 0; j < 4; ++j) {
        const float4 gg = ((const float4*)g)[lane + 64 * j];
        const float4 y = make_float4(v[j].x * rinv * gg.x, v[j].y * rinv * gg.y, v[j].z * rinv * gg.z, v[j].w * rinv * gg.w);
        u32x2 o; o.x = pk2(y.x, y.y); o.y = pk2(y.z, y.w);
        *(u32x2*)(H2 + (size_t)m * D + 4 * (lane + 64 * j)) = o;
        *(float4*)(&hrow[wave][4 * (lane + 64 * j)]) = y;
    }
    __syncthreads();
    float acc = 0.f;
#pragma unroll 8
    for (int i = 0; i < D; ++i) acc += hrow[wave][i] * w_router[(size_t)i * NE + lane];
    const float score = 1.f / (1.f + expf(-acc));
    float sel = score + router_bias[lane];
    float ssum = 0.f; float myw = 0.f; int myk = -1;
    for (int k = 0; k < TOPK; ++k) {
        float bv = sel; int bi = lane;
#pragma unroll
        for (int o = 1; o < 64; o <<= 1) { const float ov = __shfl_xor(bv, o); const int oi = __shfl_xor(bi, o); if (ov > bv || (ov == bv && oi < bi)) { bv = ov; bi = oi; } }
        const float sw = __shfl(score, bi);
        ssum += sw;
        if (lane == bi) { sel = -INFINITY; myw = sw; myk = k; }
    }
    if (myk >= 0) {
        const float w = myw / ssum * 2.5f;
        const int l = lane * 2 + (myk >> 2);
        const unsigned pos = atomicAdd(&CNT[l], 1u);
        LIST[(size_t)l * M + pos] = (unsigned)m * 8u + (unsigned)myk;
        GATEW[(size_t)m * 8 + myk] = w;
    }
}

__global__ void __launch_bounds__(256) k_sg_moe1(const bf16_t* __restrict__ H2, const float* __restrict__ wg_e, const float* __restrict__ wu_e, const float* __restrict__ wg_s, const float* __restrict__ wu_s,
                                                 const unsigned* __restrict__ CNT, const unsigned* __restrict__ LIST, const float* __restrict__ GATEW, bf16_t* __restrict__ H, bf16_t* __restrict__ HS) {
    SG_SMEM; __shared__ unsigned s_hb;
    const int ct = blockIdx.x, rt = blockIdx.y, l = blockIdx.z, tid = threadIdx.x, ty = tid >> 4, tx = tid & 15;
    const int cnt = (l < NLIST) ? (int)CNT[l] : M;
    if (rt * 64 >= cnt) return;
    if (tid == 0) { unsigned s = 0; for (int i = 0; i < l && i < NLIST; ++i) s += CNT[i]; s_hb = s; }
    __syncthreads();
    const unsigned hb = s_hb;
    const int e = l >> 1;
    auto entry = [&](int row) -> unsigned { const int rr = row < cnt ? row : cnt - 1; return (l < NLIST) ? LIST[(size_t)l * M + rr] : (unsigned)rr * 8u; };
    const unsigned en_s = entry(rt * 64 + (tid >> 2));
    const bf16_t* arow = H2 + (size_t)(en_s >> 3) * D + (tid & 3) * 4;
    const float* wg = (l < NLIST) ? wg_e + (size_t)e * D * DE : wg_s; const float* wu = (l < NLIST) ? wu_e + (size_t)e * D * DE : wu_s;
    float ag[4][4], au[4][4]; SG_ZERO(ag); SG_ZERO(au);
    sg_accum(ag, arow, D, wg + ct * 64, DE, As, Ws);
    sg_accum(au, arow, D, wu + ct * 64, DE, As, Ws);
#pragma unroll
    for (int i = 0; i < 4; ++i) {
        const int row = rt * 64 + ty * 4 + i; if (row >= cnt) continue;
        const unsigned en = entry(row); const float gw = (l < NLIST) ? GATEW[en] : 1.f;
        float s[4];
#pragma unroll
        for (int j = 0; j < 4; ++j) { const float gg = ag[i][j]; s[j] = gg / (1.f + expf(-gg)) * au[i][j] * gw; }
        u32x2 o; o.x = pk2(s[0], s[1]); o.y = pk2(s[2], s[3]);
        bf16_t* dst = (l < NLIST) ? H + ((size_t)hb + row) * DE : HS + (size_t)(en >> 3) * DE;
        *(u32x2*)(dst + ct * 64 + tx * 4) = o;
    }
}
__global__ void __launch_bounds__(256) k_sg_moe2(const bf16_t* __restrict__ H, const bf16_t* __restrict__ HS, const float* __restrict__ wd_e, const float* __restrict__ wd_s, const unsigned* __restrict__ CNT,
                                                 const unsigned* __restrict__ LIST, float* __restrict__ OUT) {
    SG_SMEM; __shared__ unsigned s_hb;
    const int ct = blockIdx.x, rt = blockIdx.y, l = blockIdx.z, tid = threadIdx.x, ty = tid >> 4, tx = tid & 15;
    const int cnt = (l < NLIST) ? (int)CNT[l] : M;
    if (rt * 64 >= cnt) return;
    if (tid == 0) { unsigned s = 0; for (int i = 0; i < l && i < NLIST; ++i) s += CNT[i]; s_hb = s; }
    __syncthreads();
    const unsigned hb = s_hb;
    const int e = l >> 1;
    auto entry = [&](int row) -> unsigned { const int rr = row < cnt ? row : cnt - 1; return (l < NLIST) ? LIST[(size_t)l * M + rr] : (unsigned)rr * 8u; };
    const int srow = rt * 64 + (tid >> 2); const int srr = srow < cnt ? srow : cnt - 1;
    const bf16_t* arow = ((l < NLIST) ? H + ((size_t)hb + srr) * DE : HS + (size_t)srr * DE) + (tid & 3) * 4;
    const float* wd = (l < NLIST) ? wd_e + (size_t)e * DE * D : wd_s;
    float acc[4][4]; SG_ZERO(acc);
    sg_accum(acc, arow, DE, wd + ct * 64, D, As, Ws);
#pragma unroll
    for (int i = 0; i < 4; ++i) {
        const int row = rt * 64 + ty * 4 + i; if (row >= cnt) continue;
        const unsigned tok = entry(row) >> 3;
#pragma unroll
        for (int j = 0; j < 4; ++j) atomicAdd(OUT + (size_t)tok * D + ct * 64 + tx * 4 + j, acc[i][j]);
    }
}

extern "C" void kernel_launch(void* const* d_in, const int* in_sizes, int n_in, void* d_out, int out_size, void* d_ws, size_t ws_size, hipStream_t stream) {
    if (n_in != 23 || out_size != M * D || ws_size < WS_END) { fprintf(stderr, "kernel_launch: unexpected shapes / workspace (%d inputs, out %d, ws %zu)\n", n_in, out_size, ws_size); return; }
    const float* x = (const float*)d_in[0]; const float* g_mix = (const float*)d_in[1]; const float* w_in = (const float*)d_in[2];
    const float* qna = (const float*)d_in[3]; const float* kna = (const float*)d_in[4]; const float* qnb = (const float*)d_in[5]; const float* knb = (const float*)d_in[6];
    const float* rel_bias = (const float*)d_in[7]; const float* b_forget = (const float*)d_in[8]; const float* w_gate = (const float*)d_in[9]; const float* b_gate = (const float*)d_in[10];
    const float* wpa = (const float*)d_in[11]; const float* wpb = (const float*)d_in[12]; const float* w_out = (const float*)d_in[13]; const float* g_ffn = (const float*)d_in[14];
    const float* w_router = (const float*)d_in[15]; const float* router_bias = (const float*)d_in[16]; const float* wg_e = (const float*)d_in[17]; const float* wu_e = (const float*)d_in[18];
    const float* wd_e = (const float*)d_in[19]; const float* wg_s = (const float*)d_in[20]; const float* wu_s = (const float*)d_in[21]; const float* wd_s = (const float*)d_in[22];
    unsigned char* ws = (unsigned char*)d_ws; float* out = (float*)d_out;
    bf16_t* G = (bf16_t*)d_out;
    unsigned* CTL = (unsigned*)(ws + WS_CTL);
    hipMemsetAsync(ws + WS_CTL, 0, 1 * MiB, stream);
    k_rms_logf<<<M / 4, 256, 0, stream>>>(x, g_mix, w_in, b_forget, (bf16_t*)(ws + WS_XN), (float*)(ws + WS_LOGF));
    k_cumsum<<<16, 1024, 0, stream>>>((const float*)(ws + WS_LOGF), (float*)(ws + WS_C), (bf16_t*)(ws + WS_KAUG));
    k_bias_table<<<(HA * 129 + 255) / 256, 256, 0, stream>>>(rel_bias, (float*)(ws + WS_BIAS));
    k_sg_qkv<<<dim3(60, M / 64), 256, 0, stream>>>((const bf16_t*)(ws + WS_XN), w_in, qna, kna, qnb, knb, ws);
    k_sg_gate<<<dim3(32, M / 64), 256, 0, stream>>>((const bf16_t*)(ws + WS_XN), w_gate, b_gate, G);
    k_attnA_slow<<<M * 4 / 256, 256, 0, stream>>>((const bf16_t*)(ws + WS_QA), (const bf16_t*)(ws + WS_KA), (const bf16_t*)(ws + WS_VA), (const float*)(ws + WS_BIAS), (bf16_t*)(ws + WS_YA));
    k_fox_slow<<<dim3(M / 64, HB), 64, 0, stream>>>((const bf16_t*)(ws + WS_QB), (const bf16_t*)(ws + WS_KB), (const bf16_t*)(ws + WS_VB), (const float*)(ws + WS_C), qnb, knb, (bf16_t*)(ws + WS_YB));
    k_sg_merge<<<dim3(16, M / 64), 256, 0, stream>>>((const bf16_t*)(ws + WS_YA), (const bf16_t*)(ws + WS_YB), wpa, wpb, G, (bf16_t*)(ws + WS_MERGED));
    k_sg_x1<<<dim3(16, M / 64), 256, 0, stream>>>((const bf16_t*)(ws + WS_MERGED), w_out, x, out);
    k_rms2_router<<<M / 4, 256, 0, stream>>>(out, g_ffn, w_router, router_bias, (bf16_t*)(ws + WS_H2), CTL + CW_CNT, (unsigned*)(ws + WS_LIST), (float*)(ws + WS_GATEW));
    k_sg_moe1<<<dim3(4, M / 64, NLIST + 1), 256, 0, stream>>>((const bf16_t*)(ws + WS_H2), wg_e, wu_e, wg_s, wu_s, CTL + CW_CNT, (const unsigned*)(ws + WS_LIST), (const float*)(ws + WS_GATEW),
                                                               (bf16_t*)(ws + WS_H), (bf16_t*)(ws + WS_HS));
    k_sg_moe2<<<dim3(16, M / 64, NLIST + 1), 256, 0, stream>>>((const bf16_t*)(ws + WS_H), (const bf16_t*)(ws + WS_HS), wd_e, wd_s, CTL + CW_CNT, (const unsigned*)(ws + WS_LIST), out);
}
```

```cpp
#include <hip/hip_runtime.h>
#include <hip/hip_bf16.h>
#include <cstdint>
#include <cstdio>

typedef unsigned short bf16_t;
typedef unsigned u32x4 __attribute__((ext_vector_type(4)));
typedef unsigned u32x2 __attribute__((ext_vector_type(2)));

constexpr int BATCH = 2, SEQ = 8192, M = BATCH * SEQ, D = 1024;
constexpr int HA = 12, HB = 8, HD = 64;
constexpr int WA = 3 * HA * HD, WB = 3 * HB * HD, DIN = WA + WB + HB;
constexpr int PA = HA * HD, PB = HB * HD;
constexpr int OUTA = 256, OUTB = 512;
constexpr int NE = 64, TOPK = 8, DE = 256;
constexpr int NLIST = 2 * NE;
constexpr float EPS = 1e-6f;
constexpr float LOG2E = 1.4426950408889634f;
constexpr float QSCALE = 0.125f * LOG2E;

constexpr size_t MiB = 1u << 20, KiB = 1u << 10;
constexpr size_t WS_CTL = 0;
constexpr size_t WS_LOGF = 1 * MiB;
constexpr size_t WS_C = 1 * MiB + 512 * KiB;
constexpr size_t WS_KAUG = 2 * MiB;
constexpr size_t WS_LIST = 4 * MiB;
constexpr size_t WS_GATEW = 12 * MiB;
constexpr size_t WS_BIAS = 12 * MiB + 512 * KiB;
constexpr size_t WS_FT0 = WS_BIAS + 8 * KiB;
constexpr size_t WS_WRF = WS_BIAS + 64 * KiB;
constexpr size_t WS_RINV = WS_BIAS + 384 * KiB;
constexpr size_t WS_W2 = 13 * MiB;
constexpr size_t WS_R1 = 45 * MiB + 512 * KiB;
constexpr size_t WS_W1 = WS_R1;
constexpr size_t WS_WIN = WS_R1 + 65 * MiB;
constexpr size_t WS_XN = WS_R1 + 80 * MiB;
constexpr size_t WS_YA = WS_XN;
constexpr size_t WS_YB = WS_XN + 8 * MiB;
constexpr size_t WS_H2 = WS_XN;
constexpr size_t WS_QB = WS_R1 + 112 * MiB;
constexpr size_t WS_R2 = WS_R1 + 128 * MiB;
constexpr size_t WS_QA = WS_R2;
constexpr size_t WS_KA = WS_R2 + 24 * MiB;
constexpr size_t WS_VA = WS_R2 + 48 * MiB;
constexpr size_t WS_KB = WS_R2 + 72 * MiB;
constexpr size_t WS_VB = WS_R2 + 88 * MiB;
constexpr size_t WS_MERGED = WS_R2;
constexpr size_t WS_H = WS_R2;
constexpr size_t WS_HS = WS_R2 + 65 * MiB;
constexpr size_t WS_Y = WS_R1;
constexpr size_t WS_META = WS_R2 + 80 * MiB;
constexpr size_t WS_INV = WS_R2 + 96 * MiB;
constexpr size_t WS_END = WS_R2 + 104 * MiB;
constexpr int CW_APAIR = 12288;
constexpr int CW_Q2 = 1536;
constexpr int CW_CNT = 8192, CNT_STRIDE = 32;

__device__ __forceinline__ float bf2f(bf16_t v) { return __uint_as_float((unsigned)v << 16); }
__device__ __forceinline__ unsigned f2bf(float f) { unsigned u = __float_as_uint(f); return (u + 0x7fffu + ((u >> 16) & 1u)) >> 16; }
__device__ __forceinline__ unsigned pk2(float lo, float hi) { return f2bf(lo) | (f2bf(hi) << 16); }
__device__ __forceinline__ float wave_sum(float v) {
#pragma unroll
    for (int o = 1; o < 64; o <<= 1) v += __shfl_xor(v, o);
    return v;
}
__device__ __forceinline__ float wave_max(float v) {
#pragma unroll
    for (int o = 1; o < 64; o <<= 1) v = fmaxf(v, __shfl_xor(v, o));
    return v;
}

typedef unsigned short bf16_t_dummy_;
namespace pg8 {
#define PG8_LAS __attribute__((address_space(3)))
typedef unsigned short bf16_t;
typedef short bf16x8 __attribute__((ext_vector_type(8)));
typedef float f32x4 __attribute__((ext_vector_type(4)));
typedef unsigned u32x4 __attribute__((ext_vector_type(4)));
constexpr int BM = 256, BK = 64, HALF = 128, HTB = HALF * BK * 2  , STAGE_BYTES = 8 * HTB, NXCD = 8, WGM = 8;

__host__ __device__ __forceinline__ int lds_byte(int r, int c) { const int st = (r >> 4) * 2 + (c >> 5), rr = r & 15, cc = c & 31, ob = rr * 64 + cc * 2; return st * 1024 + (ob ^ (((ob >> 9) & 1) << 5)); }
__host__ __device__ __forceinline__ void stage_rc(int b, int& R, int& C) { const int st = b / 1024, sb = b % 1024, swz = sb ^ (((sb >> 9) & 1) << 5); R = (st >> 1) * 16 + swz / 64; C = (st & 1) * 32 + (swz % 64) / 2; }
__host__ __device__ __forceinline__ int perm32(int rho) { const int n = rho >> 4, i = rho & 15; return 8 * (i >> 2) + 4 * n + (i & 3); }

struct Unit { int pm, pn; };
struct Gemm { const bf16_t* A; const bf16_t* Bt; int M, N, K; };

struct StaticOrder {
    int nM, nN, nwg, G, c;
    __host__ __device__ void init(int M, int N, int G_, int c_) { nM = M / BM; nN = N / BM; nwg = nM * nN; G = G_; c = c_; }
    __host__ __device__ bool next(int i, Unit& u) const {
        const long L = (long)i * G + c; if (L >= nwg) return false;
        int wgid = (int)L; { const int q = nwg / NXCD, r = nwg % NXCD, xcd = wgid % NXCD, off = wgid / NXCD; wgid = (xcd < r ? xcd * (q + 1) : r * (q + 1) + (xcd - r) * q) + off; }
        const int nig = WGM * nN, gid = wgid / nig, fm = gid * WGM, gsz = (nM - fm) < WGM ? (nM - fm) : WGM;
        u.pm = fm + ((wgid % nig) % gsz); u.pn = (wgid % nig) / gsz; return true;
    }
    __device__ __forceinline__ void a_ready(const Unit&) const {}
    __device__ __forceinline__ void done(const Unit&) const {}
};

__device__ __forceinline__ unsigned cvt_pk_bf16(float lo, float hi) { unsigned r; asm volatile("v_cvt_pk_bf16_f32 %0, %1, %2" : "=v"(r) : "v"(lo), "v"(hi)); return r; }
typedef float f32x2 __attribute__((ext_vector_type(2)));
struct RepOrder : StaticOrder { int nrep;
    __device__ __forceinline__ bool next(int i, Unit& u) const { const int per = (nwg - c + G - 1) / G; if (per <= 0 || i >= per * nrep) return false; return StaticOrder::next(i % per, u); } };
typedef float f32x2_c __attribute__((ext_vector_type(2))); typedef __bf16 bf16x2_c __attribute__((ext_vector_type(2)));
__device__ __forceinline__ unsigned cvtc(float lo, float hi) { f32x2_c v = {lo, hi}; bf16x2_c b = __builtin_convertvector(v, bf16x2_c); return __builtin_bit_cast(unsigned, b); }
struct EpiQKVG {
    static constexpr bool PERM = true, AFTER_DRAIN = false;
    unsigned char* ws; bf16_t* G; const float *qna, *kna, *qnb, *knb, *b_gate;
    __device__ __forceinline__ void operator()(const f32x4 (&acc)[2][2][4][2], const Unit& u, int wr, int wc, int fr, int fq) const {
        const int pn = u.pn; const int row0 = u.pm * BM + wr * 64 + fr;
        if (pn >= 15) {
            const int col0 = (pn - 15) * 256 + wc * 32 + 8 * fq;
            f32x4 bv[2][2];
#pragma unroll
            for (int bj = 0; bj < 2; ++bj)
#pragma unroll
                for (int n = 0; n < 2; ++n) bv[bj][n] = *(const f32x4*)(b_gate + col0 + bj * HALF + 4 * n);
#pragma unroll
            for (int ai = 0; ai < 2; ++ai)
#pragma unroll
                for (int m = 0; m < 4; ++m) { bf16_t* rowp = G + (size_t)(row0 + ai * HALF + m * 16) * 2048 + col0;
#pragma unroll
                    for (int bj = 0; bj < 2; ++bj) { f32x4 v0 = acc[ai][bj][m][0] + bv[bj][0], v1 = acc[ai][bj][m][1] + bv[bj][1];
#pragma unroll
                        for (int i = 0; i < 4; ++i) { v0[i] = __builtin_amdgcn_rcpf(1.f + __builtin_amdgcn_exp2f(-1.4426950408889634f * v0[i])); v1[i] = __builtin_amdgcn_rcpf(1.f + __builtin_amdgcn_exp2f(-1.4426950408889634f * v1[i])); }
                        u32x4 w; w.x = cvtc(v0[0], v0[1]); w.y = cvtc(v0[2], v0[3]); w.z = cvtc(v1[0], v1[1]); w.w = cvtc(v1[2], v1[3]);
                        *(u32x4*)(rowp + bj * HALF) = w; } }
        } else {
            bf16_t* dst; int ld, hb; const float* g = nullptr; float sc = 1.f;
            if (pn < 3) { dst = (bf16_t*)(ws + WS_QA); ld = PA; hb = 4 * pn; g = qna; sc = QSCALE; }
            else if (pn < 6) { dst = (bf16_t*)(ws + WS_KA); ld = PA; hb = 4 * (pn - 3); g = kna; }
            else if (pn < 9) { dst = (bf16_t*)(ws + WS_VA); ld = PA; hb = 4 * (pn - 6); }
            else if (pn < 11) { dst = (bf16_t*)(ws + WS_QB); ld = PB; hb = 4 * (pn - 9); g = qnb; sc = QSCALE; }
            else if (pn < 13) { dst = (bf16_t*)(ws + WS_KB); ld = PB; hb = 4 * (pn - 11); g = knb; }
            else { dst = (bf16_t*)(ws + WS_VB); ld = PB; hb = 4 * (pn - 13); }
            const int colb = (hb + wc) * 64 + 8 * fq;
            f32x4 gv[2][2];
#pragma unroll
            for (int bj = 0; bj < 2; ++bj)
#pragma unroll
                for (int n = 0; n < 2; ++n) gv[bj][n] = g ? *(const f32x4*)(g + 32 * bj + 8 * fq + 4 * n) : (f32x4){1.f, 1.f, 1.f, 1.f};
#pragma unroll
            for (int ai = 0; ai < 2; ++ai)
#pragma unroll
                for (int m = 0; m < 4; ++m) {
                    float rinv = 1.f;
                    if (g) { float ss = 0.f;
#pragma unroll
                        for (int bj = 0; bj < 2; ++bj)
#pragma unroll
                            for (int n = 0; n < 2; ++n) { const f32x4 x = acc[ai][bj][m][n]; ss += (x[0] * x[0] + x[1] * x[1]) + (x[2] * x[2] + x[3] * x[3]); }
                        ss += __shfl_xor(ss, 16); ss += __shfl_xor(ss, 32);
                        rinv = __builtin_amdgcn_rsqf(ss * (1.f / 64.f) + EPS) * sc; }
                    bf16_t* rowp = dst + (size_t)(row0 + ai * HALF + m * 16) * ld + colb;
#pragma unroll
                    for (int bj = 0; bj < 2; ++bj) { const f32x4 v0 = acc[ai][bj][m][0] * rinv * gv[bj][0], v1 = acc[ai][bj][m][1] * rinv * gv[bj][1];
                        u32x4 w; w.x = cvtc(v0[0], v0[1]); w.y = cvtc(v0[2], v0[3]); w.z = cvtc(v1[0], v1[1]); w.w = cvtc(v1[2], v1[3]);
                        *(u32x4*)(rowp + 32 * bj) = w; } }
        }
    }
};
struct EpiMergeA {
    static constexpr bool PERM = true, AFTER_DRAIN = false;
    const bf16_t* G; bf16_t* T;
    __device__ __forceinline__ void operator()(const f32x4 (&acc)[2][2][4][2], const Unit& u, int wr, int wc, int fr, int fq) const {
        const unsigned row0 = (unsigned)(u.pm * BM + wr * 64 + fr), col0 = (unsigned)(u.pn * BM + wc * 32 + 8 * fq);
#pragma unroll
        for (int ai = 0; ai < 2; ++ai) {
            u32x4 g[4][2];
#pragma unroll
            for (int m = 0; m < 4; ++m)
#pragma unroll
                for (int bj = 0; bj < 2; ++bj) g[m][bj] = *(const u32x4*)(G + ((row0 + ai * HALF + m * 16) * 2048u + col0 + bj * HALF));
#pragma unroll
            for (int m = 0; m < 4; ++m)
#pragma unroll
                for (int bj = 0; bj < 2; ++bj) { const u32x4 gg = g[m][bj]; const f32x4 a0 = acc[ai][bj][m][0], a1 = acc[ai][bj][m][1];
                    u32x4 w;
                    w.x = cvtc(a0[0] * __uint_as_float(gg.x << 16), a0[1] * __uint_as_float(gg.x & 0xffff0000u)); w.y = cvtc(a0[2] * __uint_as_float(gg.y << 16), a0[3] * __uint_as_float(gg.y & 0xffff0000u));
                    w.z = cvtc(a1[0] * __uint_as_float(gg.z << 16), a1[1] * __uint_as_float(gg.z & 0xffff0000u)); w.w = cvtc(a1[2] * __uint_as_float(gg.w << 16), a1[3] * __uint_as_float(gg.w & 0xffff0000u));
                    *(u32x4*)(T + ((row0 + ai * HALF + m * 16) * 1024u + col0 + bj * HALF)) = w; }
            asm volatile("" ::: "memory");
        }
    }
};
struct EpiMergeB {
    static constexpr bool PERM = true, AFTER_DRAIN = false;
    const bf16_t* G; const bf16_t* T; bf16_t* O;
    __device__ __forceinline__ void operator()(const f32x4 (&acc)[2][2][4][2], const Unit& u, int wr, int wc, int fr, int fq) const {
        const unsigned row0 = (unsigned)(u.pm * BM + wr * 64 + fr), col0 = (unsigned)(u.pn * BM + wc * 32 + 8 * fq);
#pragma unroll
        for (int ai = 0; ai < 2; ++ai)
#pragma unroll
          for (int mp = 0; mp < 2; ++mp) {
            u32x4 g[2][2], t[2][2];
#pragma unroll
            for (int mm = 0; mm < 2; ++mm)
#pragma unroll
                for (int bj = 0; bj < 2; ++bj) { const unsigned r = row0 + ai * HALF + (2 * mp + mm) * 16; g[mm][bj] = *(const u32x4*)(G + (r * 2048u + 1024u + col0 + bj * HALF)); t[mm][bj] = *(const u32x4*)(T + (r * 1024u + col0 + bj * HALF)); }
#pragma unroll
            for (int mm = 0; mm < 2; ++mm)
#pragma unroll
                for (int bj = 0; bj < 2; ++bj) { const int m = 2 * mp + mm; const u32x4 gg = g[mm][bj], tt = t[mm][bj]; const f32x4 a0 = acc[ai][bj][m][0], a1 = acc[ai][bj][m][1];
                    u32x4 w;
                    w.x = cvtc(__uint_as_float(tt.x << 16) + a0[0] * __uint_as_float(gg.x << 16), __uint_as_float(tt.x & 0xffff0000u) + a0[1] * __uint_as_float(gg.x & 0xffff0000u));
                    w.y = cvtc(__uint_as_float(tt.y << 16) + a0[2] * __uint_as_float(gg.y << 16), __uint_as_float(tt.y & 0xffff0000u) + a0[3] * __uint_as_float(gg.y & 0xffff0000u));
                    w.z = cvtc(__uint_as_float(tt.z << 16) + a1[0] * __uint_as_float(gg.z << 16), __uint_as_float(tt.z & 0xffff0000u) + a1[1] * __uint_as_float(gg.z & 0xffff0000u));
                    w.w = cvtc(__uint_as_float(tt.w << 16) + a1[2] * __uint_as_float(gg.w << 16), __uint_as_float(tt.w & 0xffff0000u) + a1[3] * __uint_as_float(gg.w & 0xffff0000u));
                    *(u32x4*)(O + ((row0 + ai * HALF + m * 16) * 1024u + col0 + bj * HALF)) = w; }
            asm volatile("" ::: "memory");
          }
    }
};
struct EpiResF32 {
    static constexpr bool PERM = false, AFTER_DRAIN = false;
    const float* X; float* O;
    __device__ __forceinline__ void operator()(const f32x4 (&acc)[2][2][4][2], const Unit& u, int wr, int wc, int fr, int fq) const {
        const unsigned row0 = (unsigned)(u.pm * BM + wr * 64 + fr), col0 = (unsigned)(u.pn * BM + wc * 32 + 4 * fq);
#pragma unroll
        for (int ai = 0; ai < 2; ++ai)
#pragma unroll
          for (int mp = 0; mp < 2; ++mp) {
            f32x4 xv[2][2][2];
#pragma unroll
            for (int mm = 0; mm < 2; ++mm)
#pragma unroll
                for (int bj = 0; bj < 2; ++bj)
#pragma unroll
                    for (int n = 0; n < 2; ++n) xv[mm][bj][n] = *(const f32x4*)(X + ((row0 + ai * HALF + (2 * mp + mm) * 16) * 1024u + col0 + bj * HALF + n * 16));
#pragma unroll
            for (int mm = 0; mm < 2; ++mm)
#pragma unroll
                for (int bj = 0; bj < 2; ++bj)
#pragma unroll
                    for (int n = 0; n < 2; ++n) *(f32x4*)(O + ((row0 + ai * HALF + (2 * mp + mm) * 16) * 1024u + col0 + bj * HALF + n * 16)) = xv[mm][bj][n] + acc[ai][bj][2 * mp + mm][n];
            asm volatile("" ::: "memory");
          }
    }
};
template <class Epi, class Sched, bool ALIGN_EPI = false, bool SP2 = false>
__device__ __forceinline__ void gemm_phase(PG8_LAS unsigned char* lds, const Gemm g, const Sched& S, const Epi& E) {
    int tid_ = threadIdx.x; asm volatile("" : "+v"(tid_));
    const int tid = tid_, wid = __builtin_amdgcn_readfirstlane(tid >> 6), lane = tid & 63, wr = wid >> 2, wc = wid & 3, fr = lane & 15, fq = lane >> 4;
    const int K = g.K, nt = K / BK;
    unsigned voffA[2], voffB[2];
#pragma unroll
    for (int i = 0; i < 2; ++i) { int R, C; stage_rc(tid * 16 + i * 8192, R, C); const int Rb = Epi::PERM ? ((R & ~31) + perm32(R & 31)) : R;
        voffA[i] = (unsigned)(R * K + C) * 2u; voffB[i] = (unsigned)(Rb * K + C) * 2u; }
    const size_t kstep = (size_t)(BK * 2);
    const size_t hstep = (size_t)HALF * K * 2;
    const size_t tstep = 2 * hstep;
    const unsigned ldsw = (unsigned)wid * 1024u;
    const int aoff = lds_byte(wr * 64 + fr, fq * 8), boff = lds_byte(wc * 32 + fr, fq * 8);
#define PG8_SA(b, h) (((b) * 2 + (h)) * HTB)
#define PG8_SB(b, h) ((4 + (b) * 2 + (h)) * HTB)
#define PG8_STAGE(bufoff, gbase, voff) do { _Pragma("unroll") for (int _i = 0; _i < 2; ++_i) \
        __builtin_amdgcn_global_load_lds((const unsigned*)((const char*)(gbase) + (voff)[_i]), (PG8_LAS unsigned*)(lds + (bufoff) + ldsw + _i * 8192), 16, 0, 0); } while (0)
#define PG8_LDA(dst, b, h) do { _Pragma("unroll") for (int m = 0; m < 4; ++m) _Pragma("unroll") for (int k = 0; k < 2; ++k) dst[m][k] = *(const PG8_LAS bf16x8*)(lds + PG8_SA(b, h) + aoff + m * 2048 + k * 1024); } while (0)
#define PG8_LDB(dst, b, h) do { _Pragma("unroll") for (int n = 0; n < 2; ++n) _Pragma("unroll") for (int k = 0; k < 2; ++k) dst[n][k] = *(const PG8_LAS bf16x8*)(lds + PG8_SB(b, h) + boff + n * 2048 + k * 1024); } while (0)
#define PG8_MMA(ai, bj, At, Bt) do { __builtin_amdgcn_s_setprio(1); _Pragma("unroll") for (int m = 0; m < 4; ++m) _Pragma("unroll") for (int n = 0; n < 2; ++n) _Pragma("unroll") for (int k = 0; k < 2; ++k) \
        acc[ai][bj][m][n] = __builtin_amdgcn_mfma_f32_16x16x32_bf16(Bt[n][k], At[m][k], acc[ai][bj][m][n], 0, 0, 0); __builtin_amdgcn_s_setprio(0); } while (0)
#define PG8_WAIT_V(n) asm volatile("s_waitcnt vmcnt(" #n ")" ::: "memory")
#define PG8_WAIT_L(n) asm volatile("s_waitcnt lgkmcnt(" #n ")" ::: "memory")
#define PG8_BAR __builtin_amdgcn_s_barrier()
#define PG8_SCHED __builtin_amdgcn_sched_barrier(0)
    Unit cur, nxt; int ui = 0;
    if (!S.next(0, cur)) return;
    f32x4 acc[2][2][4][2];
#pragma unroll
    for (int a = 0; a < 2; ++a)
#pragma unroll
        for (int b = 0; b < 2; ++b)
#pragma unroll
            for (int m = 0; m < 4; ++m)
#pragma unroll
                for (int n = 0; n < 2; ++n) acc[a][b][m][n] = (f32x4){0.f, 0.f, 0.f, 0.f};
    bf16x8 At[4][2], B0[2][2], B1[2][2];
    const char* cA = (const char*)g.A + (size_t)cur.pm * tstep; const char* cB = (const char*)g.Bt + (size_t)cur.pn * tstep;
    S.a_ready(cur);
    if constexpr (SP2) {
        PG8_STAGE(PG8_SB(0, 0), cB, voffB); PG8_STAGE(PG8_SB(0, 1), cB + hstep, voffB); PG8_STAGE(PG8_SA(0, 0), cA, voffA); PG8_STAGE(PG8_SA(0, 1), cA + hstep, voffA);
        if (wr == 1) PG8_BAR;
        PG8_WAIT_V(2); PG8_BAR;
        PG8_STAGE(PG8_SB(1, 0), cB + kstep, voffB); PG8_STAGE(PG8_SA(1, 0), cA + kstep, voffA); PG8_STAGE(PG8_SB(1, 1), cB + hstep + kstep, voffB);
        PG8_WAIT_V(6); PG8_BAR;
    } else {
        PG8_STAGE(PG8_SB(0, 0), cB, voffB); PG8_STAGE(PG8_SA(0, 0), cA, voffA); PG8_STAGE(PG8_SB(0, 1), cB + hstep, voffB); PG8_STAGE(PG8_SA(0, 1), cA + hstep, voffA);
        if (wr == 1) PG8_BAR;
        PG8_WAIT_V(4); PG8_BAR;
        PG8_STAGE(PG8_SB(1, 0), cB + kstep, voffB); PG8_STAGE(PG8_SA(1, 0), cA + kstep, voffA); PG8_STAGE(PG8_SB(1, 1), cB + hstep + kstep, voffB);
        PG8_WAIT_V(6); PG8_BAR;
    }
    for (;;) {
        const bool has_next = S.next(ui + 1, nxt);
        const char* nA = has_next ? (const char*)g.A + (size_t)nxt.pm * tstep : cA; const char* nB = has_next ? (const char*)g.Bt + (size_t)nxt.pn * tstep : cB;
        for (int t = 0; t < nt; t += 2) {
            const bool last = (t == nt - 2);
            const char* a1 = cA + (size_t)(t + 1) * kstep;
            const char* a2 = last ? nA : cA + (size_t)(t + 2) * kstep; const char* b2 = last ? nB : cB + (size_t)(t + 2) * kstep;
            const char* a3 = a2 + kstep; const char* b3 = b2 + kstep;
            if (last && has_next) S.a_ready(nxt);
            if constexpr (SP2) {
            PG8_LDB(B0, 0, 0); PG8_LDB(B1, 0, 1); PG8_SCHED; PG8_LDA(At, 0, 0); PG8_STAGE(PG8_SA(1, 1), a1 + hstep, voffA);
            PG8_WAIT_V(8); PG8_WAIT_L(0); PG8_BAR; PG8_MMA(0, 0, At, B0); PG8_MMA(0, 1, At, B1); PG8_BAR; PG8_SCHED;
            PG8_LDA(At, 0, 1); PG8_STAGE(PG8_SB(0, 0), b2, voffB); PG8_STAGE(PG8_SB(0, 1), b2 + hstep, voffB); PG8_STAGE(PG8_SA(0, 0), a2, voffA);
            PG8_WAIT_V(8); PG8_WAIT_L(0); PG8_BAR; PG8_MMA(1, 0, At, B0); PG8_MMA(1, 1, At, B1); PG8_BAR; PG8_SCHED;
            PG8_LDB(B0, 1, 0); PG8_LDB(B1, 1, 1); PG8_SCHED; PG8_LDA(At, 1, 0); PG8_STAGE(PG8_SA(0, 1), a2 + hstep, voffA);
            PG8_WAIT_V(8); PG8_WAIT_L(0); PG8_BAR; PG8_MMA(0, 0, At, B0); PG8_MMA(0, 1, At, B1); PG8_BAR; PG8_SCHED;
            PG8_LDA(At, 1, 1); PG8_STAGE(PG8_SB(1, 0), b3, voffB); PG8_STAGE(PG8_SB(1, 1), b3 + hstep, voffB); PG8_STAGE(PG8_SA(1, 0), a3, voffA);
            PG8_WAIT_V(8); PG8_WAIT_L(0); PG8_BAR; PG8_MMA(1, 0, At, B0); PG8_MMA(1, 1, At, B1); PG8_BAR; PG8_SCHED;
            } else {
            PG8_LDB(B0, 0, 0); PG8_SCHED; PG8_LDA(At, 0, 0); PG8_STAGE(PG8_SA(1, 1), a1 + hstep, voffA);
            PG8_WAIT_L(8); PG8_BAR; PG8_WAIT_L(0); PG8_MMA(0, 0, At, B0); PG8_BAR; PG8_SCHED;
            PG8_LDB(B1, 0, 1); PG8_STAGE(PG8_SB(0, 0), b2, voffB);
            PG8_BAR; PG8_WAIT_L(0); PG8_MMA(0, 1, At, B1); PG8_BAR;
            PG8_LDA(At, 0, 1); PG8_STAGE(PG8_SA(0, 0), a2, voffA);
            PG8_BAR; PG8_WAIT_L(0); PG8_MMA(1, 0, At, B0); PG8_BAR; PG8_SCHED;
            PG8_STAGE(PG8_SB(0, 1), b2 + hstep, voffB);
            PG8_WAIT_V(6); PG8_BAR; PG8_MMA(1, 1, At, B1); PG8_BAR;
            PG8_LDB(B0, 1, 0); PG8_SCHED; PG8_LDA(At, 1, 0); PG8_STAGE(PG8_SA(0, 1), a2 + hstep, voffA);
            PG8_WAIT_L(8); PG8_BAR; PG8_WAIT_L(0); PG8_MMA(0, 0, At, B0); PG8_BAR; PG8_SCHED;
            PG8_LDB(B1, 1, 1); PG8_STAGE(PG8_SB(1, 0), b3, voffB);
            PG8_BAR; PG8_WAIT_L(0); PG8_MMA(0, 1, At, B1); PG8_BAR;
            PG8_LDA(At, 1, 1); PG8_STAGE(PG8_SA(1, 0), a3, voffA);
            PG8_BAR; PG8_WAIT_L(0); PG8_MMA(1, 0, At, B0); PG8_BAR; PG8_SCHED;
            PG8_STAGE(PG8_SB(1, 1), b3 + hstep, voffB);
            PG8_WAIT_V(6); PG8_BAR; PG8_MMA(1, 1, At, B1); PG8_BAR;
            }
        }
        if constexpr (ALIGN_EPI) { if (wr == 0) PG8_BAR; }
        if constexpr (!Epi::AFTER_DRAIN) { E(acc, cur, wr, wc, fr, fq); S.done(cur); }
        if (!has_next) break;
#pragma unroll
        for (int a = 0; a < 2; ++a)
#pragma unroll
            for (int b = 0; b < 2; ++b)
#pragma unroll
                for (int m = 0; m < 4; ++m)
#pragma unroll
                    for (int n = 0; n < 2; ++n) acc[a][b][m][n] = (f32x4){0.f, 0.f, 0.f, 0.f};
        cur = nxt; cA = nA; cB = nB; ++ui;
        if constexpr (ALIGN_EPI) { if (wr == 1) PG8_BAR; }
    }
    PG8_WAIT_V(0);
    if constexpr (!ALIGN_EPI) { if (wr == 0) PG8_BAR; }
    PG8_BAR;
    if constexpr (Epi::AFTER_DRAIN) { E.fused(acc, cur, wr, wc, fr, fq, lds, wid, lane); S.done(cur); }
#undef PG8_SA
#undef PG8_SB
#undef PG8_STAGE
#undef PG8_LDA
#undef PG8_LDB
#undef PG8_MMA
#undef PG8_WAIT_V
#undef PG8_WAIT_L
#undef PG8_BAR
#undef PG8_SCHED
}
struct Unit2 { int pm, pn, l, cnt, split; unsigned hb; };
template <class Epi, class Sched, bool ALIGN_EPI>
__device__ __forceinline__ void gemm_phase2(PG8_LAS unsigned char* lds, const int K, const Sched& S, const Epi& E, PG8_LAS unsigned char* aux  ) {
    int tid_ = threadIdx.x; asm volatile("" : "+v"(tid_));
    const int tid = tid_, wid = __builtin_amdgcn_readfirstlane(tid >> 6), lane = tid & 63, wr = wid >> 2, wc = wid & 3, fr = lane & 15, fq = lane >> 4;
    const int nt = K / BK;
    int Rr[2], Cc[2]; unsigned voffB[2];
#pragma unroll
    for (int i = 0; i < 2; ++i) { int R, C; stage_rc(tid * 16 + i * 8192, R, C); const int Rb = Epi::PERM ? ((R & ~31) + perm32(R & 31)) : R; Rr[i] = R; Cc[i] = C; voffB[i] = (unsigned)(Rb * K + C) * 2u; }
    const size_t kstep = (size_t)(BK * 2);
    const size_t hstep = (size_t)HALF * K * 2;
    const unsigned ldsw = (unsigned)wid * 1024u;
    const int aoff = lds_byte(wr * 64 + fr, fq * 8), boff = lds_byte(wc * 32 + fr, fq * 8);
#define PG8_SA(b, h) (((b) * 2 + (h)) * HTB)
#define PG8_SB(b, h) ((4 + (b) * 2 + (h)) * HTB)
#define PG8_STAGE(bufoff, gbase, voff) do { _Pragma("unroll") for (int _i = 0; _i < 2; ++_i) \
        __builtin_amdgcn_global_load_lds((const unsigned*)((const char*)(gbase) + (voff)[_i]), (PG8_LAS unsigned*)(lds + (bufoff) + ldsw + _i * 8192), 16, 0, 0); } while (0)
#define PG8_STAGEA(bufoff, o0, o1, kb) do { \
        __builtin_amdgcn_global_load_lds((const unsigned*)(Abase + (size_t)(o0) + (kb)), (PG8_LAS unsigned*)(lds + (bufoff) + ldsw), 16, 0, 0); \
        __builtin_amdgcn_global_load_lds((const unsigned*)(Abase + (size_t)(o1) + (kb)), (PG8_LAS unsigned*)(lds + (bufoff) + ldsw + 8192), 16, 0, 0); } while (0)
#define PG8_LDA(dst, b, h) do { _Pragma("unroll") for (int m = 0; m < 4; ++m) _Pragma("unroll") for (int k = 0; k < 2; ++k) dst[m][k] = *(const PG8_LAS bf16x8*)(lds + PG8_SA(b, h) + aoff + m * 2048 + k * 1024); } while (0)
#define PG8_LDB(dst, b, h) do { _Pragma("unroll") for (int n = 0; n < 2; ++n) _Pragma("unroll") for (int k = 0; k < 2; ++k) dst[n][k] = *(const PG8_LAS bf16x8*)(lds + PG8_SB(b, h) + boff + n * 2048 + k * 1024); } while (0)
#define PG8_MMA(ai, bj, At, Bt) do { __builtin_amdgcn_s_setprio(1); _Pragma("unroll") for (int m = 0; m < 4; ++m) _Pragma("unroll") for (int n = 0; n < 2; ++n) _Pragma("unroll") for (int k = 0; k < 2; ++k) \
        acc[ai][bj][m][n] = __builtin_amdgcn_mfma_f32_16x16x32_bf16(Bt[n][k], At[m][k], acc[ai][bj][m][n], 0, 0, 0); __builtin_amdgcn_s_setprio(0); } while (0)
#define PG8_WAIT_V(n) asm volatile("s_waitcnt vmcnt(" #n ")" ::: "memory")
#define PG8_WAIT_L(n) asm volatile("s_waitcnt lgkmcnt(" #n ")" ::: "memory")
#define PG8_BAR __builtin_amdgcn_s_barrier()
#define PG8_SCHED __builtin_amdgcn_sched_barrier(0)
    Unit2 cur, nxt; int ui = 0;
    if (!S.next(0, cur)) return;
    f32x4 acc[2][2][4][2];
#pragma unroll
    for (int a = 0; a < 2; ++a)
#pragma unroll
        for (int b = 0; b < 2; ++b)
#pragma unroll
            for (int m = 0; m < 4; ++m)
#pragma unroll
                for (int n = 0; n < 2; ++n) acc[a][b][m][n] = (f32x4){0.f, 0.f, 0.f, 0.f};
    bf16x8 At[4][2], B0[2][2], B1[2][2];
    const char* Abase = (const char*)S.abase();
    unsigned cAo[4], nAo[4];
    S.aoffs(cur, Rr, Cc, cAo);
    const char* cB = (const char*)S.bptr(cur);
    typename Epi::Pre pre = E.pre(cur, wr, lane);
    PG8_STAGE(PG8_SB(0, 0), cB, voffB); PG8_STAGE(PG8_SB(0, 1), cB + hstep, voffB); PG8_STAGEA(PG8_SA(0, 0), cAo[0], cAo[1], 0); PG8_STAGEA(PG8_SA(0, 1), cAo[2], cAo[3], 0);
    if (wr == 1) PG8_BAR;
    PG8_WAIT_V(2); PG8_BAR;
    PG8_STAGE(PG8_SB(1, 0), cB + kstep, voffB); PG8_STAGEA(PG8_SA(1, 0), cAo[0], cAo[1], kstep); PG8_STAGE(PG8_SB(1, 1), cB + hstep + kstep, voffB);
    PG8_WAIT_V(6); PG8_BAR;
    for (;;) {
        const bool has_next = S.next(ui + 1, nxt);
        if (has_next) S.aoffs(nxt, Rr, Cc, nAo); else { nAo[0] = cAo[0]; nAo[1] = cAo[1]; nAo[2] = cAo[2]; nAo[3] = cAo[3]; }
        const char* nB = has_next ? (const char*)S.bptr(nxt) : cB;
        for (int t = 0; t < nt; t += 2) {
            const bool last = (t == nt - 2);
            const size_t k1 = (size_t)(t + 1) * kstep;
            const size_t k2 = last ? 0 : (size_t)(t + 2) * kstep, k3 = k2 + kstep;
            const char* b2 = last ? nB : cB + (size_t)(t + 2) * kstep; const char* b3 = b2 + kstep;
            const unsigned a20 = last ? nAo[0] : cAo[0], a21 = last ? nAo[1] : cAo[1], a22 = last ? nAo[2] : cAo[2], a23 = last ? nAo[3] : cAo[3];
            PG8_LDB(B0, 0, 0); PG8_LDB(B1, 0, 1); PG8_SCHED; PG8_LDA(At, 0, 0); PG8_STAGEA(PG8_SA(1, 1), cAo[2], cAo[3], k1);
            PG8_WAIT_V(8); PG8_WAIT_L(0); PG8_BAR; PG8_MMA(0, 0, At, B0); PG8_MMA(0, 1, At, B1); PG8_BAR; PG8_SCHED;
            PG8_LDA(At, 0, 1); PG8_STAGE(PG8_SB(0, 0), b2, voffB); PG8_STAGE(PG8_SB(0, 1), b2 + hstep, voffB); PG8_STAGEA(PG8_SA(0, 0), a20, a21, k2);
            PG8_WAIT_V(8); PG8_WAIT_L(0); PG8_BAR; PG8_MMA(1, 0, At, B0); PG8_MMA(1, 1, At, B1); PG8_BAR; PG8_SCHED;
            PG8_LDB(B0, 1, 0); PG8_LDB(B1, 1, 1); PG8_SCHED; PG8_LDA(At, 1, 0); PG8_STAGEA(PG8_SA(0, 1), a22, a23, k2);
            PG8_WAIT_V(8); PG8_WAIT_L(0); PG8_BAR; PG8_MMA(0, 0, At, B0); PG8_MMA(0, 1, At, B1); PG8_BAR; PG8_SCHED;
            PG8_LDA(At, 1, 1); PG8_STAGE(PG8_SB(1, 0), b3, voffB); PG8_STAGE(PG8_SB(1, 1), b3 + hstep, voffB); PG8_STAGEA(PG8_SA(1, 0), a20, a21, k3);
            PG8_WAIT_V(8); PG8_WAIT_L(0); PG8_BAR; PG8_MMA(1, 0, At, B0); PG8_MMA(1, 1, At, B1); PG8_BAR; PG8_SCHED;
        }
        if constexpr (ALIGN_EPI) { if (wr == 0) PG8_BAR; }
        E(acc, cur, wr, wc, fr, fq, pre, aux + wid * 1024, lane);
        if (!has_next) break;
#pragma unroll
        for (int a = 0; a < 2; ++a)
#pragma unroll
            for (int b = 0; b < 2; ++b)
#pragma unroll
                for (int m = 0; m < 4; ++m)
#pragma unroll
                    for (int n = 0; n < 2; ++n) acc[a][b][m][n] = (f32x4){0.f, 0.f, 0.f, 0.f};
        cur = nxt; pre = E.pre(cur, wr, lane); cB = nB; cAo[0] = nAo[0]; cAo[1] = nAo[1]; cAo[2] = nAo[2]; cAo[3] = nAo[3]; ++ui;
        if constexpr (ALIGN_EPI) { if (wr == 1) PG8_BAR; }
    }
    PG8_WAIT_V(0);
    if constexpr (!ALIGN_EPI) { if (wr == 0) PG8_BAR; }
    PG8_BAR;
#undef PG8_SA
#undef PG8_SB
#undef PG8_STAGE
#undef PG8_STAGEA
#undef PG8_LDA
#undef PG8_LDB
#undef PG8_MMA
#undef PG8_WAIT_V
#undef PG8_WAIT_L
#undef PG8_BAR
#undef PG8_SCHED
}
struct MoeSched {
    const PG8_LAS unsigned* tb;
    const PG8_LAS unsigned* cntL;
    const PG8_LAS unsigned* hbL;
    int nl, lmul, ladd;
    int nN, G, c, K;
    const void* Abase_; const bf16_t* Bbase; size_t bstride;
    int merged;
    const unsigned* LIST; int mode;
    PG8_LAS int* ut;
    __device__ __forceinline__ void build_table() const {
        if (threadIdx.x < 32) { Unit2 u; const bool ok = search((int)threadIdx.x, u); PG8_LAS int* p = ut + 8 * threadIdx.x;
            p[0] = ok ? 1 : 0; p[1] = u.pm; p[2] = u.pn; p[3] = u.l; p[4] = u.cnt; p[5] = u.split; p[6] = (int)u.hb; }
    }
    __device__ __forceinline__ bool next(int i, Unit2& u) const {
        if (i < 32) { const PG8_LAS int* p = ut + 8 * i; if (p[0] == 0) return false; u.pm = p[1]; u.pn = p[2]; u.l = p[3]; u.cnt = p[4]; u.split = p[5]; u.hb = (unsigned)p[6]; return true; }
        return search(i, u);
    }
    __device__ __forceinline__ bool search(int i, Unit2& u) const {
        u.pm = 0; u.pn = 0; u.l = 0; u.cnt = 0; u.split = 0; u.hb = 0u;
        const unsigned total = tb[nl] * (unsigned)nN; const unsigned Lx = (unsigned)i * (unsigned)G + (unsigned)c; if (Lx >= total) return false;
        const unsigned rt = Lx / (unsigned)nN; u.pn = (int)(Lx % (unsigned)nN);
        int lo = 0, hi = nl;
        while (hi - lo > 1) { const int mid = (lo + hi) >> 1; if (tb[mid] <= rt) lo = mid; else hi = mid; }
        u.pm = (int)(rt - tb[lo]);
        if (merged) { if (lo < 64) { u.l = 2 * lo; const int c0 = (int)cntL[2 * lo]; u.split = c0; u.cnt = c0 + (int)cntL[2 * lo + 1]; u.hb = hbL[2 * lo]; } else { u.l = 128; u.cnt = (int)cntL[128]; u.split = u.cnt; u.hb = 0u; } }
        else { u.l = lo * lmul + ladd; u.cnt = (int)cntL[u.l]; u.split = u.cnt; u.hb = hbL[u.l]; }
        return true;
    }
    __device__ __forceinline__ const void* abase() const { return Abase_; }
    __device__ __forceinline__ const bf16_t* bptr(const Unit2& u) const { const int e = (u.l < 128) ? (u.l >> 1) : 64; return Bbase + (size_t)e * bstride + (size_t)u.pn * 256 * K; }
    __device__ __forceinline__ void aoffs(const Unit2& u, const int (&Rr)[2], const int (&Cc)[2], unsigned (&o)[4]) const {
#pragma unroll
        for (int h = 0; h < 2; ++h)
#pragma unroll
            for (int i = 0; i < 2; ++i) {
                const int p = u.pm * 256 + h * 128 + Rr[i]; unsigned row;
                if (mode == 0) { if (u.l == 128) row = (unsigned)p; else { const int pp = p < u.cnt ? p : 0; row = LIST[pp < u.split ? (size_t)u.l * 16384 + pp : (size_t)(u.l + 1) * 16384 + (pp - u.split)] >> 3; } }
                else row = u.hb + (unsigned)p;
                o[h * 2 + i] = row * (unsigned)(K * 2) + (unsigned)(Cc[i] * 2);
            }
    }
};
typedef float f32x2m __attribute__((ext_vector_type(2)));
struct EpiMoe1 {
    static constexpr bool PERM = true, AFTER_DRAIN = false;
    const f32x2m* META; const float* RINV; bf16_t* H; bf16_t* HS;
    struct Pre { f32x2m r0, r1; };
    __device__ __forceinline__ Pre pre(const Unit2& u, int wr, int lane) const {
        Pre p; const int p0 = u.pm * 256 + wr * 64 + lane, p1 = p0 + HALF;
        if (u.l == 128) { p.r0 = (f32x2m){RINV[p0], 1.f}; p.r1 = (f32x2m){RINV[p1], 1.f}; }
        else { const int q0 = p0 < u.cnt ? p0 : 0, q1 = p1 < u.cnt ? p1 : 0;
            p.r0 = META[q0 < u.split ? (size_t)u.l * 16384 + q0 : (size_t)(u.l + 1) * 16384 + (q0 - u.split)]; p.r1 = META[q1 < u.split ? (size_t)u.l * 16384 + q1 : (size_t)(u.l + 1) * 16384 + (q1 - u.split)]; }
        return p;
    }
    __device__ __forceinline__ void operator()(const f32x4 (&acc)[2][2][4][2], const Unit2& u, int wr, int wc, int fr, int fq, const Pre& pr, PG8_LAS unsigned char* aux, int lane) const {
        PG8_LAS f32x2m* slot = (PG8_LAS f32x2m*)aux;
        slot[lane] = pr.r0; slot[64 + lane] = pr.r1;
        asm volatile("s_waitcnt lgkmcnt(0)" ::: "memory");
        const int col = u.pn * 128 + wc * 32 + 8 * fq;
#pragma unroll
        for (int ai = 0; ai < 2; ++ai)
#pragma unroll
            for (int m = 0; m < 4; ++m) {
                const int p = u.pm * 256 + ai * HALF + wr * 64 + m * 16 + fr;
                if (p < u.cnt) {
                    const f32x2m mr = slot[ai * 64 + m * 16 + fr]; const float ri = mr.x, gw = mr.y;
                    bf16_t* dst = (u.l == 128) ? HS + (size_t)p * 256 + col : H + ((size_t)u.hb + p) * 256 + col;
                    float hv[8];
#pragma unroll
                    for (int n = 0; n < 2; ++n)
#pragma unroll
                        for (int i = 0; i < 4; ++i) { const float g = acc[ai][0][m][n][i] * ri, uu = acc[ai][1][m][n][i] * ri;
                            hv[n * 4 + i] = g * __builtin_amdgcn_rcpf(1.f + __builtin_amdgcn_exp2f(-1.4426950408889634f * g)) * uu * gw; }
                    u32x4 w; w.x = cvtc(hv[0], hv[1]); w.y = cvtc(hv[2], hv[3]); w.z = cvtc(hv[4], hv[5]); w.w = cvtc(hv[6], hv[7]);
                    *(u32x4*)dst = w;
                }
                asm volatile("" ::: "memory");
            }
        asm volatile("s_waitcnt lgkmcnt(0)" ::: "memory");
    }
};
struct EpiMoe2 {
    static constexpr bool PERM = true, AFTER_DRAIN = false;
    unsigned char* Y8;
    struct Pre { int dummy; };
    __device__ __forceinline__ Pre pre(const Unit2&, int, int) const { return Pre{0}; }
    __device__ __forceinline__ void operator()(const f32x4 (&acc)[2][2][4][2], const Unit2& u, int wr, int wc, int fr, int fq, const Pre&, PG8_LAS unsigned char*, int) const {
        const unsigned cofs = (unsigned)(u.pn * 256 + (wc * 4 + fq) * 16);
#pragma unroll
        for (int ai = 0; ai < 2; ++ai)
#pragma unroll
            for (int m = 0; m < 4; ++m) {
                const int p = u.pm * 256 + ai * HALF + wr * 64 + m * 16 + fr;
                if (p < u.cnt) {
                    int w[4];
#pragma unroll
                    for (int bj = 0; bj < 2; ++bj) { f32x4 a0 = acc[ai][bj][m][0] * 16.f, a1 = acc[ai][bj][m][1] * 16.f;
#pragma unroll
                        for (int i = 0; i < 4; ++i) { a0[i] = __builtin_amdgcn_fmed3f(a0[i], -440.f, 440.f); a1[i] = __builtin_amdgcn_fmed3f(a1[i], -440.f, 440.f); }
                        int w0 = __builtin_amdgcn_cvt_pk_fp8_f32(a0[0], a0[1], 0, false); w0 = __builtin_amdgcn_cvt_pk_fp8_f32(a0[2], a0[3], w0, true);
                        int w1 = __builtin_amdgcn_cvt_pk_fp8_f32(a1[0], a1[1], 0, false); w1 = __builtin_amdgcn_cvt_pk_fp8_f32(a1[2], a1[3], w1, true);
                        w[2 * bj] = w0; w[2 * bj + 1] = w1; }
                    *(u32x4*)(Y8 + ((u.hb + (unsigned)p) * 1024u + cofs)) = (u32x4){(unsigned)w[0], (unsigned)w[1], (unsigned)w[2], (unsigned)w[3]};
                }
            }
    }
};
struct EpiFinal {
    static constexpr bool PERM = true, AFTER_DRAIN = false;
    const unsigned char* Y8; const unsigned* INV; const PG8_LAS unsigned* hbL; const float* Oin; float* O;
    struct Pre { int dummy; };
    __device__ __forceinline__ Pre pre(const Unit2&, int, int) const { return Pre{0}; }
    __device__ __forceinline__ void operator()(const f32x4 (&acc)[2][2][4][2], const Unit2& u, int wr, int wc, int fr, int fq, const Pre&, PG8_LAS unsigned char*, int) const {
        typedef float f32x2v __attribute__((ext_vector_type(2)));
        const unsigned col = (unsigned)(u.pn * 256 + wc * 64 + 8 * fq), cofs = (unsigned)(u.pn * 256 + (wc * 4 + fq) * 16);
#pragma unroll
        for (int ai = 0; ai < 2; ++ai)
#pragma unroll
            for (int m = 0; m < 4; ++m) {
                const unsigned row = (unsigned)(u.pm * 256 + ai * HALF + wr * 64 + m * 16 + fr);
                const u32x4 iv0 = *(const u32x4*)(INV + row * 8u), iv1 = *(const u32x4*)(INV + row * 8u + 4u);
                const unsigned iv[8] = {iv0.x, iv0.y, iv0.z, iv0.w, iv1.x, iv1.y, iv1.z, iv1.w};
                unsigned yo[8];
#pragma unroll
                for (int j = 0; j < 8; ++j) yo[j] = (hbL[iv[j] >> 16] + (iv[j] & 0xffffu)) * 1024u + cofs;
#pragma unroll
                for (int bj = 0; bj < 2; ++bj) {
                    typedef unsigned u32x2g __attribute__((ext_vector_type(2)));
                    u32x2g t[8];
#pragma unroll
                    for (int j = 0; j < 8; ++j) t[j] = *(const u32x2g*)(Y8 + (yo[j] + bj * 8u));
                    const f32x4 x0 = *(const f32x4*)(Oin + (row * 1024u + col + bj * 32)), x1 = *(const f32x4*)(Oin + (row * 1024u + col + bj * 32 + 4));
                    f32x4 s0 = (f32x4){0.f, 0.f, 0.f, 0.f}, s1 = (f32x4){0.f, 0.f, 0.f, 0.f};
#pragma unroll
                    for (int j = 0; j < 8; ++j) { const f32x2v p0 = __builtin_amdgcn_cvt_pk_f32_fp8((int)t[j].x, false), p1 = __builtin_amdgcn_cvt_pk_f32_fp8((int)t[j].x, true),
                                                               p2 = __builtin_amdgcn_cvt_pk_f32_fp8((int)t[j].y, false), p3 = __builtin_amdgcn_cvt_pk_f32_fp8((int)t[j].y, true);
                        s0[0] += p0.x; s0[1] += p0.y; s0[2] += p1.x; s0[3] += p1.y; s1[0] += p2.x; s1[1] += p2.y; s1[2] += p3.x; s1[3] += p3.y; }
                    float* op = O + (row * 1024u + col + bj * 32);
                    *(f32x4*)op = x0 + acc[ai][bj][m][0] + s0 * 0.0625f; *(f32x4*)(op + 4) = x1 + acc[ai][bj][m][1] + s1 * 0.0625f;
                    asm volatile("" ::: "memory");
                }
                asm volatile("" ::: "memory");
            }
    }
};
struct EpiFinalD {
    static constexpr bool PERM = true, AFTER_DRAIN = true;
    const unsigned char* Y8; const unsigned* INV; const PG8_LAS unsigned* hbL; const float* Oin; float* O;
    __device__ __forceinline__ void fused(const f32x4 (&acc)[2][2][4][2], const Unit& u, int wr, int wc, int fr, int fq, PG8_LAS unsigned char*, int, int) const {
        typedef float f32x2v __attribute__((ext_vector_type(2)));
        const unsigned col = (unsigned)(u.pn * 256 + wc * 64 + 8 * fq), cofs = (unsigned)(u.pn * 256 + (wc * 4 + fq) * 16);
#pragma unroll
        for (int ai = 0; ai < 2; ++ai)
#pragma unroll
            for (int m = 0; m < 4; ++m) {
                const unsigned row = (unsigned)(u.pm * 256 + ai * HALF + wr * 64 + m * 16 + fr);
                const u32x4 iv0 = *(const u32x4*)(INV + row * 8u), iv1 = *(const u32x4*)(INV + row * 8u + 4u);
                const unsigned iv[8] = {iv0.x, iv0.y, iv0.z, iv0.w, iv1.x, iv1.y, iv1.z, iv1.w};
                f32x4 xr[2][2];
#pragma unroll
                for (int bj = 0; bj < 2; ++bj) { xr[bj][0] = *(const f32x4*)(Oin + (row * 1024u + col + bj * 32)); xr[bj][1] = *(const f32x4*)(Oin + (row * 1024u + col + bj * 32 + 4)); }
                f32x4 s[2][2];
#pragma unroll
                for (int bj = 0; bj < 2; ++bj) { s[bj][0] = (f32x4){0.f, 0.f, 0.f, 0.f}; s[bj][1] = (f32x4){0.f, 0.f, 0.f, 0.f}; }
#pragma unroll
                for (int jh = 0; jh < 2; ++jh) {
                    u32x4 t[4];
#pragma unroll
                    for (int j = 0; j < 4; ++j) { const unsigned ivv = iv[jh * 4 + j]; t[j] = *(const u32x4*)(Y8 + ((hbL[ivv >> 16] + (ivv & 0xffffu)) * 1024u + cofs)); }
#pragma unroll
                    for (int j = 0; j < 4; ++j) { const unsigned tw[4] = {t[j].x, t[j].y, t[j].z, t[j].w};
#pragma unroll
                        for (int bj = 0; bj < 2; ++bj) { const f32x2v p0 = __builtin_amdgcn_cvt_pk_f32_fp8((int)tw[2 * bj], false), p1 = __builtin_amdgcn_cvt_pk_f32_fp8((int)tw[2 * bj], true),
                                                                     p2 = __builtin_amdgcn_cvt_pk_f32_fp8((int)tw[2 * bj + 1], false), p3 = __builtin_amdgcn_cvt_pk_f32_fp8((int)tw[2 * bj + 1], true);
                            s[bj][0][0] += p0.x; s[bj][0][1] += p0.y; s[bj][0][2] += p1.x; s[bj][0][3] += p1.y; s[bj][1][0] += p2.x; s[bj][1][1] += p2.y; s[bj][1][2] += p3.x; s[bj][1][3] += p3.y; } }
                    asm volatile("" ::: "memory");
                }
#pragma unroll
                for (int bj = 0; bj < 2; ++bj) { float* op = O + (row * 1024u + col + bj * 32);
                    *(f32x4*)op = xr[bj][0] + acc[ai][bj][m][0] + s[bj][0] * 0.0625f; *(f32x4*)(op + 4) = xr[bj][1] + acc[ai][bj][m][1] + s[bj][1] * 0.0625f; }
                asm volatile("" ::: "memory");
            }
    }
};
}
#ifndef PG8_SP2
#define PG8_SP2 true
#endif
namespace fox {
using bf16=__hip_bfloat16;
using bf16x8=__attribute__((ext_vector_type(8)))short;
using s16x4=__attribute__((ext_vector_type(4)))short;
using f32x16=__attribute__((ext_vector_type(16)))float;
using u32x4=__attribute__((ext_vector_type(4)))unsigned;
constexpr int BATCH=2,NHEAD=8,SEQ=8192,D=64,DM=NHEAD*D;
constexpr int NW=8,QBLK=32,QB=QBLK*NW,KVBLK=64,NQB=SEQ/QB;
constexpr int ATTN_PITCH=DM, ATTN_UNIT_ROWS=QB;
__device__ __forceinline__ int crow(int r,int hi){return (r&3)+8*(r>>2)+4*hi;}
#define SBAR() __builtin_amdgcn_sched_barrier(0)
__device__ __forceinline__ void cmask(f32x16&p0,f32x16&p1,int jb,int qrel,int hi){
  const float NEG=-INFINITY; int kb=64*jb+4*hi;
  #pragma unroll
  for(int r=0;r<16;++r){int kv=kb+(r&3)+8*(r>>2); if(kv>qrel)p0[r]=NEG; if(kv+32>qrel)p1[r]=NEG;}
}

constexpr int NSLOT=3, SLOTB=9216, KAOFF=8192;
constexpr int LDS_K=0, LDS_V=NSLOT*SLOTB, LDS_WS=2*NSLOT*SLOTB, LDS_OST=LDS_WS+NW*64*4, LDS_BYTES=LDS_OST+NW*4096;
constexpr float C2=0.125f*1.4426950408889634f;
__device__ __forceinline__ void glds16(const void*gsrc,unsigned lds_dst){unsigned keep;
  asm volatile("s_mov_b32 %0, m0\n\ts_mov_b32 m0, %2\n\ts_nop 0\n\tglobal_load_lds_dwordx4 %1, off\n\ts_mov_b32 m0, %0":"=&s"(keep):"v"(gsrc),"s"(lds_dst):"memory");}
__device__ __forceinline__ float max3f(float a,float b,float c){float r;asm("v_max3_f32 %0, %1, %2, %3":"=v"(r):"v"(a),"v"(b),"v"(c));return r;}
__device__ __forceinline__ float max2f(float a,float b){float r;asm("v_max_f32_e32 %0, %1, %2":"=v"(r):"v"(a),"v"(b));return r;}
__device__ __forceinline__ float fadd_s(float a,float b){float r;asm("v_add_f32_e32 %0, %1, %2":"=v"(r):"v"(a),"v"(b));return r;}
__device__ __forceinline__ float fsub_s(float a,float b){float r;asm("v_sub_f32_e32 %0, %1, %2":"=v"(r):"v"(a),"v"(b));return r;}
typedef float f32x2_t __attribute__((ext_vector_type(2))); typedef __bf16 bf16x2_t __attribute__((ext_vector_type(2)));
__device__ __forceinline__ unsigned cvtpk_s(float lo,float hi){f32x2_t v={lo,hi};bf16x2_t b=__builtin_convertvector(v,bf16x2_t);return __builtin_bit_cast(unsigned,b);}
#define WAIT_BAR(N) asm volatile("s_waitcnt vmcnt(" #N ") lgkmcnt(0)\n\ts_barrier":::"memory")

__device__ __forceinline__ void qkt(f32x16&p0,f32x16&p1,const char*Kslot,const bf16x8*qr,const bf16x8 qa,int r32,int hi){
  const f32x16 z16=f32x16{};
  const char*kb=Kslot+hi*1024+r32*16;
  #pragma unroll
  for(int d0=0;d0<4;++d0){
    const bf16x8 b0=*reinterpret_cast<const bf16x8*>(kb+d0*2048);
    const bf16x8 b1=*reinterpret_cast<const bf16x8*>(kb+d0*2048+512);
    if(d0==0){p0=__builtin_amdgcn_mfma_f32_32x32x16_bf16(b0,qr[0],z16,0,0,0);p1=__builtin_amdgcn_mfma_f32_32x32x16_bf16(b1,qr[0],z16,0,0,0);}
    else{p0=__builtin_amdgcn_mfma_f32_32x32x16_bf16(b0,qr[d0],p0,0,0,0);p1=__builtin_amdgcn_mfma_f32_32x32x16_bf16(b1,qr[d0],p1,0,0,0);}}
  { const bf16x8 a0=*reinterpret_cast<const bf16x8*>(Kslot+KAOFF+r32*16); const bf16x8 a1=*reinterpret_cast<const bf16x8*>(Kslot+KAOFF+r32*16+512);
    p0=__builtin_amdgcn_mfma_f32_32x32x16_bf16(a0,qa,p0,0,0,0);p1=__builtin_amdgcn_mfma_f32_32x32x16_bf16(a1,qa,p1,0,0,0); }
}
typedef __attribute__((address_space(3))) const char* lds_cptr;
typedef short v4i16_t __attribute__((ext_vector_type(4)));
__device__ __forceinline__ void kload8(bf16x8*kf,lds_cptr kp){
  kf[0]=*(const __attribute__((address_space(3))) bf16x8*)(kp);      kf[1]=*(const __attribute__((address_space(3))) bf16x8*)(kp+512);
  kf[2]=*(const __attribute__((address_space(3))) bf16x8*)(kp+2048); kf[3]=*(const __attribute__((address_space(3))) bf16x8*)(kp+2560);
  kf[4]=*(const __attribute__((address_space(3))) bf16x8*)(kp+4096); kf[5]=*(const __attribute__((address_space(3))) bf16x8*)(kp+4608);
  kf[6]=*(const __attribute__((address_space(3))) bf16x8*)(kp+6144); kf[7]=*(const __attribute__((address_space(3))) bf16x8*)(kp+6656);
}
__device__ __forceinline__ void kload2(bf16x8*kf,lds_cptr kp,int j){ kf[2*j]=*(const __attribute__((address_space(3))) bf16x8*)(kp+j*2048); kf[2*j+1]=*(const __attribute__((address_space(3))) bf16x8*)(kp+j*2048+512); }
__device__ __forceinline__ s16x4 vtr(lds_cptr p){ return __builtin_bit_cast(s16x4,__builtin_amdgcn_ds_read_tr16_b64_v4i16((__attribute__((address_space(3))) v4i16_t*)p)); }
__device__ __forceinline__ float rowmax(const f32x16&p0,const f32x16&p1){
  float a=max3f(p0[0],p0[1],p1[0]),b=max3f(p0[2],p0[3],p1[1]);a=max3f(a,p1[2],p1[3]);
  #pragma unroll
  for(int r=4;r<16;r+=4){a=max3f(a,p0[r],p0[r+1]);b=max3f(b,p0[r+2],p0[r+3]);a=max3f(a,p1[r],p1[r+1]);b=max3f(b,p1[r+2],p1[r+3]);}
  const float m=max2f(a,b);
  auto rr=__builtin_amdgcn_permlane32_swap(__float_as_uint(m),__float_as_uint(m),false,false);
  return max2f(__uint_as_float(rr[0]),__uint_as_float(rr[1]));
}
__device__ __forceinline__ void pv(f32x16*o,int vb,bf16x8 pa0,bf16x8 pa1,bf16x8 pa2,bf16x8 pa3){
  #pragma unroll
  for(int d0=0;d0<2;++d0){s16x4 lo[4],hi[4];
    #pragma unroll
    for(int ks=0;ks<4;++ks){
      asm volatile("ds_read_b64_tr_b16 %0,%1 offset:%c2":"=&v"(lo[ks]):"v"(vb),"i"(d0*4096+ks*1024):"memory");
      asm volatile("ds_read_b64_tr_b16 %0,%1 offset:%c2":"=&v"(hi[ks]):"v"(vb),"i"(d0*4096+ks*1024+512):"memory");}
    asm volatile("s_waitcnt lgkmcnt(0)":::"memory");SBAR();
    #define PK(k) (bf16x8){lo[k][0],lo[k][1],lo[k][2],lo[k][3],hi[k][0],hi[k][1],hi[k][2],hi[k][3]}
    o[d0]=__builtin_amdgcn_mfma_f32_32x32x16_bf16(pa0,PK(0),o[d0],0,0,0);
    o[d0]=__builtin_amdgcn_mfma_f32_32x32x16_bf16(pa1,PK(1),o[d0],0,0,0);
    o[d0]=__builtin_amdgcn_mfma_f32_32x32x16_bf16(pa2,PK(2),o[d0],0,0,0);
    o[d0]=__builtin_amdgcn_mfma_f32_32x32x16_bf16(pa3,PK(3),o[d0],0,0,0);
    #undef PK
  }
}

#ifndef ATTN_STORE16
#define ATTN_STORE16(p,v) (*(u32x4*)(p)=(v))
#endif
template<int THRL> __device__ __forceinline__ void attn_unit(int b,int h,int qb,int T0,const bf16*Q,const bf16*__restrict__ K,const bf16*__restrict__ V,const bf16*__restrict__ KA,const float*__restrict__ Cbh,bf16*O,char*shm){
  int tid_=threadIdx.x; asm volatile("":"+v"(tid_));
  const int tid=tid_,lane=tid&63,r32=lane&31,hi=lane>>5; const int wid=__builtin_amdgcn_readfirstlane(tid>>6);
  const long rowbase=(long)b*SEQ; const int q0=qb*QB;
  const bf16*Qw=Q+(rowbase+q0+wid*QBLK)*DM+h*D;
  const bf16*Kh=K+(rowbase+(long)T0*KVBLK)*DM+h*D,*Vh=V+(rowbase+(long)T0*KVBLK)*DM+h*D;
  const bf16*kasrc=KA+((rowbase+(long)T0*KVBLK+lane)*NHEAD+h)*8;
  const unsigned lds0=(unsigned)(uintptr_t)shm;
  float*wsf=(float*)(shm+LDS_WS)+wid*64;
  const bf16*ksrc=Kh+(long)lane*DM+wid*8;
  const bf16*vsrc=Vh+(long)(16*(wid&3)+(lane>>2))*DM+(wid>>2)*32+(lane&3)*8;
  const unsigned kdst=lds0+LDS_K+wid*1024, vdst=lds0+LDS_V+wid*1024;
  #define DMA_K(t,slot) glds16(ksrc+(long)(t)*KVBLK*DM,(unsigned)__builtin_amdgcn_readfirstlane(kdst+(slot)))
  #define DMA_V(t,slot) glds16(vsrc+(long)(t)*KVBLK*DM,(unsigned)__builtin_amdgcn_readfirstlane(vdst+(slot)))
  #define DMA_KA(t,slot) do{ if(wid==0) glds16(kasrc+(long)(t)*KVBLK*NHEAD*8,(unsigned)__builtin_amdgcn_readfirstlane(lds0+LDS_K+KAOFF+(slot))); }while(0)
  const int vb0=(int)(lds0+LDS_V)+((lane>>4)&1)*32+(lane&3)*8+(4*hi+((lane&15)>>2))*64;
  const char*Kbase=shm+LDS_K; bf16x8 kf[8],kfa[2];
  const lds_cptr shm3=(lds_cptr)shm; const lds_cptr kpa=shm3+LDS_K+KAOFF+r32*16; const lds_cptr kp0=shm3+LDS_K+hi*1024+r32*16;
  #define KALOAD(sl) do{ kfa[0]=*(const __attribute__((address_space(3))) bf16x8*)(kpa+(sl)); kfa[1]=*(const __attribute__((address_space(3))) bf16x8*)(kpa+(sl)+512); }while(0)
  const lds_cptr vp0=shm3+LDS_V+((lane>>4)&1)*32+(lane&3)*8+(4*hi+((lane&15)>>2))*64;
  const int NT=(q0+QB)/KVBLK-T0;
  DMA_KA(0,0);DMA_KA(1,SLOTB);DMA_KA(2,2*SLOTB);
  DMA_K(0,0);DMA_V(0,0);DMA_K(1,SLOTB);
  bf16x8 qr[4];
  #pragma unroll
  for(int d0=0;d0<4;++d0)qr[d0]=*reinterpret_cast<const bf16x8*>(&Qw[(long)r32*DM+d0*16+hi*8]);
  const float ct2=Cbh[q0+wid*QBLK+r32]*1.4426950408889634f;
  float mhat=0.f,l_reg=0.f;f32x16 o[2];o[0]=f32x16{};o[1]=f32x16{};u32x4 qaw;
  #define QA_REBUILD() do{ const float a_=ct2-mhat; const unsigned p0_=cvtpk_s(a_,0.f)&0xffffu; const float r1_=a_-__uint_as_float(p0_<<16); const unsigned p1_=cvtpk_s(r1_,0.f)&0xffffu; \
      const float r2_=r1_-__uint_as_float(p1_<<16); const unsigned p2_=cvtpk_s(r2_,0.f)&0xffffu; \
      qaw=hi?(u32x4){0u,0u,0u,0u}:(u32x4){0x3F803F80u,0x3F80u|(p0_<<16),p1_|(p2_<<16),0u}; asm volatile("":"+v"(qaw)); }while(0)
  #define QAF __builtin_bit_cast(bf16x8,qaw)
  QA_REBUILD();
  const int qrel=wid*QBLK+r32;
  #define CMASK(P0,P1,t) do{int jb_=(t)-(NT-4); if(jb_>=0)cmask(P0,P1,jb_,qrel,hi);}while(0)
  bool resc=false;
  #define START(P0,P1) do{ const float rm=rowmax(P0,P1); resc=false; \
    { const float dl=rm; mhat=fadd_s(mhat,dl); \
      _Pragma("unroll") for(int r=0;r<16;++r){P0[r]=fsub_s(P0[r],dl);P1[r]=fsub_s(P1[r],dl);} \
      QA_REBUILD(); } \
    _Pragma("unroll") for(int r=0;r<16;++r)P0[r]=__builtin_amdgcn_exp2f(P0[r]); }while(0)
  #define RESC() do{ if(resc){ asm volatile("s_waitcnt lgkmcnt(0)":::"memory"); \
      _Pragma("unroll") for(int d_=0;d_<2;++d_) _Pragma("unroll") for(int r=0;r<16;++r)o[d_][r]*=wsf[crow(r,hi)]; } }while(0)
  f32x16 pA0,pA1,pB0,pB1;
  int sl_prev=0,sl_cur=0,sl_next=SLOTB;
  #define ROT() do{sl_prev=sl_cur;sl_cur=sl_next;sl_next=(sl_next==(NSLOT-1)*SLOTB)?0:sl_next+SLOTB;}while(0)
  DMA_K(2,2*SLOTB);
  WAIT_BAR(3);
  qkt(pA0,pA1,Kbase,qr,QAF,r32,hi);asm volatile("s_nop 15\n\ts_nop 7":"+v"(pA0),"+v"(pA1));CMASK(pA0,pA1,0);
  START(pA0,pA1);
  _Pragma("unroll") for(int r=0;r<16;++r)pA1[r]=__builtin_amdgcn_exp2f(pA1[r]);
  WAIT_BAR(0);
  DMA_KA(3,0);DMA_K(3,0);DMA_V(1,SLOTB);
  ROT();
  kload8(kf,kp0+sl_cur); KALOAD(sl_cur);
  WAIT_BAR(2);
  s16x4 vlo[8],vhi[8]; u32x4 pw0,pw1,pw2,pw3;
  #define PKW(P,B) cvtpk_s(P[B],P[B+1])
  #define PAF(k) __builtin_bit_cast(bf16x8,pw##k)
  #define VFR(i) (bf16x8){vlo[i][0],vlo[i][1],vlo[i][2],vlo[i][3],vhi[i][0],vhi[i][1],vhi[i][2],vhi[i][3]}
  #define PIN(x) asm volatile("":"+v"(x))
  #define MX3(a,b,c) __builtin_fmaxf(__builtin_fmaxf((a),(b)),(c))
  #define GAPA(MF,A0,A1,A2,A3,W0,W1,PW) do{ MF; sacc+=A0; sacc+=A1; sacc+=A2; sacc+=A3; PIN(sacc); W0; W1; PIN(PW); SBAR(); }while(0)
  #define EX(v) __builtin_amdgcn_exp2f(v)
  #define GAPB(MF,X,B) do{ MF; X[B]=EX(X[B]); X[B+1]=EX(X[B+1]); X[B+2]=EX(X[B+2]); X[B+3]=EX(X[B+3]); PIN(X); SBAR(); }while(0)
  #define VRD(i) do{ vlo[i]=vtr(vp_+(((i)>>2)*4096+((i)&3)*1024)); vhi[i]=vtr(vp_+(((i)>>2)*4096+((i)&3)*1024+512)); }while(0)
  #define KRD(G,j) do{ if(G){ kload2(kf,kp0+sl_next,j); SBAR(); } }while(0)
  const f32x16 z16=f32x16{};
  #define STEP(C0,C1,P0,P1,t,GK,GV,GL) do{ SBAR(); \
    const lds_cptr vp_=vp0+sl_prev; \
    VRD(0); SBAR(); float sacc=(P0[0]+P0[1]); \
    GAPA(C0=__builtin_amdgcn_mfma_f32_32x32x16_bf16(kf[0],qr[0],z16,0,0,0), P0[2],P0[3],P0[4],P0[5],     pw0[0]=PKW(P0,0), pw0[1]=PKW(P0,2), pw0); \
    VRD(4); SBAR(); GAPA(C1=__builtin_amdgcn_mfma_f32_32x32x16_bf16(kf[1],qr[0],z16,0,0,0), P0[6],P0[7],P0[8],P0[9],     pw0[2]=PKW(P0,4), pw0[3]=PKW(P0,6), pw0); \
    VRD(1); SBAR(); GAPA(C0=__builtin_amdgcn_mfma_f32_32x32x16_bf16(kf[2],qr[1],C0,0,0,0),   P0[10],P0[11],P0[12],P0[13], pw1[0]=PKW(P0,8), pw1[1]=PKW(P0,10), pw1); \
    VRD(5); SBAR(); GAPA(C1=__builtin_amdgcn_mfma_f32_32x32x16_bf16(kf[3],qr[1],C1,0,0,0),   P0[14],P0[15],P1[0],P1[1],   pw1[2]=PKW(P0,12),pw1[3]=PKW(P0,14), pw1); \
    VRD(2); SBAR(); GAPA(C0=__builtin_amdgcn_mfma_f32_32x32x16_bf16(kf[4],qr[2],C0,0,0,0),   P1[2],P1[3],P1[4],P1[5],     pw2[0]=PKW(P1,0), pw2[1]=PKW(P1,2), pw2); \
    VRD(6); SBAR(); GAPA(C1=__builtin_amdgcn_mfma_f32_32x32x16_bf16(kf[5],qr[2],C1,0,0,0),   P1[6],P1[7],P1[8],P1[9],     pw2[2]=PKW(P1,4), pw2[3]=PKW(P1,6), pw2); \
    VRD(3); SBAR(); GAPA(C0=__builtin_amdgcn_mfma_f32_32x32x16_bf16(kf[6],qr[3],C0,0,0,0),   P1[10],P1[11],P1[12],P1[13], pw3[0]=PKW(P1,8), pw3[1]=PKW(P1,10), pw3); \
    VRD(7); SBAR(); GAPA(C1=__builtin_amdgcn_mfma_f32_32x32x16_bf16(kf[7],qr[3],C1,0,0,0),   P1[14],P1[15],0.f,0.f,       pw3[2]=PKW(P1,12),pw3[3]=PKW(P1,14), pw3); \
    C0=__builtin_amdgcn_mfma_f32_32x32x16_bf16(kfa[0],QAF,C0,0,0,0); C1=__builtin_amdgcn_mfma_f32_32x32x16_bf16(kfa[1],QAF,C1,0,0,0); SBAR(); \
    l_reg+=sacc; \
    if(GK){DMA_KA((t)+3,sl_cur);DMA_K((t)+3,sl_cur);} if(GV){DMA_V((t)+1,sl_next);} \
    CMASK(C0,C1,t); \
    { float a=MX3(C0[0],C0[1],C1[0]),b=MX3(C0[2],C0[3],C1[1]); a=MX3(a,C1[2],C1[3]); \
      _Pragma("unroll") for(int r=4;r<16;r+=4){a=MX3(a,C0[r],C0[r+1]);b=MX3(b,C0[r+2],C0[r+3]);a=MX3(a,C1[r],C1[r+1]);b=MX3(b,C1[r+2],C1[r+3]);} \
      float rm=__builtin_fmaxf(a,b); { auto rr=__builtin_amdgcn_permlane32_swap(__float_as_uint(rm),__float_as_uint(rm),false,false); rm=__builtin_fmaxf(__uint_as_float(rr[0]),__uint_as_float(rr[1])); } \
      resc=false; \
      if(__builtin_expect(__any(rm>(float)THRL),0)){ const float dl=__builtin_fmaxf(rm,0.f); mhat+=dl; \
        _Pragma("unroll") for(int r=0;r<16;++r){C0[r]-=dl;C1[r]-=dl;} \
        QA_REBUILD(); \
        const float f=__builtin_amdgcn_exp2f(-dl); l_reg*=f; if(hi==0)wsf[r32]=f; resc=true; } } \
    SBAR(); \
    GAPB(o[0]=__builtin_amdgcn_mfma_f32_32x32x16_bf16(PAF(0),VFR(0),o[0],0,0,0), C0,0); \
    GAPB(o[1]=__builtin_amdgcn_mfma_f32_32x32x16_bf16(PAF(0),VFR(4),o[1],0,0,0), C0,4); \
    KRD(GL,0); GAPB(o[0]=__builtin_amdgcn_mfma_f32_32x32x16_bf16(PAF(1),VFR(1),o[0],0,0,0), C0,8); \
    KRD(GL,1); GAPB(o[1]=__builtin_amdgcn_mfma_f32_32x32x16_bf16(PAF(1),VFR(5),o[1],0,0,0), C0,12); \
    KRD(GL,2); GAPB(o[0]=__builtin_amdgcn_mfma_f32_32x32x16_bf16(PAF(2),VFR(2),o[0],0,0,0), C1,0); \
    KRD(GL,3); GAPB(o[1]=__builtin_amdgcn_mfma_f32_32x32x16_bf16(PAF(2),VFR(6),o[1],0,0,0), C1,4); \
    if(GL){ KALOAD(sl_next); SBAR(); } \
    GAPB(o[0]=__builtin_amdgcn_mfma_f32_32x32x16_bf16(PAF(3),VFR(3),o[0],0,0,0), C1,8); \
    GAPB(o[1]=__builtin_amdgcn_mfma_f32_32x32x16_bf16(PAF(3),VFR(7),o[1],0,0,0), C1,12); \
    }while(0)
  int t=1;
  #undef CMASK
  #define CMASK(P0,P1,t) do{}while(0)
  for(;t+5<NT;t+=2){
    STEP(pB0,pB1,pA0,pA1,t,true,true,true);     WAIT_BAR(2); RESC(); ROT();
    STEP(pA0,pA1,pB0,pB1,t+1,true,true,true);   WAIT_BAR(2); RESC(); ROT();
  }
  #undef CMASK
  #define CMASK(P0,P1,t) do{int jb_=(t)-(NT-4); if(jb_>=0)cmask(P0,P1,jb_,qrel,hi);}while(0)
  #define ENDW(tt) do{ if((tt)+3<NT){WAIT_BAR(2);} else if((tt)+2<NT){WAIT_BAR(1);} else {WAIT_BAR(0);} }while(0)
  for(;t+1<NT;t+=2){
    STEP(pB0,pB1,pA0,pA1,t,(t+3<NT),(t+1<NT),(t+1<NT));       ENDW(t);   RESC(); ROT();
    STEP(pA0,pA1,pB0,pB1,t+1,(t+4<NT),(t+2<NT),(t+2<NT));     ENDW(t+1); RESC(); ROT();
  }
  STEP(pB0,pB1,pA0,pA1,NT-1,false,false,false); RESC();
  { float sacc=pB0[0]+pB0[1]; _Pragma("unroll") for(int r=2;r<16;++r)sacc+=pB0[r]; _Pragma("unroll") for(int r=0;r<16;++r)sacc+=pB1[r]; l_reg+=sacc;
    pw0=(u32x4){PKW(pB0,0),PKW(pB0,2),PKW(pB0,4),PKW(pB0,6)};pw1=(u32x4){PKW(pB0,8),PKW(pB0,10),PKW(pB0,12),PKW(pB0,14)};pw2=(u32x4){PKW(pB1,0),PKW(pB1,2),PKW(pB1,4),PKW(pB1,6)};pw3=(u32x4){PKW(pB1,8),PKW(pB1,10),PKW(pB1,12),PKW(pB1,14)};
    SBAR(); pv(o,vb0+sl_cur,PAF(0),PAF(1),PAF(2),PAF(3)); }
  #undef PKW
  #undef PAF
  #undef VFR
  #undef PIN
  #undef MX3
  #undef GAPA
  #undef GAPB
  #undef EX
  #undef VRD
  #undef KRD
  #undef STEP
  #undef ENDW
  {auto rr=__builtin_amdgcn_permlane32_swap(__float_as_uint(l_reg),__float_as_uint(l_reg),false,false);l_reg=__uint_as_float(rr[0])+__uint_as_float(rr[1]);}
  if(hi==0)wsf[32+r32]=l_reg;asm volatile("s_waitcnt lgkmcnt(0)":::"memory");
  float rli[16];
  #pragma unroll
  for(int r=0;r<16;++r)rli[r]=__builtin_amdgcn_rcpf(wsf[32+crow(r,hi)]);
  bf16*Ow=O+(rowbase+q0+wid*QBLK)*DM+h*D;
  { bf16*stg=(bf16*)(shm+LDS_OST)+wid*2048;
    #pragma unroll
    for(int r=0;r<16;++r){const int orow=crow(r,hi);
      #pragma unroll
      for(int d0=0;d0<2;++d0)stg[orow*64+d0*32+r32]=__float2bfloat16(o[d0][r]*rli[r]);}
    asm volatile("s_waitcnt lgkmcnt(0)":::"memory");
    #pragma unroll
    for(int i=0;i<4;++i){const int row=i*8+(lane>>3),ch=lane&7; const u32x4 v=*(const u32x4*)(stg+row*64+ch*8); ATTN_STORE16(Ow+(long)row*DM+ch*8,v);} }
  asm volatile("s_waitcnt lgkmcnt(0)\n\ts_barrier":::"memory");
  #undef DMA_K
  #undef DMA_KA
  #undef KALOAD
  #undef QA_REBUILD
  #undef QAF
  #undef DMA_V
  #undef CMASK
  #undef START
  #undef RESC
  #undef ROT
}
constexpr int ATTN_LDS_BYTES=LDS_BYTES;
#undef SBAR
#undef WAIT_BAR
}
namespace dil {
using fox::bf16; using fox::bf16x8; using fox::f32x16; using fox::u32x4; using fox::s16x4;
constexpr int PITCH = 768;
constexpr int BT_N = 224;
__device__ __forceinline__ float hswap_max(float v) { auto rr = __builtin_amdgcn_permlane32_swap(__float_as_uint(v), __float_as_uint(v), false, false); return fmaxf(__uint_as_float(rr[0]), __uint_as_float(rr[1])); }
__device__ __forceinline__ float hswap_sum(float v) { auto rr = __builtin_amdgcn_permlane32_swap(__float_as_uint(v), __float_as_uint(v), false, false); return __uint_as_float(rr[0]) + __uint_as_float(rr[1]); }
__device__ __forceinline__ void pv_hi(f32x16* o, int vb, bf16x8 pa2, bf16x8 pa3) {
#pragma unroll
    for (int d0 = 0; d0 < 2; ++d0) { s16x4 lo[2], hi[2];
#pragma unroll
        for (int ks = 0; ks < 2; ++ks) {
            asm volatile("ds_read_b64_tr_b16 %0,%1 offset:%c2" : "=&v"(lo[ks]) : "v"(vb), "i"(d0 * 4096 + (ks + 2) * 1024) : "memory");
            asm volatile("ds_read_b64_tr_b16 %0,%1 offset:%c2" : "=&v"(hi[ks]) : "v"(vb), "i"(d0 * 4096 + (ks + 2) * 1024 + 512) : "memory"); }
        asm volatile("s_waitcnt lgkmcnt(0)" ::: "memory"); __builtin_amdgcn_sched_barrier(0);
#define DIL_PKV(k) (bf16x8){lo[k][0], lo[k][1], lo[k][2], lo[k][3], hi[k][0], hi[k][1], hi[k][2], hi[k][3]}
        o[d0] = __builtin_amdgcn_mfma_f32_32x32x16_bf16(pa2, DIL_PKV(0), o[d0], 0, 0, 0);
        o[d0] = __builtin_amdgcn_mfma_f32_32x32x16_bf16(pa3, DIL_PKV(1), o[d0], 0, 0, 0);
#undef DIL_PKV
    }
}
struct TP { int d, h12, tb, c, ubase; };
__device__ __forceinline__ TP mk_tp(int hs, int g, int t0, int r, int c) { TP p; p.d = (g == 0) ? 1 : (g == 1 ? 4 : 16); p.h12 = 4 * g + hs; p.tb = t0 + r; p.c = c; p.ubase = 32 * c - 160; return p; }
__device__ __forceinline__ void glds16s(const void* sbase, unsigned voff, unsigned lds_dst) { unsigned keep;
    asm volatile("s_mov_b32 %0, m0\n\ts_mov_b32 m0, %3\n\ts_nop 0\n\tglobal_load_lds_dwordx4 %1, %2\n\ts_mov_b32 m0, %0" : "=&s"(keep) : "v"(voff), "s"(sbase), "s"(lds_dst) : "memory"); }
__device__ __forceinline__ void dma_v(const TP& p, const unsigned rowbase, const bf16* __restrict__ VA, const unsigned lds_slot, const int tt, const int lane) {
#pragma unroll
    for (int w = 0; w < 8; ++w) {
        if (tt == 0 && (w & 3) < 2) continue;
        int pos = p.tb + p.d * (p.ubase + 64 * tt + 16 * (w & 3) + (lane >> 2)); pos = pos < 0 ? 0 : (pos > SEQ - 1 ? SEQ - 1 : pos);
        const unsigned off = ((rowbase + (unsigned)pos) * (unsigned)PITCH + (unsigned)(p.h12 * 64 + (w >> 2) * 32 + (lane & 3) * 8)) * 2u;
        glds16s(VA, off, (unsigned)__builtin_amdgcn_readfirstlane(lds_slot + w * 1024));
    }
}
__device__ __forceinline__ void issue_qk(const TP& p, const unsigned rowbase, const bf16* __restrict__ QA, const bf16* __restrict__ KA, bf16x8 (&qr)[4], bf16x8 (&kf)[5][4], const int lane) {
    const int r32 = lane & 31, hi = lane >> 5;
    { int tq = p.tb + p.d * (32 * p.c + r32); tq = tq > SEQ - 1 ? SEQ - 1 : tq;
      const unsigned qo = ((rowbase + (unsigned)tq) * (unsigned)PITCH + (unsigned)(p.h12 * 64 + hi * 8)) * 2u;
#pragma unroll
      for (int d0 = 0; d0 < 4; ++d0) qr[d0] = *reinterpret_cast<const bf16x8*>((const char*)QA + qo + d0 * 32); }
#pragma unroll
    for (int ch = 1; ch < 6; ++ch) {
        int pos = p.tb + p.d * (p.ubase + 32 * ch + r32); pos = pos < 0 ? 0 : (pos > SEQ - 1 ? SEQ - 1 : pos);
        const unsigned ko = ((rowbase + (unsigned)pos) * (unsigned)PITCH + (unsigned)(p.h12 * 64 + hi * 8)) * 2u;
#pragma unroll
        for (int d0 = 0; d0 < 4; ++d0) kf[ch - 1][d0] = *reinterpret_cast<const bf16x8*>((const char*)KA + ko + d0 * 32);
    }
    __builtin_amdgcn_sched_barrier(0);
}
template <bool HAS_NEXT>
__device__ __forceinline__ void task(const TP& p, const TP& nx, const int hs, const unsigned rowbase, const bf16* __restrict__ QA, const bf16* __restrict__ KA, const bf16* __restrict__ VA,
                                     bf16* __restrict__ PO, float* __restrict__ LSE, char* shm, const int vslot, const float* bt, float* wsf, bf16x8 (&qr)[4], bf16x8 (&kf)[5][4], const int lane_in) {
    int lane = lane_in; asm volatile("" : "+v"(lane));
    const int r32 = lane & 31, hi = lane >> 5;
    const unsigned lds0 = (unsigned)(uintptr_t)shm;
    f32x16 sc[6];
#pragma unroll
    for (int ch = 1; ch < 6; ++ch) {
        f32x16 a = f32x16{};
#pragma unroll
        for (int d0 = 0; d0 < 4; ++d0) a = __builtin_amdgcn_mfma_f32_32x32x16_bf16(kf[ch - 1][d0], qr[d0], a, 0, 0, 0);
        sc[ch] = a;
    }
    const int kmin = -p.ubase - p.tb / p.d;
    const int kth = kmin - 4 * hi;
    const float* btl = bt + (r32 - 4 * hi + 192);
    float mx = -INFINITY;
#pragma unroll
    for (int ch = 1; ch < 6; ++ch) {
#pragma unroll
        for (int rr = 0; rr < 16; ++rr) {
            const int kc = 32 * ch + (rr & 3) + 8 * (rr >> 2);
            float v = sc[ch][rr] + btl[-kc];
            if (kmin > 0) { if (kc < kth) v = -INFINITY; }
            sc[ch][rr] = v; mx = fmaxf(mx, v);
        }
        asm volatile("" ::: "memory");
    }
    mx = hswap_max(mx);
    float l = 0.f;
#define DIL_PK(P, B) fox::cvtpk_s(P[B], P[B + 1])
#define DIL_PA(P, B) __builtin_bit_cast(bf16x8, (u32x4){DIL_PK(P, B), DIL_PK(P, B + 2), DIL_PK(P, B + 4), DIL_PK(P, B + 6)})
    bf16x8 pk[6][2];
#pragma unroll
    for (int ch = 1; ch < 6; ++ch) {
#pragma unroll
        for (int rr = 0; rr < 16; ++rr) { const float pe = __builtin_amdgcn_exp2f(sc[ch][rr] - mx); sc[ch][rr] = pe; l += pe; }
        pk[ch][0] = DIL_PA(sc[ch], 0); pk[ch][1] = DIL_PA(sc[ch], 8);
    }
#undef DIL_PK
#undef DIL_PA
    l = hswap_sum(l);
    f32x16 o[2]; o[0] = f32x16{}; o[1] = f32x16{};
    const int vb = (int)(lds0 + vslot) + ((lane >> 4) & 1) * 32 + (lane & 3) * 8 + (4 * hi + ((lane & 15) >> 2)) * 64;
    asm volatile("s_waitcnt vmcnt(0)" ::: "memory");
    pv_hi(o, vb, pk[1][0], pk[1][1]);
    dma_v(p, rowbase, VA, lds0 + vslot, 2, lane);
    fox::pv(o, vb + 8192, pk[2][0], pk[2][1], pk[3][0], pk[3][1]);
    if constexpr (HAS_NEXT) {
        issue_qk(nx, rowbase, QA, KA, qr, kf, lane);
        dma_v(nx, rowbase, VA, lds0 + vslot + 8192, 1, lane);
        asm volatile("s_waitcnt vmcnt(32)" ::: "memory");
    } else {
        asm volatile("s_waitcnt vmcnt(0)" ::: "memory");
    }
    fox::pv(o, vb, pk[4][0], pk[4][1], pk[5][0], pk[5][1]);
    if (hi == 0) wsf[r32] = __builtin_amdgcn_rcpf(l);
    if (hi == 0) __hip_atomic_store(LSE + ((size_t)rowbase + p.tb + p.d * (32 * p.c + r32)) * 4 + hs, mx + __builtin_amdgcn_logf(l), __ATOMIC_RELAXED, __HIP_MEMORY_SCOPE_AGENT);
    asm volatile("s_waitcnt lgkmcnt(0)" ::: "memory");
    typedef __attribute__((address_space(3))) unsigned short* lds_u16p; typedef __attribute__((address_space(3))) const u32x4* lds_v4p;
    { const lds_u16p stg = (lds_u16p)(uintptr_t)(lds0 + vslot) + (4 * hi * 64 + r32);
#pragma unroll
      for (int rr = 0; rr < 16; ++rr) {
          const int q0 = (rr & 3) + 8 * (rr >> 2); const float rl = wsf[q0 + 4 * hi];
          stg[q0 * 64] = (unsigned short)(fox::cvtpk_s(o[0][rr] * rl, 0.f) & 0xffffu); stg[q0 * 64 + 32] = (unsigned short)(fox::cvtpk_s(o[1][rr] * rl, 0.f) & 0xffffu);
      } }
    asm volatile("s_waitcnt lgkmcnt(0)" ::: "memory");
    u32x4 ov[4];
    { const lds_v4p rb = (lds_v4p)(uintptr_t)(lds0 + vslot) + lane;
#pragma unroll
      for (int i = 0; i < 4; ++i) ov[i] = rb[i * 64]; }
    asm volatile("s_waitcnt lgkmcnt(0)" ::: "memory");
    if constexpr (HAS_NEXT) dma_v(nx, rowbase, VA, lds0 + vslot, 0, lane);
#pragma unroll
    for (int i = 0; i < 4; ++i) { const int idx = i * 64 + lane; const int qi = idx >> 3, c8 = idx & 7;
        asm volatile("global_store_dwordx4 %0, %1, off sc1\n\ts_nop 1" :: "v"(PO + ((size_t)rowbase + p.tb + p.d * (32 * p.c + qi)) * 256 + hs * 64 + c8 * 8), "v"(ov[i]) : "memory"); }
}
__device__ __forceinline__ void unit(const int b, const int hs, const int blk, const bf16* QA, const bf16* KA, const bf16* VA, const float* __restrict__ BIAS, bf16* PO0, bf16* PO1, bf16* PO2, float* LSE, bf16* YA,
                                     char* shm, float* bt_all, float* wsf_all, unsigned* pairctr, const int gmask = 7  ) {
    int tid_ = threadIdx.x; asm volatile("" : "+v"(tid_));
    const int tid = tid_, wave = __builtin_amdgcn_readfirstlane(tid >> 6);
    const int t0 = blk * 256, t512 = (blk >> 1) * 512, half = blk & 1;
    const int lane = tid & 63; const unsigned rowbase = (unsigned)b * SEQ; const int vslot = wave * 16384;
    const TP p0 = mk_tp(hs, 0, t0, 0, wave), p1 = mk_tp(hs, 1, t0, wave & 3, wave >> 2), p2 = mk_tp(hs, 2, t512, 8 * half + wave, 0);
    bf16x8 qr[4], kf[5][4];
    const unsigned lds0 = (unsigned)(uintptr_t)shm;
    if (gmask == 7) { dma_v(p0, rowbase, VA, lds0 + vslot, 0, lane); dma_v(p0, rowbase, VA, lds0 + vslot + 8192, 1, lane); issue_qk(p0, rowbase, QA, KA, qr, kf, lane); }
    for (int i = tid; i < 3 * BT_N; i += 512) { const int g = i / BT_N, x = i % BT_N, j = x - 32; bt_all[i] = (j >= 0 && j <= 128) ? BIAS[(4 * g + hs) * 129 + j] : -INFINITY; }
    __syncthreads();
    if (gmask == 7) {
        task<true>(p0, p1, hs, rowbase, QA, KA, VA, PO0, LSE, shm, vslot, bt_all, wsf_all + wave * 64, qr, kf, lane);
        task<true>(p1, p2, hs, rowbase, QA, KA, VA, PO1, LSE + (size_t)M * 4, shm, vslot, bt_all + BT_N, wsf_all + wave * 64, qr, kf, lane);
        task<false>(p2, p2, hs, rowbase, QA, KA, VA, PO2, LSE + (size_t)2 * M * 4, shm, vslot, bt_all + 2 * BT_N, wsf_all + wave * 64, qr, kf, lane);
    }
    asm volatile("s_waitcnt vmcnt(0)" ::: "memory");
    __syncthreads();
    unsigned* tick = (unsigned*)(wsf_all + 512);
    if (tid == 0) *tick = __hip_atomic_fetch_add(pairctr, 1u, __ATOMIC_RELAXED, __HIP_MEMORY_SCOPE_AGENT);
    __syncthreads();
    const bool last = (*tick & 1u) == 1u;
    if (last) {
        if (tid < 64) { __builtin_amdgcn_fence(__ATOMIC_ACQUIRE, "agent"); asm volatile("s_waitcnt vmcnt(0)" ::: "memory"); }
        __syncthreads();
        const size_t row0 = (size_t)b * SEQ + t512;
        for (int it = tid; it < 512 * 8; it += 512) {
            const int tok = it >> 3, c8 = it & 7; const size_t row = row0 + tok;
            float ls[3]; u32x4 pv3[3];
#pragma unroll
            for (int g = 0; g < 3; ++g) { const bf16* POg = g == 0 ? PO0 : (g == 1 ? PO1 : PO2); ls[g] = LSE[((size_t)g * M + row) * 4 + hs]; pv3[g] = *(const u32x4*)(POg + row * 256 + hs * 64 + c8 * 8); }
            const float mm = fmaxf(ls[0], fmaxf(ls[1], ls[2]));
            float w[3]; float ws_ = 0.f;
#pragma unroll
            for (int g = 0; g < 3; ++g) { w[g] = __builtin_amdgcn_exp2f(ls[g] - mm); ws_ += w[g]; }
            const float iw = 1.f / ws_;
            float y[8];
#pragma unroll
            for (int e = 0; e < 8; ++e) y[e] = 0.f;
#pragma unroll
            for (int g = 0; g < 3; ++g) { const float wg = w[g] * iw; const unsigned q[4] = {pv3[g].x, pv3[g].y, pv3[g].z, pv3[g].w};
#pragma unroll
                for (int e = 0; e < 4; ++e) { y[2 * e] += wg * __uint_as_float(q[e] << 16); y[2 * e + 1] += wg * __uint_as_float(q[e] & 0xffff0000u); } }
            u32x4 ov; ov.x = fox::cvtpk_s(y[0], y[1]); ov.y = fox::cvtpk_s(y[2], y[3]); ov.z = fox::cvtpk_s(y[4], y[5]); ov.w = fox::cvtpk_s(y[6], y[7]);
            *(u32x4*)(YA + row * 256 + hs * 64 + c8 * 8) = ov;
        }
    }
    __syncthreads();
}
}
namespace rtr {
using fox::bf16x8; using fox::f32x16; using fox::u32x4;
__device__ __forceinline__ void task(const int t, const int kq, const bool valid, const float* __restrict__ X1, const float* __restrict__ gf, const unsigned short* __restrict__ WRF, const float* __restrict__ router_bias,
                                     unsigned short* __restrict__ H2, float* __restrict__ RINV, unsigned* __restrict__ CNT, unsigned* __restrict__ LIST, float* __restrict__ GATEW, float2* __restrict__ META, unsigned* __restrict__ INV, float* tiles, float* sst, PG8_LAS unsigned* LC  ) {
    int tid_ = threadIdx.x; asm volatile("" : "+v"(tid_));
    if (tid_ < 128) LC[tid_] = 0u;
    const int lane = tid_ & 63, r32 = lane & 31, hi = lane >> 5;
    const size_t row = (size_t)t * 32 + r32;
    const float* xp = X1 + row * D + hi * 8; const float* gp = gf + hi * 8; unsigned short* hp = H2 + row * D + hi * 8;
    const u32x4* wf = (const u32x4*)WRF + lane;
    f32x16 acc[2]; acc[0] = f32x16{}; acc[1] = f32x16{};
    float ss = 0.f;
    if (valid) {
#pragma unroll 4
    for (int k0 = 16 * kq; k0 < 16 * kq + 16; ++k0) {
        const float4 xa = *(const float4*)(xp + k0 * 16), xb = *(const float4*)(xp + k0 * 16 + 4);
        const float4 ga = *(const float4*)(gp + k0 * 16), gb = *(const float4*)(gp + k0 * 16 + 4);
        const u32x4 bh0 = wf[(0 * 64 + k0) * 64], bh1 = wf[(1 * 64 + k0) * 64], bl0 = wf[(2 * 64 + k0) * 64], bl1 = wf[(3 * 64 + k0) * 64];
        const float x[8] = {xa.x, xa.y, xa.z, xa.w, xb.x, xb.y, xb.z, xb.w}; const float gg[8] = {ga.x, ga.y, ga.z, ga.w, gb.x, gb.y, gb.z, gb.w};
        float y[8]; unsigned ph[4], pl[4];
#pragma unroll
        for (int e = 0; e < 8; ++e) { ss += x[e] * x[e]; y[e] = x[e] * gg[e]; }
#pragma unroll
        for (int e = 0; e < 4; ++e) { ph[e] = fox::cvtpk_s(y[2 * e], y[2 * e + 1]);
            pl[e] = fox::cvtpk_s(y[2 * e] - __uint_as_float(ph[e] << 16), y[2 * e + 1] - __uint_as_float(ph[e] & 0xffff0000u)); }
        const u32x4 hv = {ph[0], ph[1], ph[2], ph[3]}, lv = {pl[0], pl[1], pl[2], pl[3]};
        *(u32x4*)(hp + k0 * 16) = hv;
        const bf16x8 ah = __builtin_bit_cast(bf16x8, hv), al = __builtin_bit_cast(bf16x8, lv);
        acc[0] = __builtin_amdgcn_mfma_f32_32x32x16_bf16(ah, __builtin_bit_cast(bf16x8, bh0), acc[0], 0, 0, 0);
        acc[1] = __builtin_amdgcn_mfma_f32_32x32x16_bf16(ah, __builtin_bit_cast(bf16x8, bh1), acc[1], 0, 0, 0);
        acc[0] = __builtin_amdgcn_mfma_f32_32x32x16_bf16(ah, __builtin_bit_cast(bf16x8, bl0), acc[0], 0, 0, 0);
        acc[1] = __builtin_amdgcn_mfma_f32_32x32x16_bf16(ah, __builtin_bit_cast(bf16x8, bl1), acc[1], 0, 0, 0);
        acc[0] = __builtin_amdgcn_mfma_f32_32x32x16_bf16(al, __builtin_bit_cast(bf16x8, bh0), acc[0], 0, 0, 0);
        acc[1] = __builtin_amdgcn_mfma_f32_32x32x16_bf16(al, __builtin_bit_cast(bf16x8, bh1), acc[1], 0, 0, 0);
    }
    { auto rr = __builtin_amdgcn_permlane32_swap(__float_as_uint(ss), __float_as_uint(ss), false, false); ss = __uint_as_float(rr[0]) + __uint_as_float(rr[1]); }
    float* tile = tiles + kq * (32 * 65);
#pragma unroll
    for (int eh = 0; eh < 2; ++eh)
#pragma unroll
        for (int r = 0; r < 16; ++r) tile[((r & 3) + 8 * (r >> 2) + 4 * hi) * 65 + eh * 32 + r32] = acc[eh][r];
    if (hi == 0) sst[kq * 32 + r32] = ss;
    }
    asm volatile("s_waitcnt lgkmcnt(0)" ::: "memory");
    __syncthreads();
    const bool fin = valid && kq == 0;
    int ls[4] = {0, 0, 0, 0}; unsigned lp[4] = {0u, 0u, 0u, 0u}; float gwv[4] = {0.f, 0.f, 0.f, 0.f}; float rinv = 0.f;
#define RT_LOGIT(e_) ((trow[e_] + trow[(e_) + 32 * 65]) + (trow[(e_) + 2 * 32 * 65] + trow[(e_) + 3 * 32 * 65]))
    if (fin) {
    rinv = rsqrtf((sst[r32] + sst[32 + r32] + sst[64 + r32] + sst[96 + r32]) * (1.f / D) + EPS);
    if (hi == 0) RINV[row] = rinv;
    float tv[8]; int ti[8];
#pragma unroll
    for (int p = 0; p < 8; ++p) { tv[p] = -INFINITY; ti[p] = 0; }
    const float* trow = tiles + r32 * 65;
#pragma unroll 4
    for (int e0 = 0; e0 < 32; ++e0) {
        const int e = hi * 32 + e0;
        float v = 1.f / (1.f + __expf(-RT_LOGIT(e) * rinv)) + router_bias[e]; int id = e;
#pragma unroll
        for (int p = 0; p < 8; ++p) { const bool gt = v > tv[p]; const float tvv = tv[p]; const int tii = ti[p]; tv[p] = gt ? v : tvv; ti[p] = gt ? id : tii; v = gt ? tvv : v; id = gt ? tii : id; }
    }
    float ov[8]; int oi[8];
#pragma unroll
    for (int p = 0; p < 8; ++p) { auto a = __builtin_amdgcn_permlane32_swap(__float_as_uint(tv[p]), __float_as_uint(tv[p]), false, false); ov[p] = hi ? __uint_as_float(a[0]) : __uint_as_float(a[1]);
        auto bq = __builtin_amdgcn_permlane32_swap((unsigned)ti[p], (unsigned)ti[p], false, false); oi[p] = hi ? (int)bq[0] : (int)bq[1]; }
#pragma unroll
    for (int q = 0; q < 8; ++q) { float v = ov[q]; int id = oi[q];
#pragma unroll
        for (int p = 0; p < 8; ++p) { const bool gt = (v > tv[p]) || (v == tv[p] && id < ti[p]); const float tvv = tv[p]; const int tii = ti[p]; tv[p] = gt ? v : tvv; ti[p] = gt ? id : tii; v = gt ? tvv : v; id = gt ? tii : id; } }
    float sv[8]; float ssum = 0.f;
#pragma unroll
    for (int p = 0; p < 8; ++p) { sv[p] = 1.f / (1.f + __expf(-RT_LOGIT(ti[p]) * rinv)); ssum += sv[p]; }
    const float sc = 2.5f / ssum;
#pragma unroll
    for (int j = 0; j < 4; ++j) { const int e = hi ? ti[4 + j] : ti[j]; ls[j] = e * 2 + hi; gwv[j] = (hi ? sv[4 + j] : sv[j]) * sc;
        lp[j] = __hip_atomic_fetch_add(LC + ls[j], 1u, __ATOMIC_RELAXED, __HIP_MEMORY_SCOPE_WORKGROUP); }
    }
    asm volatile("s_waitcnt lgkmcnt(0)" ::: "memory");
    __syncthreads();
    if (tid_ < 128) { const unsigned c = LC[tid_]; unsigned base = 0u; if (c != 0u) base = atomicAdd(&CNT[tid_ * CNT_STRIDE], c); LC[128 + tid_] = base; }
    asm volatile("s_waitcnt lgkmcnt(0)" ::: "memory");
    __syncthreads();
    if (fin) {
#pragma unroll
    for (int j = 0; j < 4; ++j) {
        const int l = ls[j], p = 4 * hi + j;
        const unsigned pos = LC[128 + l] + lp[j];
        LIST[(size_t)l * M + pos] = (unsigned)row * 8u + (unsigned)p;
        GATEW[row * 8 + p] = gwv[j];
        META[(size_t)l * M + pos] = make_float2(rinv, gwv[j]);
        INV[row * 8 + p] = ((unsigned)l << 16) | pos;
    }
    }
    asm volatile("s_waitcnt lgkmcnt(0)" ::: "memory");
#undef RT_LOGIT
}
}
#define GAS __attribute__((address_space(1)))
#define LAS __attribute__((address_space(3)))
typedef unsigned short bf16;
typedef unsigned v4u __attribute__((ext_vector_type(4)));
typedef float f32x4 __attribute__((ext_vector_type(4)));
typedef short bf16x8 __attribute__((ext_vector_type(8)));
typedef GAS unsigned gu32;
typedef GAS unsigned long long gu64;
#define RLX_AGENT __ATOMIC_RELAXED, __HIP_MEMORY_SCOPE_AGENT
#define LDS_WAIT() asm volatile("s_waitcnt lgkmcnt(0)" ::: "memory")
#define VM_WAIT() asm volatile("s_waitcnt vmcnt(0)" ::: "memory")
__device__ __forceinline__ unsigned long long rt() { return __builtin_amdgcn_s_memrealtime(); }

#define XB_TMO      128
#define XB_XCNT(j)  (256  + 64 * (j))
#define XB_XSUB(j)  (1280 + 64 * (j))
#define XB_XGEN(j)  (2304 + 64 * (j))
#define XB_TOP      3328
#define XB_TOPGEN   3392
#define XCD_BAR_WORDS 3456
#define XB_SPIN_CAP (1u << 18)

__device__ __forceinline__ unsigned xb_ld(unsigned* p)              { return __hip_atomic_load(p, __ATOMIC_RELAXED, __HIP_MEMORY_SCOPE_AGENT); }
__device__ __forceinline__ unsigned xb_add(unsigned* p, unsigned v) { return __hip_atomic_fetch_add(p, v, __ATOMIC_RELAXED, __HIP_MEMORY_SCOPE_AGENT); }
__device__ __forceinline__ unsigned xb_xcc_id() { return (unsigned)__builtin_amdgcn_s_getreg((3 << 11) | 20) & 0xFu; }
#define XB_SPIN(cond, bar) do { unsigned _sp = 0; while (cond) { __builtin_amdgcn_s_sleep(1); \
    if ((++_sp & 255u) == 0u) { if (xb_ld(&(bar)[XB_TMO])) break; if (_sp > XB_SPIN_CAP) { atomicAdd(&(bar)[XB_TMO], 1u); break; } } } } while (0)

struct XcdBarrier {
    unsigned* bar; unsigned x;
    volatile LAS unsigned* st;
};

__device__ __forceinline__ XcdBarrier xcd_barrier_post(unsigned* bar, volatile LAS unsigned* st) {
    XcdBarrier b; b.bar = bar; b.x = xb_xcc_id(); b.st = st;
    if (threadIdx.x == 0) (void)xb_add(&bar[XB_XCNT(b.x)], 1u);
    return b;
}
__device__ __forceinline__ void xcd_barrier_complete(unsigned* bar, unsigned x, unsigned& nloc, unsigned& nx) {
    const unsigned G = gridDim.x * gridDim.y * gridDim.z;
    unsigned sum, cnt, mine, sp = 0u;
    for (;;) {
        sum = 0u; cnt = 0u; mine = 0u;
#pragma unroll
        for (unsigned j = 0; j < 16; ++j) { const unsigned c = xb_ld(&bar[XB_XCNT(j)]); sum += c; cnt += (c > 0u) ? 1u : 0u; mine = (j == x) ? c : mine; }
        if (sum == G) break;
        __builtin_amdgcn_s_sleep(1);
        if ((++sp & 255u) == 0u) { if (xb_ld(&bar[XB_TMO])) break; if (sp > XB_SPIN_CAP) { atomicAdd(&bar[XB_TMO], 1u); break; } }
    }
    nloc = mine > 0u ? mine : 1u; nx = cnt > 0u ? cnt : 1u;
}

__device__ __forceinline__ void xcd_barrier(const XcdBarrier& b) {
    asm volatile("s_waitcnt vmcnt(0)" ::: "memory");
    __syncthreads();
    if (threadIdx.x == 0) {
        unsigned* bar = b.bar;
        __builtin_amdgcn_s_waitcnt(0);
        unsigned nloc = b.st[0], nx = b.st[1];
        if (nloc == 0u) { xcd_barrier_complete(bar, b.x, nloc, nx); b.st[0] = nloc; b.st[1] = nx; }
        const unsigned old = xb_add(&bar[XB_XSUB(b.x)], 1u);
        const unsigned gen = old / nloc;
        if (old + 1u == (gen + 1u) * nloc) {
            __builtin_amdgcn_fence(__ATOMIC_RELEASE, "agent");
            asm volatile("s_waitcnt vmcnt(0)" ::: "memory");
            const unsigned og = xb_add(&bar[XB_TOP], 1u);
            const unsigned tg = og / nx;
            if (og + 1u == (tg + 1u) * nx) xb_add(&bar[XB_TOPGEN], 1u);
            else XB_SPIN(xb_ld(&bar[XB_TOPGEN]) == tg, bar);
            __builtin_amdgcn_fence(__ATOMIC_ACQUIRE, "agent");
            xb_add(&bar[XB_XGEN(b.x)], 1u);
            asm volatile("s_waitcnt vmcnt(0)" ::: "memory");
        } else {
            XB_SPIN(xb_ld(&bar[XB_XGEN(b.x)]) == gen, bar);
            __builtin_amdgcn_fence(__ATOMIC_ACQUIRE, "agent");
            asm volatile("s_waitcnt vmcnt(0)" ::: "memory");
        }
    }
    __syncthreads();
}
constexpr int NWAVES = 8;
constexpr int RING_OFF = 0, RING_BYTES = 131072;
constexpr int LDSCTL_OFF = RING_BYTES, MISC_OFF = LDSCTL_OFF + 320;
constexpr int TB_CNT = LDSCTL_OFF + 1024, TB_HB = LDSCTL_OFF + 2048, TB_T6 = LDSCTL_OFF + 3072, TB_TA = LDSCTL_OFF + 4096, TB_TB = LDSCTL_OFF + 5120, TB_T9 = LDSCTL_OFF + 6144, TB_UT = LDSCTL_OFF + 7168;
constexpr int LDS_BYTES = 147456;
constexpr int CW_TMO = 0, CW_CODE = 1, CW_BAR = 4096;
constexpr int N_IN = 16 * 60, N_G = 16 * 32, N_PA = 4 * 16, N_PB = 8 * 16, N_O = 16 * 16, N_EX = 65 * 128, N_W2 = 65 * 64;
constexpr int N_FILL1 = 0;    constexpr int N_FILL2 = 8320;
constexpr int NITEMS = N_IN + N_G + N_PA + N_PB + N_O + N_EX - N_FILL1 - N_FILL2;
constexpr int NPHASE = 10;
constexpr int NTOT1 = 3840 + 2048;
struct MArgs { const float* in[23]; float* out; unsigned char* ws; int ph_lo, ph_hi, li, pad; };

__device__ __forceinline__ void tr64_load(f32x4 (&v)[16], const float* W, int ldw, int k0, int n0, int lane) {
    const int lq = lane >> 4, n4 = lane & 15;
    const GAS f32x4* src = (const GAS f32x4*)(W + (size_t)(k0 + 2 * lq) * ldw + n0 + 4 * n4);
#pragma unroll
    for (int j = 0; j < 16; ++j) v[j] = src[((size_t)(8 * (j >> 1) + (j & 1)) * ldw) >> 2];
}
__device__ __forceinline__ void tr64_store(const f32x4 (&v)[16], int k0, bf16* WT, int K, int base_row, int hstride, LAS unsigned* T, int lane) {
    const int lq = lane >> 4, n4 = lane & 15;
#pragma unroll
    for (int p = 0; p < 8; ++p)
#pragma unroll
        for (int e = 0; e < 4; ++e) T[(4 * n4 + e) * 33 + 4 * p + lq] = pg8::cvtc(v[2 * p][e], v[2 * p + 1][e]);
    LDS_WAIT(); asm volatile("" ::: "memory");
    const int c = lane & 7;
#pragma unroll
    for (int j = 0; j < 8; ++j) { const int n = (lane >> 3) + 8 * j; const LAS unsigned* s = T + n * 33 + 4 * c;
        v4u o; o.x = s[0]; o.y = s[1]; o.z = s[2]; o.w = s[3];
        *(GAS v4u*)(WT + (size_t)(base_row + hstride * (n >> 5) + (n & 31)) * K + k0 + 8 * c) = o; }
    LDS_WAIT(); asm volatile("" ::: "memory");
}
__device__ __forceinline__ void p0_tr64(const float* W, int ldw, int k0, int n0, bf16* WT, int K, int base_row, int hstride, LAS unsigned* T, int lane) {
    f32x4 v[16];
    tr64_load(v, W, ldw, k0, n0, lane);
    tr64_store(v, k0, WT, K, base_row, hstride, T, lane);
}
__device__ __forceinline__ void rms_row(const float* xrow, const float* g, bf16* orow, const LAS float* wt8, const float* b_forget, float* logf_row, int lane) {
    const GAS f32x4* xr = (const GAS f32x4*)xrow;
    f32x4 v[4]; float ss = 0.f;
#pragma unroll
    for (int j = 0; j < 4; ++j) { v[j] = xr[lane + 64 * j]; ss += v[j].x * v[j].x + v[j].y * v[j].y + v[j].z * v[j].z + v[j].w * v[j].w; }
    ss = wave_sum(ss);
    const float rinv = rsqrtf(ss * (1.f / D) + EPS);
    float f[8];
#pragma unroll
    for (int c = 0; c < 8; ++c) f[c] = 0.f;
#pragma unroll
    for (int j = 0; j < 4; ++j) {
        const f32x4 gg = ((const GAS f32x4*)g)[lane + 64 * j];
        float y[4] = {v[j].x * rinv * gg.x, v[j].y * rinv * gg.y, v[j].z * rinv * gg.z, v[j].w * rinv * gg.w};
        u32x2 o; o.x = pg8::cvtc(y[0], y[1]); o.y = pg8::cvtc(y[2], y[3]);
        *(GAS u32x2*)(orow + 4 * (lane + 64 * j)) = o;
        if (wt8) {
#pragma unroll
            for (int c = 0; c < 8; ++c) { const f32x4 w = *(const LAS f32x4*)(wt8 + c * 1024 + 4 * (lane + 64 * j)); f[c] += (y[0] * w.x + y[1] * w.y) + (y[2] * w.z + y[3] * w.w); }
        }
    }
    if (wt8) {
#pragma unroll
        for (int c = 0; c < 8; ++c) f[c] = wave_sum(f[c]);
        float mine = f[0];
#pragma unroll
        for (int c = 1; c < 8; ++c) mine = (lane == c) ? f[c] : mine;
        if (lane < 8) { const float z = mine + b_forget[lane]; logf_row[lane] = fminf(z, 0.f) - log1pf(expf(-fabsf(z))); }
    }
}
__device__ __forceinline__ void p1_cumsum(int bh, const float* LOGF, float* C, bf16* KAUG, LAS float* sc, int tid, const float* qnb, const float* knb, int* FT0) {
    const int b = bh >> 3, h = bh & 7;
    float loc[16]; float run = 0.f;
#pragma unroll
    for (int e = 0; e < 16; ++e) { run += LOGF[((size_t)b * SEQ + 16 * tid + e) * 8 + h]; loc[e] = run; }
    sc[tid] = run; __syncthreads();
    for (int o = 1; o < 512; o <<= 1) { const float t = (tid >= o) ? sc[tid - o] : 0.f; __syncthreads(); sc[tid] += t; __syncthreads(); }
    const float base = sc[tid] - run;
#pragma unroll
    for (int e = 0; e < 16; ++e) {
        const float c = base + loc[e]; const int t = 16 * tid + e;
        C[(size_t)bh * SEQ + t] = c;
        const float vv = -c * LOG2E;
        const unsigned p0 = f2bf(vv); const float r1 = vv - __uint_as_float(p0 << 16);
        const unsigned p1 = f2bf(r1); const float r2 = r1 - __uint_as_float(p1 << 16);
        const unsigned p2 = f2bf(r2);
        v4u o; o.x = p0 | (p1 << 16); o.y = p2 | (0x3F80u << 16); o.z = 0x3F803F80u; o.w = 0u;
        *(GAS v4u*)(KAUG + (((size_t)b * SEQ + t) * 8 + h) * 8) = o;
        sc[512 + t] = c;
    }
    __syncthreads();
    if (tid < 64) {
        const int lane = tid; const float gq = wave_max(fabsf(qnb[lane])), gk = wave_max(fabsf(knb[lane]));
        const float thr = 2.f * 8.f * gq * gk * 1.03f + 20.f;
        int cost = 0;
        if (lane < 32) { const int q0 = 256 * lane; const float c0 = sc[512 + q0]; int lo = 0, hi = q0;
            while (lo < hi) { const int mid = (lo + hi) >> 1; if (c0 - sc[512 + mid] >= -thr) hi = mid; else lo = mid + 1; }
            int T0 = (lo >> 6) & ~1; if (T0 > 4 * lane) T0 = 4 * lane; FT0[bh * 32 + lane] = T0; cost = 4 * lane + 4 - T0; }
#pragma unroll
        for (int o = 1; o < 64; o <<= 1) cost += __shfl_xor(cost, o);
        if (lane == 0) FT0[512 + bh] = cost;
    }
    __syncthreads();
}

__device__ __forceinline__ unsigned wave_excl_scan(unsigned v, int lane, unsigned& total) {
    unsigned x = v;
#pragma unroll
    for (int o = 1; o < 64; o <<= 1) { const unsigned y = __shfl_up(x, o); if (lane >= o) x += y; }
    total = __shfl(x, 63); return x - v;
}
__device__ __forceinline__ void moe_tables(LAS unsigned char* L, const gu32* CNT, int tid) {
    asm volatile("" : "+v"(tid));
    if (tid < 64) {
        const int lane = tid;
        const unsigned c0 = __hip_atomic_load(CNT + (2 * lane) * CNT_STRIDE, RLX_AGENT), c1 = __hip_atomic_load(CNT + (2 * lane + 1) * CNT_STRIDE, RLX_AGENT);
        const unsigned t0 = (c0 + 255u) >> 8, t1 = (c1 + 255u) >> 8;
        unsigned tc, ta, tbb, t6;
        const unsigned hb = wave_excl_scan(c0 + c1, lane, tc), pa = wave_excl_scan(t0, lane, ta), pb = wave_excl_scan(t1, lane, tbb), p6 = wave_excl_scan((c0 + c1 + 255u) >> 8, lane, t6);
        LAS unsigned* cntL = (LAS unsigned*)(L + TB_CNT); LAS unsigned* hbL = (LAS unsigned*)(L + TB_HB); LAS unsigned* T6 = (LAS unsigned*)(L + TB_T6);
        LAS unsigned* TA = (LAS unsigned*)(L + TB_TA); LAS unsigned* TBt = (LAS unsigned*)(L + TB_TB); LAS unsigned* T9 = (LAS unsigned*)(L + TB_T9);
        cntL[2 * lane] = c0; cntL[2 * lane + 1] = c1; hbL[2 * lane] = hb; hbL[2 * lane + 1] = hb + c0;
        T6[lane] = p6; TA[lane] = pa; TBt[lane] = pb;
        if (lane == 0) { cntL[128] = (unsigned)M; hbL[128] = 0u; T6[64] = t6; T6[65] = t6 + (unsigned)(M / 256); TA[64] = ta; TBt[64] = tbb; T9[0] = 0u; T9[1] = (unsigned)(M / 256); }
    }
    __syncthreads();
}

__device__ __forceinline__ void conv_w1_item(int r, const float* wg_e, const float* wu_e, const float* wg_s, const float* wu_s, bf16* W1, LAS unsigned* scr, int lane) {
    const int e = r >> 7, q = r & 127, up = q >> 6, qq = q & 63, kb = qq >> 2, nb = qq & 3;
    const float* src = (e < NE) ? (up ? wu_e : wg_e) + (size_t)e * D * DE : (up ? wu_s : wg_s);
    p0_tr64(src, DE, 64 * kb, 64 * nb, W1 + (size_t)e * 512 * D, D, 256 * (nb >> 1) + 128 * up + 64 * (nb & 1), 32, scr, lane);
}
__global__ void __launch_bounds__(NWAVES * 64, 2) mega(MArgs args) {
    extern __shared__ __attribute__((aligned(16))) unsigned char lds[];
    LAS unsigned char* L = (LAS unsigned char*)lds;
    volatile LAS unsigned* MISC = (volatile LAS unsigned*)(L + MISC_OFF);
    const int tid = threadIdx.x, lane = tid & 63, wave = __builtin_amdgcn_readfirstlane(tid >> 6);
    const int G = gridDim.x; const int bx = blockIdx.x; const int vcu = (G % 8 == 0) ? (bx % 8) * (G / 8) + bx / 8 : bx;
    unsigned char* ws = args.ws;
    gu32* ctl = (gu32*)(ws + WS_CTL);
#ifdef RERUN_PHASE
#define PROBE_RR (args.li != 0)
#else
#define PROBE_RR false
#endif
    for (int u = tid; u < (LDS_BYTES - LDSCTL_OFF) / 4; u += NWAVES * 64) ((LAS unsigned*)(L + LDSCTL_OFF))[u] = 0u;
    __syncthreads();
    XcdBarrier bar = xcd_barrier_post((unsigned*)(ctl + CW_BAR) + args.li * 28672  , MISC + 8);
#ifdef DIAG_TS
#define GRID_BAR() do { const unsigned long long t0_ = rt(); xcd_barrier(bar); if (bx == DIAG_BLK && tid == 0) ((unsigned long long*)(ws + WS_CTL + 512 * 1024))[20] += rt() - t0_; } while (0)
#else
#define GRID_BAR() xcd_barrier(bar)
#endif
#ifdef RERUN_GMASK
#define DIL_GMASK (PROBE_RR ? RERUN_GMASK : 7)
#else
#define DIL_GMASK 7
#endif
#ifdef RERUN_NOEPI
#define PROBE_NOEPI (PROBE_RR ? 1 : 0)
#else
#define PROBE_NOEPI 0
#endif
#define VCU() ((G % 8 == 0) ? ((int)blockIdx.x % 8) * (G / 8) + (int)blockIdx.x / 8 : (int)blockIdx.x)
#ifndef REPEAT_PHASE
#define REPEAT_PHASE (-1)
#endif
#define NREP(k) (((REPEAT_PHASE) == (k)) ? 2 : 1)
#ifdef REPEAT_BARRIER
#define REP_BAR() do { if (rep_ > 0) GRID_BAR(); } while (0)
#else
#define REP_BAR() do {} while (0)
#endif
#ifndef EXTRA_BARRIERS
#define EXTRA_BARRIERS 0
#endif
#ifdef DIAG_TS
#define TSTAMP(k) do { if (bx == DIAG_BLK && tid == 0) ((unsigned long long*)(ws + WS_CTL + 512 * 1024))[k] = rt(); } while (0)
#else
#define TSTAMP(k) do {} while (0)
#endif
    const int lo = args.ph_lo, hi = args.ph_hi;
#define IN(k) (lo <= (k) && (k) < hi)
#define BOTH(k) (IN(k) && IN((k) + 1))

    TSTAMP(0);
    if (IN(0)) {
        const float* x = args.in[0]; const float* g_mix = args.in[1]; const float* w_in = args.in[2]; const float* rel_bias = args.in[7]; const float* b_forget = args.in[8]; const float* w_gate = args.in[9]; const float* wpa = args.in[11]; const float* wpb = args.in[12]; const float* w_out = args.in[13]; const float* w_router = args.in[15]; const float* wg_e = args.in[17]; const float* wu_e = args.in[18]; const float* wd_e = args.in[19]; const float* wg_s = args.in[20]; const float* wu_s = args.in[21]; const float* wd_s = args.in[22]; bf16* XN = (bf16*)(ws + WS_XN); bf16* WIN_t = (bf16*)(ws + WS_WIN); bf16* WPA_t = (bf16*)(ws + WS_WIN) + (size_t)NTOT1 * D; bf16* WPB_t = (bf16*)(ws + WS_WIN) + (size_t)NTOT1 * D + (size_t)D * OUTA; bf16* WOUT_t = (bf16*)(ws + WS_WIN) + (size_t)NTOT1 * D + (size_t)D * OUTA + (size_t)D * OUTB; bf16* W1 = (bf16*)(ws + WS_W1); bf16* W2 = (bf16*)(ws + WS_W2); float* LOGF = (float*)(ws + WS_LOGF); float* BIAS = (float*)(ws + WS_BIAS);
        _Pragma("unroll") for (int rep_ = 0; rep_ < NREP(0); ++rep_) { REP_BAR();
        LAS unsigned* scr = (LAS unsigned*)(L + RING_OFF + wave * 8704);
        LAS float* wt8 = (LAS float*)(L + RING_OFF + 8 * 8704);
        const int gw = vcu * NWAVES + wave, NGW = G * NWAVES;
        for (int i = tid; i < 8 * D; i += NWAVES * 64) { const int ii = i >> 3, c = i & 7; wt8[c * D + ii] = w_in[(size_t)ii * DIN + (WA + WB) + c]; }
        for (int it = gw; it < NITEMS; it += NGW) {
            int r = it;
            if (r < N_EX - N_FILL1 - N_FILL2) { conv_w1_item(r + N_FILL1 + N_FILL2, wg_e, wu_e, wg_s, wu_s, W1, scr, lane); continue; } r -= N_EX - N_FILL1 - N_FILL2;
            if (r < N_IN) { const int kb = r / 60, nb = r % 60, c = 64 * nb;
                p0_tr64(w_in, DIN, 64 * kb, c, WIN_t, D, 256 * (c / 256) + 32 * ((c % 256) / 64), 128, scr, lane); continue; } r -= N_IN;
            if (r < N_G) { const int kb = r >> 5, nb = r & 31; p0_tr64(w_gate, 2 * D, 64 * kb, 64 * nb, WIN_t, D, 3840 + 64 * nb, 32, scr, lane); continue; } r -= N_G;
            if (r < N_PA) { const int kb = r >> 4, nb = r & 15; p0_tr64(wpa, D, 64 * kb, 64 * nb, WPA_t, OUTA, 64 * nb, 32, scr, lane); continue; } r -= N_PA;
            if (r < N_PB) { const int kb = r >> 4, nb = r & 15; p0_tr64(wpb, D, 64 * kb, 64 * nb, WPB_t, OUTB, 64 * nb, 32, scr, lane); continue; } r -= N_PB;
            { const int kb = r >> 4, nb = r & 15; p0_tr64(w_out, D, 64 * kb, 64 * nb, WOUT_t, D, 64 * nb, 32, scr, lane); }
        }
        __syncthreads();
        for (int m = gw; m < M; m += NGW) rms_row(x + (size_t)m * D, g_mix, XN + (size_t)m * D, wt8, b_forget, LOGF + (size_t)m * 8, lane);
        if (bx == 0) for (int i = tid; i < HA * 129; i += NWAVES * 64) {
            const int head = i / 129, j = i % 129, g = head >> 2; const int d = (g == 0) ? 1 : (g == 1 ? 4 : 16);
            const int dist = d * j; int bucket;
            if (dist < 16) bucket = dist;
            else { const int large = 16 + (int)(__log2f((float)dist * 0.0625f) * (16.f / 7.f)); bucket = large < 31 ? large : 31; }
            BIAS[head * 129 + j] = rel_bias[bucket * HA + head] * LOG2E;
        }
        { unsigned* WRFw = (unsigned*)(ws + WS_WRF);
          for (int i = bx * (NWAVES * 64) + tid; i < 2 * 64 * 64; i += G * NWAVES * 64) {
              const int ln = i & 63, k0 = (i >> 6) & 63, eh = i >> 12; const int e = eh * 32 + (ln & 31), kb = 16 * k0 + 8 * (ln >> 5);
              float wv[8]; unsigned ph[4], pl[4];
#pragma unroll
              for (int j = 0; j < 8; ++j) wv[j] = w_router[(size_t)(kb + j) * NE + e];
#pragma unroll
              for (int j = 0; j < 4; ++j) { ph[j] = pk2(wv[2 * j], wv[2 * j + 1]); pl[j] = pk2(wv[2 * j] - __uint_as_float(ph[j] << 16), wv[2 * j + 1] - __uint_as_float(ph[j] & 0xffff0000u)); }
              v4u hv; hv.x = ph[0]; hv.y = ph[1]; hv.z = ph[2]; hv.w = ph[3]; v4u lv; lv.x = pl[0]; lv.y = pl[1]; lv.z = pl[2]; lv.w = pl[3];
              *(GAS v4u*)(WRFw + ((size_t)((0 + eh) * 64 + k0) * 64 + ln) * 4) = hv; *(GAS v4u*)(WRFw + ((size_t)((2 + eh) * 64 + k0) * 64 + ln) * 4) = lv;
          } }
        }
        if (BOTH(0)) GRID_BAR();
    }

    TSTAMP(1);
    if (IN(1)) {
        const float* qna = args.in[3]; const float* kna = args.in[4]; const float* qnb = args.in[5]; const float* knb = args.in[6]; const float* b_gate = args.in[10]; bf16* Gb = PROBE_RR ? (bf16*)(ws + WS_H) : (bf16*)args.out; bf16* XN = (bf16*)(ws + WS_XN); bf16* WIN_t = (bf16*)(ws + WS_WIN); float* LOGF = (float*)(ws + WS_LOGF); float* Cc = (float*)(ws + WS_C); bf16* KAUG = (bf16*)(ws + WS_KAUG); int* FT0 = (int*)(ws + WS_FT0); const float* wg_e = args.in[17]; const float* wu_e = args.in[18]; const float* wg_s = args.in[20]; const float* wu_s = args.in[21]; bf16* W1 = (bf16*)(ws + WS_W1);
        _Pragma("unroll") for (int rep_ = 0; rep_ < 1; ++rep_) {
        if (G >= 16 && bx >= G - 16) p1_cumsum(bx - (G - 16), LOGF, Cc, KAUG, (LAS float*)(L + RING_OFF), tid, qnb, knb, FT0);
        else if (G < 16 && bx == 0) for (int bh = 0; bh < 16; ++bh) p1_cumsum(bh, LOGF, Cc, KAUG, (LAS float*)(L + RING_OFF), tid, qnb, knb, FT0);
        pg8::Gemm g{XN, WIN_t, M, NTOT1, D}; pg8::RepOrder S; S.init(M, NTOT1, G, bx); S.nrep = NREP(1);
        pg8::EpiQKVG E{ws, Gb, qna, kna, qnb, knb, b_gate};
        pg8::gemm_phase<pg8::EpiQKVG, pg8::RepOrder, true, true>(L + RING_OFF, g, S, E);
        { const int nfull = (M / 256) * (NTOT1 / 256) % G;
          if (nfull != 0 && bx >= nfull) { const int nw = (G - nfull) * NWAVES; for (int it = (bx - nfull) * NWAVES + wave; it < N_FILL1; it += nw) conv_w1_item(it, wg_e, wu_e, wg_s, wu_s, W1, (LAS unsigned*)(L + RING_OFF + wave * 8704), lane); }
          else if (nfull == 0) { for (int it = bx * NWAVES + wave; it < N_FILL1; it += G * NWAVES) conv_w1_item(it, wg_e, wu_e, wg_s, wu_s, W1, (LAS unsigned*)(L + RING_OFF + wave * 8704), lane); } }
        }
        if (BOTH(1)) GRID_BAR();
    }


    TSTAMP(2);
    if (IN(2)) {
        float* Cc = (float*)(ws + WS_C); bf16* KAUG = (bf16*)(ws + WS_KAUG); float* BIAS = (float*)(ws + WS_BIAS); int* FT0 = (int*)(ws + WS_FT0); const float* wd_e = args.in[19]; const float* wd_s = args.in[22]; bf16* W2 = (bf16*)(ws + WS_W2); const float* wg_e = args.in[17]; const float* wu_e = args.in[18]; const float* wg_s = args.in[20]; const float* wu_s = args.in[21]; bf16* W1 = (bf16*)(ws + WS_W1);
        _Pragma("unroll") for (int rep_ = 0; rep_ < NREP(2); ++rep_) { REP_BAR();
#ifdef RERUN_VARIANT
        if (!(PROBE_RR && RERUN_VARIANT >= 2))
#endif
        for (int au = VCU(); au < 2 * 4 * 32; au += G) {
            const int bb = au >> 7, hs = (au >> 5) & 3, blk = au & 31;
            dil::unit(bb, hs, blk, (const fox::bf16*)(ws + WS_QA), (const fox::bf16*)(ws + WS_KA), (const fox::bf16*)(ws + WS_VA), BIAS,
                      (fox::bf16*)(ws + WS_WIN), (fox::bf16*)(ws + WS_XN + 24 * MiB), (fox::bf16*)(ws + WS_LIST), (float*)(ws + WS_WIN + 8 * MiB), (fox::bf16*)(ws + WS_YA),
                      (char*)lds + RING_OFF, (float*)((char*)lds + LDSCTL_OFF + 8192), (float*)((char*)lds + LDSCTL_OFF + 12288), (unsigned*)(ctl + CW_APAIR + 32 * ((bb * 4 + hs) * 16 + (blk >> 1))), DIL_GMASK);
        }
        if (tid < 16) { const int my = FT0[512 + tid]; int rank = 0;
            for (int o = 0; o < 16; ++o) { const int c2 = FT0[512 + o]; rank += (c2 > my || (c2 == my && o < tid)) ? 1 : 0; }
            MISC[24 + rank] = (unsigned)tid; }
        __syncthreads();
        gu32* qhead = ctl + CW_Q2 + 64 * rep_ + 128 * args.li;
        if (tid == 0) MISC[16] = (unsigned)VCU();
        __syncthreads();
        for (;;) {
            const unsigned u = MISC[16];
            __syncthreads();
            constexpr unsigned NFCH = (unsigned)((N_W2 + N_FILL2 + 31) / 32);
            if (u >= 512u + NFCH) break;
            int fox_u = -1, fill_c = -1;
            { const unsigned v = u; if (v < 2u * NFCH) { if ((v & 1u) == 0u) fox_u = (int)(v >> 1); else fill_c = (int)(v >> 1); } else fox_u = (int)(v - NFCH); }
            static_assert((N_W2 + N_FILL2 + 31) / 32 <= 512, "filler chunks interleave one per FoX unit");
#ifdef RERUN_VARIANT
            const bool skip_ = PROBE_RR && ((RERUN_VARIANT == 1) || (RERUN_VARIANT == 2 && fox_u < 0) || (RERUN_VARIANT == 3 && fox_u >= 0));
#else
            const bool skip_ = false;
#endif
            unsigned nxt_u = 0u; if (tid == 0) nxt_u = __hip_atomic_fetch_add(qhead, 1u, RLX_AGENT) + (unsigned)G;
            if (skip_) {
            } else if (fill_c >= 0) {
                for (int k4 = 0; k4 < 4; ++k4) {
                const int r = fill_c * 32 + k4 * 8 + wave;
                if (r >= N_W2) { if (r < N_W2 + N_FILL2) conv_w1_item(N_FILL1 + r - N_W2, wg_e, wu_e, wg_s, wu_s, W1, (LAS unsigned*)(L + RING_OFF + wave * 8704), lane); }
                else { const int e = r >> 6, qq = r & 63, kb = qq >> 4, nb = qq & 15; const float* src = (e < NE) ? wd_e + (size_t)e * DE * D : wd_s;
                    p0_tr64(src, D, 64 * kb, 64 * nb, W2 + (size_t)e * D * DE, DE, 256 * (nb >> 2) + 32 * (nb & 3), 128, (LAS unsigned*)(L + RING_OFF + wave * 8704), lane); }
                }
            } else {
                const int fu = fox_u; const int bh = __builtin_amdgcn_readfirstlane((int)MISC[24 + (fu >> 5)]), qb = 31 - (fu & 31); const int T0 = __builtin_amdgcn_readfirstlane(FT0[bh * 32 + qb]);
                fox::attn_unit<8>(bh >> 3, bh & 7, qb, T0, (const fox::bf16*)(ws + WS_QB), (const fox::bf16*)(ws + WS_KB), (const fox::bf16*)(ws + WS_VB), (const fox::bf16*)KAUG, Cc + (size_t)bh * SEQ,
                                  (fox::bf16*)(ws + WS_YB), (char*)lds + RING_OFF);
            }
            if (tid == 0) MISC[16] = nxt_u;
            __syncthreads();
        }
        }
        if (BOTH(2)) GRID_BAR();
    }
    TSTAMP(3);
    if (IN(3)) {
        const float* x = args.in[0]; bf16* Gb = PROBE_RR ? (bf16*)(ws + WS_H) : (bf16*)args.out; bf16* WPA_t = (bf16*)(ws + WS_WIN) + (size_t)NTOT1 * D; bf16* WPB_t = (bf16*)(ws + WS_WIN) + (size_t)NTOT1 * D + (size_t)D * OUTA;
        _Pragma("unroll") for (int rep_ = 0; rep_ < 1; ++rep_) {
        bf16* YAb = (bf16*)(ws + WS_YA); bf16* YBb = (bf16*)(ws + WS_YB); bf16* MG = (bf16*)(ws + WS_MERGED); bf16* TMPM = (bf16*)(ws + WS_R2 + 32 * MiB);
        pg8::RepOrder S; S.init(M, D, G, bx); S.nrep = NREP(3);
        { pg8::Gemm g{YAb, WPA_t, M, D, OUTA}; pg8::EpiMergeA E{Gb, TMPM}; pg8::gemm_phase<pg8::EpiMergeA, pg8::RepOrder, true, true>(L + RING_OFF, g, S, E); }
        { pg8::Gemm g{YBb, WPB_t, M, D, OUTB}; pg8::EpiMergeB E{Gb, TMPM, MG}; pg8::gemm_phase<pg8::EpiMergeB, pg8::RepOrder, true, true>(L + RING_OFF, g, S, E); }
        }
        if (BOTH(3)) GRID_BAR();
    }
    TSTAMP(4);
    if (IN(4)) {
        const float* x = args.in[0]; const float* g_ffn = args.in[14]; float* out_w = PROBE_RR ? (float*)(ws + WS_H) : args.out; bf16* WOUT_t = (bf16*)(ws + WS_WIN) + (size_t)NTOT1 * D + (size_t)D * OUTA + (size_t)D * OUTB;
        _Pragma("unroll") for (int rep_ = 0; rep_ < 1; ++rep_) {
        bf16* MG = (bf16*)(ws + WS_MERGED);
        pg8::Gemm g{MG, WOUT_t, M, D, D}; pg8::RepOrder S; S.init(M, D, G, bx); S.nrep = NREP(4);
        pg8::EpiResF32 E{x, out_w};
        pg8::gemm_phase<pg8::EpiResF32, pg8::RepOrder, true, true>(L + RING_OFF, g, S, E);
        }
        if (BOTH(4)) GRID_BAR();
        _Pragma("unroll") for (int xb_ = 0; xb_ < EXTRA_BARRIERS; ++xb_) GRID_BAR();
    }


    TSTAMP(5);
    if (IN(5)) {
        const float* g_ffn = args.in[14]; const float* router_bias = args.in[16]; float* out = args.out;
        _Pragma("unroll") for (int rep_ = 0; rep_ < NREP(5); ++rep_) { REP_BAR();
        for (int tb0 = bx * 2; tb0 < M / 32; tb0 += G * 2) {
            const int grp = wave >> 2, t = tb0 + grp;
            rtr::task(t, wave & 3, t < M / 32, out, g_ffn, (const unsigned short*)(ws + WS_WRF), router_bias, (unsigned short*)(ws + WS_H2), (float*)(ws + WS_RINV), (unsigned*)(ctl + CW_CNT), (unsigned*)(ws + WS_LIST),
                      (float*)(ws + WS_GATEW), (float2*)(ws + WS_META), (unsigned*)(ws + WS_INV), (float*)((char*)lds + RING_OFF + grp * 40960), (float*)((char*)lds + RING_OFF + 81920 + grp * 512), (LAS unsigned*)(L + RING_OFF + 90112));
            __syncthreads();
        }
        }
        if (BOTH(5)) GRID_BAR();
    }
    TSTAMP(6);
    if (IN(6)) {
        bf16* W1 = (bf16*)(ws + WS_W1);
        _Pragma("unroll") for (int rep_ = 0; rep_ < NREP(6); ++rep_) { REP_BAR();
        moe_tables(L, ctl + CW_CNT, tid);
        pg8::MoeSched S{(const LAS unsigned*)(L + TB_T6), (const LAS unsigned*)(L + TB_CNT), (const LAS unsigned*)(L + TB_HB), 65, 1, 0, 2, G, VCU(), D,
                        (const void*)(ws + WS_H2), W1, (size_t)512 * D, 1, (const unsigned*)(ws + WS_LIST), 0, (LAS int*)(L + TB_UT)};
        S.build_table(); __syncthreads();
        pg8::EpiMoe1 E{(const pg8::f32x2m*)(ws + WS_META), (const float*)(ws + WS_RINV), (bf16*)(ws + WS_H), (bf16*)(ws + WS_HS)};
        pg8::gemm_phase2<pg8::EpiMoe1, pg8::MoeSched, true>(L + RING_OFF, D, S, E, L + LDSCTL_OFF + 8192);
        }
        if (BOTH(6)) GRID_BAR();
    }
    TSTAMP(7);
    if (IN(7)) {
        bf16* W2 = (bf16*)(ws + WS_W2);
        _Pragma("unroll") for (int rep_ = 0; rep_ < NREP(7); ++rep_) { REP_BAR();
        if (!IN(6)) moe_tables(L, ctl + CW_CNT, tid);
        pg8::MoeSched S{(const LAS unsigned*)(L + TB_T6), (const LAS unsigned*)(L + TB_CNT), (const LAS unsigned*)(L + TB_HB), 64, 1, 0, 4, G, VCU(), DE,
                        (const void*)(ws + WS_H), W2, (size_t)D * DE, 1, (const unsigned*)(ws + WS_LIST), 1, (LAS int*)(L + TB_UT)};
        S.build_table(); __syncthreads();
        pg8::EpiMoe2 E{(unsigned char*)(ws + WS_Y)};
        pg8::gemm_phase2<pg8::EpiMoe2, pg8::MoeSched, true>(L + RING_OFF, DE, S, E, L + LDSCTL_OFF + 8192);
        }
        if (BOTH(7)) GRID_BAR();
    }
    TSTAMP(8);
    TSTAMP(9);
    if (IN(9)) {
        float* out = args.out; float* out_w = PROBE_RR ? (float*)(ws + WS_H) : args.out; bf16* W2 = (bf16*)(ws + WS_W2);
        _Pragma("unroll") for (int rep_ = 0; rep_ < NREP(9); ++rep_) { REP_BAR();
        if (!IN(6)) moe_tables(L, ctl + CW_CNT, tid);
        if (G == 256) {
            pg8::Gemm g{(const bf16*)(ws + WS_HS), W2 + (size_t)NE * D * DE, M, D, DE}; pg8::StaticOrder S; S.init(M, D, G, bx);
            pg8::EpiFinalD E{(const unsigned char*)(ws + WS_Y), (const unsigned*)(ws + WS_INV), (const LAS unsigned*)(L + TB_HB), out, (NREP(9) == 2 && rep_ == 0) ? (float*)(ws + WS_H) : out_w};
            pg8::gemm_phase<pg8::EpiFinalD, pg8::StaticOrder, false, true>(L + RING_OFF, g, S, E);
        } else {
        pg8::MoeSched S{(const LAS unsigned*)(L + TB_T9), (const LAS unsigned*)(L + TB_CNT), (const LAS unsigned*)(L + TB_HB), 1, 0, 128, 4, G, VCU(), DE,
                        (const void*)(ws + WS_HS), W2, (size_t)D * DE, 0, (const unsigned*)(ws + WS_LIST), 1, (LAS int*)(L + TB_UT)};
        S.build_table(); __syncthreads();
        pg8::EpiFinal E{(const unsigned char*)(ws + WS_Y), (const unsigned*)(ws + WS_INV), (const LAS unsigned*)(L + TB_HB), out, (NREP(9) == 2 && rep_ == 0) ? (float*)(ws + WS_H) : out_w};
        pg8::gemm_phase2<pg8::EpiFinal, pg8::MoeSched, true>(L + RING_OFF, DE, S, E, L + LDSCTL_OFF + 8192);
        }
        }
    }
    TSTAMP(NPHASE);
#undef IN
#undef BOTH
}

#ifdef DIAG_TS
__global__ void k_diag_ts(float* out, const unsigned long long* ts) {
    const float tot = floorf((float)(ts[NPHASE] - ts[0]) * 0.01f / 50.f + 0.5f) * 50.f, bw = floorf((float)ts[20] * 0.01f / 20.f + 0.5f) * 20.f;
    const size_t idx = (size_t)blockIdx.x * 256 + threadIdx.x;
    float v = out[idx] * (1.f + sqrtf(tot / 2000.f));
    if (idx == 0) v += 50.f + bw * 0.5f;
    out[idx] = v;
}
#endif
extern "C" void kernel_launch(void* const* d_in, const int* in_sizes, int n_in, void* d_out, int out_size, void* d_ws, size_t ws_size, hipStream_t stream) {
    static int grid = 0;
    if (grid == 0) {
        if (n_in != 23 || out_size != M * D || ws_size < WS_END) { fprintf(stderr, "kernel_launch: unexpected shapes / workspace (%d inputs, out %d, ws %zu)\n", n_in, out_size, ws_size); grid = -1; return; }
        int dev = 0, cus = 0;
        if (hipGetDevice(&dev) != hipSuccess || hipDeviceGetAttribute(&cus, hipDeviceAttributeMultiprocessorCount, dev) != hipSuccess) { grid = -1; return; }
        if (hipFuncSetAttribute((const void*)mega, hipFuncAttributeMaxDynamicSharedMemorySize, LDS_BYTES) != hipSuccess) { fprintf(stderr, "kernel_launch: hipFuncSetAttribute failed\n"); grid = -1; return; }
        int per_cu = 0;
        if (hipOccupancyMaxActiveBlocksPerMultiprocessor(&per_cu, (const void*)mega, NWAVES * 64, LDS_BYTES) != hipSuccess || per_cu < 1) fprintf(stderr, "kernel_launch: occupancy query says %d\n", per_cu);
        (void)hipGetLastError();
        grid = cus;
    }
    if (grid < 0) return;
    const float* x = (const float*)d_in[0];
    const float* qnb = (const float*)d_in[5]; const float* knb = (const float*)d_in[6];
    const float* wpa = (const float*)d_in[11]; const float* wpb = (const float*)d_in[12]; const float* w_out = (const float*)d_in[13]; const float* g_ffn = (const float*)d_in[14];
    const float* w_router = (const float*)d_in[15]; const float* router_bias = (const float*)d_in[16]; const float* wg_e = (const float*)d_in[17]; const float* wu_e = (const float*)d_in[18];
    const float* wd_e = (const float*)d_in[19]; const float* wg_s = (const float*)d_in[20]; const float* wu_s = (const float*)d_in[21]; const float* wd_s = (const float*)d_in[22];
    unsigned char* ws = (unsigned char*)d_ws; float* out = (float*)d_out;
    bf16_t* G = (bf16_t*)d_out;
    unsigned* CTL = (unsigned*)(ws + WS_CTL);
    #ifdef RERUN_PHASE
    (void)hipMemsetAsync(ws + WS_CTL, 0, 256 * KiB, stream);
#else
    (void)hipMemsetAsync(ws + WS_CTL, 0, 64 * KiB, stream);
#endif
    MArgs a{};
    for (int i = 0; i < 23; ++i) a.in[i] = (const float*)d_in[i];
    a.out = out; a.ws = ws;
    a.ph_lo = 0; a.ph_hi = NPHASE; a.li = 0;
    hipLaunchKernelGGL(mega, dim3(grid), dim3(NWAVES * 64), LDS_BYTES, stream, a);
#ifdef RERUN_PHASE
    a.ph_lo = RERUN_PHASE; a.ph_hi = RERUN_PHASE + RERUN_COUNT; a.li = 1;
    hipLaunchKernelGGL(mega, dim3(grid), dim3(NWAVES * 64), LDS_BYTES, stream, a);
#endif
#ifdef DIAG_TS
    k_diag_ts<<<M * D / 256, 256, 0, stream>>>(out, (const unsigned long long*)(ws + WS_CTL + 512 * 1024));
#endif
}
```

```cpp
#include <hip/hip_runtime.h>
#include <hip/hip_bf16.h>
#include <cstdint>
#include <cstdio>

typedef unsigned short bf16_t;
typedef unsigned u32x4 __attribute__((ext_vector_type(4)));
typedef unsigned u32x2 __attribute__((ext_vector_type(2)));

constexpr int BATCH = 2, SEQ = 8192, M = BATCH * SEQ, D = 1024;
constexpr int HA = 12, HB = 8, HD = 64;
constexpr int WA = 3 * HA * HD, WB = 3 * HB * HD, DIN = WA + WB + HB;
constexpr int PA = HA * HD, PB = HB * HD;
constexpr int OUTA = 256, OUTB = 512;
constexpr int NE = 64, TOPK = 8, DE = 256;
constexpr int NLIST = 2 * NE;
constexpr float EPS = 1e-6f;
constexpr float LOG2E = 1.4426950408889634f;
constexpr float QSCALE = 0.125f * LOG2E;

constexpr size_t MiB = 1u << 20, KiB = 1u << 10;
constexpr size_t WS_CTL = 0;
constexpr size_t WS_LOGF = 1 * MiB;
constexpr size_t WS_C = 1 * MiB + 512 * KiB;
constexpr size_t WS_KAUG = 2 * MiB;
constexpr size_t WS_LIST = 4 * MiB;
constexpr size_t WS_GATEW = 12 * MiB;
constexpr size_t WS_BIAS = 12 * MiB + 512 * KiB;
constexpr size_t WS_FT0 = WS_BIAS + 8 * KiB;
constexpr size_t WS_WRF = WS_BIAS + 64 * KiB;
constexpr size_t WS_RINV = WS_BIAS + 384 * KiB;
constexpr size_t WS_W2 = 13 * MiB;
constexpr size_t WS_R1 = 45 * MiB + 512 * KiB;
constexpr size_t WS_W1 = WS_R1;
constexpr size_t WS_WIN = WS_R1 + 65 * MiB;
constexpr size_t WS_XN = WS_R1 + 80 * MiB;
constexpr size_t WS_YA = WS_XN;
constexpr size_t WS_YB = WS_XN + 8 * MiB;
constexpr size_t WS_H2 = WS_XN;
constexpr size_t WS_QB = WS_R1 + 112 * MiB;
constexpr size_t WS_R2 = WS_R1 + 128 * MiB;
constexpr size_t WS_QA = WS_R2;
constexpr size_t WS_KA = WS_R2 + 24 * MiB;
constexpr size_t WS_VA = WS_R2 + 48 * MiB;
constexpr size_t WS_KB = WS_R2 + 72 * MiB;
constexpr size_t WS_VB = WS_R2 + 88 * MiB;
constexpr size_t WS_MERGED = WS_R2;
constexpr size_t WS_H = WS_R2;
constexpr size_t WS_HS = WS_R2 + 65 * MiB;
constexpr size_t WS_Y = WS_R1;
constexpr size_t WS_META = WS_R2 + 80 * MiB;
constexpr size_t WS_INV = WS_R2 + 96 * MiB;
constexpr size_t WS_END = WS_R2 + 104 * MiB;
constexpr int CW_APAIR = 12288;
constexpr int CW_Q2 = 1536;
constexpr int CW_CNT = 8192, CNT_STRIDE = 32;

__device__ __forceinline__ float bf2f(bf16_t v) { return __uint_as_float((unsigned)v << 16); }
__device__ __forceinline__ unsigned f2bf(float f) { unsigned u = __float_as_uint(f); return (u + 0x7fffu + ((u >> 16) & 1u)) >> 16; }
__device__ __forceinline__ unsigned pk2(float lo, float hi) { return f2bf(lo) | (f2bf(hi) << 16); }
__device__ __forceinline__ float wave_sum(float v) {
#pragma unroll
    for (int o = 1; o < 64; o <<= 1) v += __shfl_xor(v, o);
    return v;
}
__device__ __forceinline__ float wave_max(float v) {
#pragma unroll
    for (int o = 1; o < 64; o <<= 1) v = fmaxf(v, __shfl_xor(v, o));
    return v;
}

typedef unsigned short bf16_t_dummy_;
namespace pg8 {
#define PG8_LAS __attribute__((address_space(3)))
typedef unsigned short bf16_t;
typedef short bf16x8 __attribute__((ext_vector_type(8)));
typedef float f32x4 __attribute__((ext_vector_type(4)));
typedef unsigned u32x4 __attribute__((ext_vector_type(4)));
constexpr int BM = 256, BK = 64, HALF = 128, HTB = HALF * BK * 2  , STAGE_BYTES = 8 * HTB, NXCD = 8, WGM = 8;

__host__ __device__ __forceinline__ int lds_byte(int r, int c) { const int st = (r >> 4) * 2 + (c >> 5), rr = r & 15, cc = c & 31, ob = rr * 64 + cc * 2; return st * 1024 + (ob ^ (((ob >> 9) & 1) << 5)); }
__host__ __device__ __forceinline__ void stage_rc(int b, int& R, int& C) { const int st = b / 1024, sb = b % 1024, swz = sb ^ (((sb >> 9) & 1) << 5); R = (st >> 1) * 16 + swz / 64; C = (st & 1) * 32 + (swz % 64) / 2; }
__host__ __device__ __forceinline__ int perm32(int rho) { const int n = rho >> 4, i = rho & 15; return 8 * (i >> 2) + 4 * n + (i & 3); }

struct Unit { int pm, pn; };
struct Gemm { const bf16_t* A; const bf16_t* Bt; int M, N, K; };

struct StaticOrder {
    int nM, nN, nwg, G, c;
    __host__ __device__ void init(int M, int N, int G_, int c_) { nM = M / BM; nN = N / BM; nwg = nM * nN; G = G_; c = c_; }
    __host__ __device__ bool next(int i, Unit& u) const {
        const long L = (long)i * G + c; if (L >= nwg) return false;
        int wgid = (int)L; { const int q = nwg / NXCD, r = nwg % NXCD, xcd = wgid % NXCD, off = wgid / NXCD; wgid = (xcd < r ? xcd * (q + 1) : r * (q + 1) + (xcd - r) * q) + off; }
        const int nig = WGM * nN, gid = wgid / nig, fm = gid * WGM, gsz = (nM - fm) < WGM ? (nM - fm) : WGM;
        u.pm = fm + ((wgid % nig) % gsz); u.pn = (wgid % nig) / gsz; return true;
    }
    __device__ __forceinline__ void a_ready(const Unit&) const {}
    __device__ __forceinline__ void done(const Unit&) const {}
};

__device__ __forceinline__ unsigned cvt_pk_bf16(float lo, float hi) { unsigned r; asm volatile("v_cvt_pk_bf16_f32 %0, %1, %2" : "=v"(r) : "v"(lo), "v"(hi)); return r; }
typedef float f32x2 __attribute__((ext_vector_type(2)));
struct RepOrder : StaticOrder { int nrep;
    __device__ __forceinline__ bool next(int i, Unit& u) const { const int per = (nwg - c + G - 1) / G; if (per <= 0 || i >= per * nrep) return false; return StaticOrder::next(i % per, u); } };
typedef float f32x2_c __attribute__((ext_vector_type(2))); typedef __bf16 bf16x2_c __attribute__((ext_vector_type(2)));
__device__ __forceinline__ unsigned cvtc(float lo, float hi) { f32x2_c v = {lo, hi}; bf16x2_c b = __builtin_convertvector(v, bf16x2_c); return __builtin_bit_cast(unsigned, b); }
struct EpiQKVG {
    static constexpr bool PERM = true, AFTER_DRAIN = false;
    unsigned char* ws; bf16_t* G; const float *qna, *kna, *qnb, *knb, *b_gate;
    __device__ __forceinline__ void operator()(const f32x4 (&acc)[2][2][4][2], const Unit& u, int wr, int wc, int fr, int fq) const {
        const int pn = u.pn; const int row0 = u.pm * BM + wr * 64 + fr;
        if (pn >= 15) {
            const int col0 = (pn - 15) * 256 + wc * 32 + 8 * fq;
            f32x4 bv[2][2];
#pragma unroll
            for (int bj = 0; bj < 2; ++bj)
#pragma unroll
                for (int n = 0; n < 2; ++n) bv[bj][n] = *(const f32x4*)(b_gate + col0 + bj * HALF + 4 * n);
#pragma unroll
            for (int ai = 0; ai < 2; ++ai)
#pragma unroll
                for (int m = 0; m < 4; ++m) { bf16_t* rowp = G + (size_t)(row0 + ai * HALF + m * 16) * 2048 + col0;
#pragma unroll
                    for (int bj = 0; bj < 2; ++bj) { f32x4 v0 = acc[ai][bj][m][0] + bv[bj][0], v1 = acc[ai][bj][m][1] + bv[bj][1];
#pragma unroll
                        for (int i = 0; i < 4; ++i) { v0[i] = __builtin_amdgcn_rcpf(1.f + __builtin_amdgcn_exp2f(-1.4426950408889634f * v0[i])); v1[i] = __builtin_amdgcn_rcpf(1.f + __builtin_amdgcn_exp2f(-1.4426950408889634f * v1[i])); }
                        u32x4 w; w.x = cvtc(v0[0], v0[1]); w.y = cvtc(v0[2], v0[3]); w.z = cvtc(v1[0], v1[1]); w.w = cvtc(v1[2], v1[3]);
                        *(u32x4*)(rowp + bj * HALF) = w; } }
        } else {
            bf16_t* dst; int ld, hb; const float* g = nullptr; float sc = 1.f;
            if (pn < 3) { dst = (bf16_t*)(ws + WS_QA); ld = PA; hb = 4 * pn; g = qna; sc = QSCALE; }
            else if (pn < 6) { dst = (bf16_t*)(ws + WS_KA); ld = PA; hb = 4 * (pn - 3); g = kna; }
            else if (pn < 9) { dst = (bf16_t*)(ws + WS_VA); ld = PA; hb = 4 * (pn - 6); }
            else if (pn < 11) { dst = (bf16_t*)(ws + WS_QB); ld = PB; hb = 4 * (pn - 9); g = qnb; sc = QSCALE; }
            else if (pn < 13) { dst = (bf16_t*)(ws + WS_KB); ld = PB; hb = 4 * (pn - 11); g = knb; }
            else { dst = (bf16_t*)(ws + WS_VB); ld = PB; hb = 4 * (pn - 13); }
            const int colb = (hb + wc) * 64 + 8 * fq;
            f32x4 gv[2][2];
#pragma unroll
            for (int bj = 0; bj < 2; ++bj)
#pragma unroll
                for (int n = 0; n < 2; ++n) gv[bj][n] = g ? *(const f32x4*)(g + 32 * bj + 8 * fq + 4 * n) : (f32x4){1.f, 1.f, 1.f, 1.f};
#pragma unroll
            for (int ai = 0; ai < 2; ++ai)
#pragma unroll
                for (int m = 0; m < 4; ++m) {
                    float rinv = 1.f;
                    if (g) { float ss = 0.f;
#pragma unroll
                        for (int bj = 0; bj < 2; ++bj)
#pragma unroll
                            for (int n = 0; n < 2; ++n) { const f32x4 x = acc[ai][bj][m][n]; ss += (x[0] * x[0] + x[1] * x[1]) + (x[2] * x[2] + x[3] * x[3]); }
                        ss += __shfl_xor(ss, 16); ss += __shfl_xor(ss, 32);
                        rinv = __builtin_amdgcn_rsqf(ss * (1.f / 64.f) + EPS) * sc; }
                    bf16_t* rowp = dst + (size_t)(row0 + ai * HALF + m * 16) * ld + colb;
#pragma unroll
                    for (int bj = 0; bj < 2; ++bj) { const f32x4 v0 = acc[ai][bj][m][0] * rinv * gv[bj][0], v1 = acc[ai][bj][m][1] * rinv * gv[bj][1];
                        u32x4 w; w.x = cvtc(v0[0], v0[1]); w.y = cvtc(v0[2], v0[3]); w.z = cvtc(v1[0], v1[1]); w.w = cvtc(v1[2], v1[3]);
                        *(u32x4*)(rowp + 32 * bj) = w; } }
        }
    }
};
struct EpiMergeA {
    static constexpr bool PERM = true, AFTER_DRAIN = false;
    const bf16_t* G; bf16_t* T; unsigned goff;
    __device__ __forceinline__ void operator()(const f32x4 (&acc)[2][2][4][2], const Unit& u, int wr, int wc, int fr, int fq) const {
        const unsigned row0 = (unsigned)(u.pm * BM + wr * 64 + fr), col0 = (unsigned)(u.pn * BM + wc * 32 + 8 * fq);
#pragma unroll
        for (int ai = 0; ai < 2; ++ai) {
            u32x4 g[4][2];
#pragma unroll
            for (int m = 0; m < 4; ++m)
#pragma unroll
                for (int bj = 0; bj < 2; ++bj) g[m][bj] = *(const u32x4*)(G + ((row0 + ai * HALF + m * 16) * 2048u + goff + col0 + bj * HALF));
#pragma unroll
            for (int m = 0; m < 4; ++m)
#pragma unroll
                for (int bj = 0; bj < 2; ++bj) { const u32x4 gg = g[m][bj]; const f32x4 a0 = acc[ai][bj][m][0], a1 = acc[ai][bj][m][1];
                    u32x4 w;
                    w.x = cvtc(a0[0] * __uint_as_float(gg.x << 16), a0[1] * __uint_as_float(gg.x & 0xffff0000u)); w.y = cvtc(a0[2] * __uint_as_float(gg.y << 16), a0[3] * __uint_as_float(gg.y & 0xffff0000u));
                    w.z = cvtc(a1[0] * __uint_as_float(gg.z << 16), a1[1] * __uint_as_float(gg.z & 0xffff0000u)); w.w = cvtc(a1[2] * __uint_as_float(gg.w << 16), a1[3] * __uint_as_float(gg.w & 0xffff0000u));
                    *(u32x4*)(T + ((row0 + ai * HALF + m * 16) * 1024u + col0 + bj * HALF)) = w; }
            asm volatile("" ::: "memory");
        }
    }
};
struct EpiMergeB {
    static constexpr bool PERM = true, AFTER_DRAIN = false;
    const bf16_t* G; const bf16_t* T; bf16_t* O; unsigned goff;
    __device__ __forceinline__ void operator()(const f32x4 (&acc)[2][2][4][2], const Unit& u, int wr, int wc, int fr, int fq) const {
        const unsigned row0 = (unsigned)(u.pm * BM + wr * 64 + fr), col0 = (unsigned)(u.pn * BM + wc * 32 + 8 * fq);
#pragma unroll
        for (int ai = 0; ai < 2; ++ai)
#pragma unroll
          for (int mp = 0; mp < 2; ++mp) {
            u32x4 g[2][2], t[2][2];
#pragma unroll
            for (int mm = 0; mm < 2; ++mm)
#pragma unroll
                for (int bj = 0; bj < 2; ++bj) { const unsigned r = row0 + ai * HALF + (2 * mp + mm) * 16; g[mm][bj] = *(const u32x4*)(G + (r * 2048u + goff + col0 + bj * HALF)); t[mm][bj] = *(const u32x4*)(T + (r * 1024u + col0 + bj * HALF)); }
#pragma unroll
            for (int mm = 0; mm < 2; ++mm)
#pragma unroll
                for (int bj = 0; bj < 2; ++bj) { const int m = 2 * mp + mm; const u32x4 gg = g[mm][bj], tt = t[mm][bj]; const f32x4 a0 = acc[ai][bj][m][0], a1 = acc[ai][bj][m][1];
                    u32x4 w;
                    w.x = cvtc(__uint_as_float(tt.x << 16) + a0[0] * __uint_as_float(gg.x << 16), __uint_as_float(tt.x & 0xffff0000u) + a0[1] * __uint_as_float(gg.x & 0xffff0000u));
                    w.y = cvtc(__uint_as_float(tt.y << 16) + a0[2] * __uint_as_float(gg.y << 16), __uint_as_float(tt.y & 0xffff0000u) + a0[3] * __uint_as_float(gg.y & 0xffff0000u));
                    w.z = cvtc(__uint_as_float(tt.z << 16) + a1[0] * __uint_as_float(gg.z << 16), __uint_as_float(tt.z & 0xffff0000u) + a1[1] * __uint_as_float(gg.z & 0xffff0000u));
                    w.w = cvtc(__uint_as_float(tt.w << 16) + a1[2] * __uint_as_float(gg.w << 16), __uint_as_float(tt.w & 0xffff0000u) + a1[3] * __uint_as_float(gg.w & 0xffff0000u));
                    *(u32x4*)(O + ((row0 + ai * HALF + m * 16) * 1024u + col0 + bj * HALF)) = w; }
            asm volatile("" ::: "memory");
          }
    }
};
struct EpiResF32 {
    static constexpr bool PERM = false, AFTER_DRAIN = false;
    const float* X; float* O;
    __device__ __forceinline__ void operator()(const f32x4 (&acc)[2][2][4][2], const Unit& u, int wr, int wc, int fr, int fq) const {
        const unsigned row0 = (unsigned)(u.pm * BM + wr * 64 + fr), col0 = (unsigned)(u.pn * BM + wc * 32 + 4 * fq);
#pragma unroll
        for (int ai = 0; ai < 2; ++ai)
#pragma unroll
          for (int mp = 0; mp < 2; ++mp) {
            f32x4 xv[2][2][2];
#pragma unroll
            for (int mm = 0; mm < 2; ++mm)
#pragma unroll
                for (int bj = 0; bj < 2; ++bj)
#pragma unroll
                    for (int n = 0; n < 2; ++n) xv[mm][bj][n] = *(const f32x4*)(X + ((row0 + ai * HALF + (2 * mp + mm) * 16) * 1024u + col0 + bj * HALF + n * 16));
#pragma unroll
            for (int mm = 0; mm < 2; ++mm)
#pragma unroll
                for (int bj = 0; bj < 2; ++bj)
#pragma unroll
                    for (int n = 0; n < 2; ++n) *(f32x4*)(O + ((row0 + ai * HALF + (2 * mp + mm) * 16) * 1024u + col0 + bj * HALF + n * 16)) = xv[mm][bj][n] + acc[ai][bj][2 * mp + mm][n];
            asm volatile("" ::: "memory");
          }
    }
};
template <class Epi, class Sched, bool ALIGN_EPI = false, bool SP2 = false>
__device__ __forceinline__ void gemm_phase(PG8_LAS unsigned char* lds, const Gemm g, const Sched& S, const Epi& E) {
    int tid_ = threadIdx.x; asm volatile("" : "+v"(tid_));
    const int tid = tid_, wid = __builtin_amdgcn_readfirstlane(tid >> 6), lane = tid & 63, wr = wid >> 2, wc = wid & 3, fr = lane & 15, fq = lane >> 4;
    const int K = g.K, nt = K / BK;
    unsigned voffA[2], voffB[2];
#pragma unroll
    for (int i = 0; i < 2; ++i) { int R, C; stage_rc(tid * 16 + i * 8192, R, C); const int Rb = Epi::PERM ? ((R & ~31) + perm32(R & 31)) : R;
        voffA[i] = (unsigned)(R * K + C) * 2u; voffB[i] = (unsigned)(Rb * K + C) * 2u; }
    const size_t kstep = (size_t)(BK * 2);
    const size_t hstep = (size_t)HALF * K * 2;
    const size_t tstep = 2 * hstep;
    const unsigned ldsw = (unsigned)wid * 1024u;
    const int aoff = lds_byte(wr * 64 + fr, fq * 8), boff = lds_byte(wc * 32 + fr, fq * 8);
#define PG8_SA(b, h) (((b) * 2 + (h)) * HTB)
#define PG8_SB(b, h) ((4 + (b) * 2 + (h)) * HTB)
#define PG8_STAGE(bufoff, gbase, voff) do { _Pragma("unroll") for (int _i = 0; _i < 2; ++_i) \
        __builtin_amdgcn_global_load_lds((const unsigned*)((const char*)(gbase) + (voff)[_i]), (PG8_LAS unsigned*)(lds + (bufoff) + ldsw + _i * 8192), 16, 0, 0); } while (0)
#define PG8_LDA(dst, b, h) do { _Pragma("unroll") for (int m = 0; m < 4; ++m) _Pragma("unroll") for (int k = 0; k < 2; ++k) dst[m][k] = *(const PG8_LAS bf16x8*)(lds + PG8_SA(b, h) + aoff + m * 2048 + k * 1024); } while (0)
#define PG8_LDB(dst, b, h) do { _Pragma("unroll") for (int n = 0; n < 2; ++n) _Pragma("unroll") for (int k = 0; k < 2; ++k) dst[n][k] = *(const PG8_LAS bf16x8*)(lds + PG8_SB(b, h) + boff + n * 2048 + k * 1024); } while (0)
#define PG8_MMA(ai, bj, At, Bt) do { __builtin_amdgcn_s_setprio(1); _Pragma("unroll") for (int m = 0; m < 4; ++m) _Pragma("unroll") for (int n = 0; n < 2; ++n) _Pragma("unroll") for (int k = 0; k < 2; ++k) \
        acc[ai][bj][m][n] = __builtin_amdgcn_mfma_f32_16x16x32_bf16(Bt[n][k], At[m][k], acc[ai][bj][m][n], 0, 0, 0); __builtin_amdgcn_s_setprio(0); } while (0)
#define PG8_WAIT_V(n) asm volatile("s_waitcnt vmcnt(" #n ")" ::: "memory")
#define PG8_WAIT_L(n) asm volatile("s_waitcnt lgkmcnt(" #n ")" ::: "memory")
#define PG8_BAR __builtin_amdgcn_s_barrier()
#define PG8_SCHED __builtin_amdgcn_sched_barrier(0)
    Unit cur, nxt; int ui = 0;
    if (!S.next(0, cur)) return;
    f32x4 acc[2][2][4][2];
#pragma unroll
    for (int a = 0; a < 2; ++a)
#pragma unroll
        for (int b = 0; b < 2; ++b)
#pragma unroll
            for (int m = 0; m < 4; ++m)
#pragma unroll
                for (int n = 0; n < 2; ++n) acc[a][b][m][n] = (f32x4){0.f, 0.f, 0.f, 0.f};
    bf16x8 At[4][2], B0[2][2], B1[2][2];
    const char* cA = (const char*)g.A + (size_t)cur.pm * tstep; const char* cB = (const char*)g.Bt + (size_t)cur.pn * tstep;
    S.a_ready(cur);
    if constexpr (SP2) {
        PG8_STAGE(PG8_SB(0, 0), cB, voffB); PG8_STAGE(PG8_SB(0, 1), cB + hstep, voffB); PG8_STAGE(PG8_SA(0, 0), cA, voffA); PG8_STAGE(PG8_SA(0, 1), cA + hstep, voffA);
        if (wr == 1) PG8_BAR;
        PG8_WAIT_V(2); PG8_BAR;
        PG8_STAGE(PG8_SB(1, 0), cB + kstep, voffB); PG8_STAGE(PG8_SA(1, 0), cA + kstep, voffA); PG8_STAGE(PG8_SB(1, 1), cB + hstep + kstep, voffB);
        PG8_WAIT_V(6); PG8_BAR;
    } else {
        PG8_STAGE(PG8_SB(0, 0), cB, voffB); PG8_STAGE(PG8_SA(0, 0), cA, voffA); PG8_STAGE(PG8_SB(0, 1), cB + hstep, voffB); PG8_STAGE(PG8_SA(0, 1), cA + hstep, voffA);
        if (wr == 1) PG8_BAR;
        PG8_WAIT_V(4); PG8_BAR;
        PG8_STAGE(PG8_SB(1, 0), cB + kstep, voffB); PG8_STAGE(PG8_SA(1, 0), cA + kstep, voffA); PG8_STAGE(PG8_SB(1, 1), cB + hstep + kstep, voffB);
        PG8_WAIT_V(6); PG8_BAR;
    }
    for (;;) {
        const bool has_next = S.next(ui + 1, nxt);
        const char* nA = has_next ? (const char*)g.A + (size_t)nxt.pm * tstep : cA; const char* nB = has_next ? (const char*)g.Bt + (size_t)nxt.pn * tstep : cB;
        for (int t = 0; t < nt; t += 2) {
            const bool last = (t == nt - 2);
            const char* a1 = cA + (size_t)(t + 1) * kstep;
            const char* a2 = last ? nA : cA + (size_t)(t + 2) * kstep; const char* b2 = last ? nB : cB + (size_t)(t + 2) * kstep;
            const char* a3 = a2 + kstep; const char* b3 = b2 + kstep;
            if (last && has_next) S.a_ready(nxt);
            if constexpr (SP2) {
            PG8_LDB(B0, 0, 0); PG8_LDB(B1, 0, 1); PG8_SCHED; PG8_LDA(At, 0, 0); PG8_STAGE(PG8_SA(1, 1), a1 + hstep, voffA);
            PG8_WAIT_V(8); PG8_WAIT_L(0); PG8_BAR; PG8_MMA(0, 0, At, B0); PG8_MMA(0, 1, At, B1); PG8_BAR; PG8_SCHED;
            PG8_LDA(At, 0, 1); PG8_STAGE(PG8_SB(0, 0), b2, voffB); PG8_STAGE(PG8_SB(0, 1), b2 + hstep, voffB); PG8_STAGE(PG8_SA(0, 0), a2, voffA);
            PG8_WAIT_V(8); PG8_WAIT_L(0); PG8_BAR; PG8_MMA(1, 0, At, B0); PG8_MMA(1, 1, At, B1); PG8_BAR; PG8_SCHED;
            PG8_LDB(B0, 1, 0); PG8_LDB(B1, 1, 1); PG8_SCHED; PG8_LDA(At, 1, 0); PG8_STAGE(PG8_SA(0, 1), a2 + hstep, voffA);
            PG8_WAIT_V(8); PG8_WAIT_L(0); PG8_BAR; PG8_MMA(0, 0, At, B0); PG8_MMA(0, 1, At, B1); PG8_BAR; PG8_SCHED;
            PG8_LDA(At, 1, 1); PG8_STAGE(PG8_SB(1, 0), b3, voffB); PG8_STAGE(PG8_SB(1, 1), b3 + hstep, voffB); PG8_STAGE(PG8_SA(1, 0), a3, voffA);
            PG8_WAIT_V(8); PG8_WAIT_L(0); PG8_BAR; PG8_MMA(1, 0, At, B0); PG8_MMA(1, 1, At, B1); PG8_BAR; PG8_SCHED;
            } else {
            PG8_LDB(B0, 0, 0); PG8_SCHED; PG8_LDA(At, 0, 0); PG8_STAGE(PG8_SA(1, 1), a1 + hstep, voffA);
            PG8_WAIT_L(8); PG8_BAR; PG8_WAIT_L(0); PG8_MMA(0, 0, At, B0); PG8_BAR; PG8_SCHED;
            PG8_LDB(B1, 0, 1); PG8_STAGE(PG8_SB(0, 0), b2, voffB);
            PG8_BAR; PG8_WAIT_L(0); PG8_MMA(0, 1, At, B1); PG8_BAR;
            PG8_LDA(At, 0, 1); PG8_STAGE(PG8_SA(0, 0), a2, voffA);
            PG8_BAR; PG8_WAIT_L(0); PG8_MMA(1, 0, At, B0); PG8_BAR; PG8_SCHED;
            PG8_STAGE(PG8_SB(0, 1), b2 + hstep, voffB);
            PG8_WAIT_V(6); PG8_BAR; PG8_MMA(1, 1, At, B1); PG8_BAR;
            PG8_LDB(B0, 1, 0); PG8_SCHED; PG8_LDA(At, 1, 0); PG8_STAGE(PG8_SA(0, 1), a2 + hstep, voffA);
            PG8_WAIT_L(8); PG8_BAR; PG8_WAIT_L(0); PG8_MMA(0, 0, At, B0); PG8_BAR; PG8_SCHED;
            PG8_LDB(B1, 1, 1); PG8_STAGE(PG8_SB(1, 0), b3, voffB);
            PG8_BAR; PG8_WAIT_L(0); PG8_MMA(0, 1, At, B1); PG8_BAR;
            PG8_LDA(At, 1, 1); PG8_STAGE(PG8_SA(1, 0), a3, voffA);
            PG8_BAR; PG8_WAIT_L(0); PG8_MMA(1, 0, At, B0); PG8_BAR; PG8_SCHED;
            PG8_STAGE(PG8_SB(1, 1), b3 + hstep, voffB);
            PG8_WAIT_V(6); PG8_BAR; PG8_MMA(1, 1, At, B1); PG8_BAR;
            }
        }
        if constexpr (ALIGN_EPI) { if (wr == 0) PG8_BAR; }
        if constexpr (!Epi::AFTER_DRAIN) { E(acc, cur, wr, wc, fr, fq); S.done(cur); }
        if (!has_next) break;
#pragma unroll
        for (int a = 0; a < 2; ++a)
#pragma unroll
            for (int b = 0; b < 2; ++b)
#pragma unroll
                for (int m = 0; m < 4; ++m)
#pragma unroll
                    for (int n = 0; n < 2; ++n) acc[a][b][m][n] = (f32x4){0.f, 0.f, 0.f, 0.f};
        cur = nxt; cA = nA; cB = nB; ++ui;
        if constexpr (ALIGN_EPI) { if (wr == 1) PG8_BAR; }
    }
    PG8_WAIT_V(0);
    if constexpr (!ALIGN_EPI) { if (wr == 0) PG8_BAR; }
    PG8_BAR;
    if constexpr (Epi::AFTER_DRAIN) { E.fused(acc, cur, wr, wc, fr, fq, lds, wid, lane); S.done(cur); }
#undef PG8_SA
#undef PG8_SB
#undef PG8_STAGE
#undef PG8_LDA
#undef PG8_LDB
#undef PG8_MMA
#undef PG8_WAIT_V
#undef PG8_WAIT_L
#undef PG8_BAR
#undef PG8_SCHED
}
struct Unit2 { int pm, pn, l, cnt, split; unsigned hb; };
template <class Epi, class Sched, bool ALIGN_EPI>
__device__ __forceinline__ void gemm_phase2(PG8_LAS unsigned char* lds, const int K, const Sched& S, const Epi& E, PG8_LAS unsigned char* aux  ) {
    int tid_ = threadIdx.x; asm volatile("" : "+v"(tid_));
    const int tid = tid_, wid = __builtin_amdgcn_readfirstlane(tid >> 6), lane = tid & 63, wr = wid >> 2, wc = wid & 3, fr = lane & 15, fq = lane >> 4;
    const int nt = K / BK;
    int Rr[2], Cc[2]; unsigned voffB[2];
#pragma unroll
    for (int i = 0; i < 2; ++i) { int R, C; stage_rc(tid * 16 + i * 8192, R, C); const int Rb = Epi::PERM ? ((R & ~31) + perm32(R & 31)) : R; Rr[i] = R; Cc[i] = C; voffB[i] = (unsigned)(Rb * K + C) * 2u; }
    const size_t kstep = (size_t)(BK * 2);
    const size_t hstep = (size_t)HALF * K * 2;
    const unsigned ldsw = (unsigned)wid * 1024u;
    const int aoff = lds_byte(wr * 64 + fr, fq * 8), boff = lds_byte(wc * 32 + fr, fq * 8);
#define PG8_SA(b, h) (((b) * 2 + (h)) * HTB)
#define PG8_SB(b, h) ((4 + (b) * 2 + (h)) * HTB)
#define PG8_STAGE(bufoff, gbase, voff) do { _Pragma("unroll") for (int _i = 0; _i < 2; ++_i) \
        __builtin_amdgcn_global_load_lds((const unsigned*)((const char*)(gbase) + (voff)[_i]), (PG8_LAS unsigned*)(lds + (bufoff) + ldsw + _i * 8192), 16, 0, 0); } while (0)
#define PG8_STAGEA(bufoff, o0, o1, kb) do { \
        __builtin_amdgcn_global_load_lds((const unsigned*)(Abase + (size_t)(o0) + (kb)), (PG8_LAS unsigned*)(lds + (bufoff) + ldsw), 16, 0, 0); \
        __builtin_amdgcn_global_load_lds((const unsigned*)(Abase + (size_t)(o1) + (kb)), (PG8_LAS unsigned*)(lds + (bufoff) + ldsw + 8192), 16, 0, 0); } while (0)
#define PG8_LDA(dst, b, h) do { _Pragma("unroll") for (int m = 0; m < 4; ++m) _Pragma("unroll") for (int k = 0; k < 2; ++k) dst[m][k] = *(const PG8_LAS bf16x8*)(lds + PG8_SA(b, h) + aoff + m * 2048 + k * 1024); } while (0)
#define PG8_LDB(dst, b, h) do { _Pragma("unroll") for (int n = 0; n < 2; ++n) _Pragma("unroll") for (int k = 0; k < 2; ++k) dst[n][k] = *(const PG8_LAS bf16x8*)(lds + PG8_SB(b, h) + boff + n * 2048 + k * 1024); } while (0)
#define PG8_MMA(ai, bj, At, Bt) do { __builtin_amdgcn_s_setprio(1); _Pragma("unroll") for (int m = 0; m < 4; ++m) _Pragma("unroll") for (int n = 0; n < 2; ++n) _Pragma("unroll") for (int k = 0; k < 2; ++k) \
        acc[ai][bj][m][n] = __builtin_amdgcn_mfma_f32_16x16x32_bf16(Bt[n][k], At[m][k], acc[ai][bj][m][n], 0, 0, 0); __builtin_amdgcn_s_setprio(0); } while (0)
#define PG8_WAIT_V(n) asm volatile("s_waitcnt vmcnt(" #n ")" ::: "memory")
#define PG8_WAIT_L(n) asm volatile("s_waitcnt lgkmcnt(" #n ")" ::: "memory")
#define PG8_BAR __builtin_amdgcn_s_barrier()
#define PG8_SCHED __builtin_amdgcn_sched_barrier(0)
    Unit2 cur, nxt; int ui = 0;
    if (!S.next(0, cur)) return;
    f32x4 acc[2][2][4][2];
#pragma unroll
    for (int a = 0; a < 2; ++a)
#pragma unroll
        for (int b = 0; b < 2; ++b)
#pragma unroll
            for (int m = 0; m < 4; ++m)
#pragma unroll
                for (int n = 0; n < 2; ++n) acc[a][b][m][n] = (f32x4){0.f, 0.f, 0.f, 0.f};
    bf16x8 At[4][2], B0[2][2], B1[2][2];
    const char* Abase = (const char*)S.abase();
    unsigned cAo[4], nAo[4];
    S.aoffs(cur, Rr, Cc, cAo);
    const char* cB = (const char*)S.bptr(cur);
    typename Epi::Pre pre = E.pre(cur, wr, lane);
    PG8_STAGE(PG8_SB(0, 0), cB, voffB); PG8_STAGE(PG8_SB(0, 1), cB + hstep, voffB); PG8_STAGEA(PG8_SA(0, 0), cAo[0], cAo[1], 0); PG8_STAGEA(PG8_SA(0, 1), cAo[2], cAo[3], 0);
    if (wr == 1) PG8_BAR;
    PG8_WAIT_V(2); PG8_BAR;
    PG8_STAGE(PG8_SB(1, 0), cB + kstep, voffB); PG8_STAGEA(PG8_SA(1, 0), cAo[0], cAo[1], kstep); PG8_STAGE(PG8_SB(1, 1), cB + hstep + kstep, voffB);
    PG8_WAIT_V(6); PG8_BAR;
    for (;;) {
        const bool has_next = S.next(ui + 1, nxt);
        if (has_next) S.aoffs(nxt, Rr, Cc, nAo); else { nAo[0] = cAo[0]; nAo[1] = cAo[1]; nAo[2] = cAo[2]; nAo[3] = cAo[3]; }
        const char* nB = has_next ? (const char*)S.bptr(nxt) : cB;
        for (int t = 0; t < nt; t += 2) {
            const bool last = (t == nt - 2);
            const size_t k1 = (size_t)(t + 1) * kstep;
            const size_t k2 = last ? 0 : (size_t)(t + 2) * kstep, k3 = k2 + kstep;
            const char* b2 = last ? nB : cB + (size_t)(t + 2) * kstep; const char* b3 = b2 + kstep;
            const unsigned a20 = last ? nAo[0] : cAo[0], a21 = last ? nAo[1] : cAo[1], a22 = last ? nAo[2] : cAo[2], a23 = last ? nAo[3] : cAo[3];
            PG8_LDB(B0, 0, 0); PG8_LDB(B1, 0, 1); PG8_SCHED; PG8_LDA(At, 0, 0); PG8_STAGEA(PG8_SA(1, 1), cAo[2], cAo[3], k1);
            PG8_WAIT_V(8); PG8_WAIT_L(0); PG8_BAR; PG8_MMA(0, 0, At, B0); PG8_MMA(0, 1, At, B1); PG8_BAR; PG8_SCHED;
            PG8_LDA(At, 0, 1); PG8_STAGE(PG8_SB(0, 0), b2, voffB); PG8_STAGE(PG8_SB(0, 1), b2 + hstep, voffB); PG8_STAGEA(PG8_SA(0, 0), a20, a21, k2);
            PG8_WAIT_V(8); PG8_WAIT_L(0); PG8_BAR; PG8_MMA(1, 0, At, B0); PG8_MMA(1, 1, At, B1); PG8_BAR; PG8_SCHED;
            PG8_LDB(B0, 1, 0); PG8_LDB(B1, 1, 1); PG8_SCHED; PG8_LDA(At, 1, 0); PG8_STAGEA(PG8_SA(0, 1), a22, a23, k2);
            PG8_WAIT_V(8); PG8_WAIT_L(0); PG8_BAR; PG8_MMA(0, 0, At, B0); PG8_MMA(0, 1, At, B1); PG8_BAR; PG8_SCHED;
            PG8_LDA(At, 1, 1); PG8_STAGE(PG8_SB(1, 0), b3, voffB); PG8_STAGE(PG8_SB(1, 1), b3 + hstep, voffB); PG8_STAGEA(PG8_SA(1, 0), a20, a21, k3);
            PG8_WAIT_V(8); PG8_WAIT_L(0); PG8_BAR; PG8_MMA(1, 0, At, B0); PG8_MMA(1, 1, At, B1); PG8_BAR; PG8_SCHED;
        }
        if constexpr (ALIGN_EPI) { if (wr == 0) PG8_BAR; }
        E(acc, cur, wr, wc, fr, fq, pre, aux + wid * 1024, lane);
        if (!has_next) break;
#pragma unroll
        for (int a = 0; a < 2; ++a)
#pragma unroll
            for (int b = 0; b < 2; ++b)
#pragma unroll
                for (int m = 0; m < 4; ++m)
#pragma unroll
                    for (int n = 0; n < 2; ++n) acc[a][b][m][n] = (f32x4){0.f, 0.f, 0.f, 0.f};
        cur = nxt; pre = E.pre(cur, wr, lane); cB = nB; cAo[0] = nAo[0]; cAo[1] = nAo[1]; cAo[2] = nAo[2]; cAo[3] = nAo[3]; ++ui;
        if constexpr (ALIGN_EPI) { if (wr == 1) PG8_BAR; }
    }
    PG8_WAIT_V(0);
    if constexpr (!ALIGN_EPI) { if (wr == 0) PG8_BAR; }
    PG8_BAR;
#undef PG8_SA
#undef PG8_SB
#undef PG8_STAGE
#undef PG8_STAGEA
#undef PG8_LDA
#undef PG8_LDB
#undef PG8_MMA
#undef PG8_WAIT_V
#undef PG8_WAIT_L
#undef PG8_BAR
#undef PG8_SCHED
}
struct MoeSched {
    const PG8_LAS unsigned* tb;
    const PG8_LAS unsigned* cntL;
    const PG8_LAS unsigned* hbL;
    int nl, lmul, ladd;
    int nN, G, c, K;
    const void* Abase_; const bf16_t* Bbase; size_t bstride;
    int merged;
    const unsigned* LIST; int mode;
    PG8_LAS int* ut;
    __device__ __forceinline__ void build_table() const {
        if (threadIdx.x < 32) { Unit2 u; const bool ok = search((int)threadIdx.x, u); PG8_LAS int* p = ut + 8 * threadIdx.x;
            p[0] = ok ? 1 : 0; p[1] = u.pm; p[2] = u.pn; p[3] = u.l; p[4] = u.cnt; p[5] = u.split; p[6] = (int)u.hb; }
    }
    __device__ __forceinline__ bool next(int i, Unit2& u) const {
        if (i < 32) { const PG8_LAS int* p = ut + 8 * i; if (p[0] == 0) return false; u.pm = p[1]; u.pn = p[2]; u.l = p[3]; u.cnt = p[4]; u.split = p[5]; u.hb = (unsigned)p[6]; return true; }
        return search(i, u);
    }
    __device__ __forceinline__ bool search(int i, Unit2& u) const {
        u.pm = 0; u.pn = 0; u.l = 0; u.cnt = 0; u.split = 0; u.hb = 0u;
        const unsigned total = tb[nl] * (unsigned)nN; const unsigned Lx = (unsigned)i * (unsigned)G + (unsigned)c; if (Lx >= total) return false;
        const unsigned rt = Lx / (unsigned)nN; u.pn = (int)(Lx % (unsigned)nN);
        int lo = 0, hi = nl;
        while (hi - lo > 1) { const int mid = (lo + hi) >> 1; if (tb[mid] <= rt) lo = mid; else hi = mid; }
        u.pm = (int)(rt - tb[lo]);
        if (merged) { if (lo < 64) { u.l = 2 * lo; const int c0 = (int)cntL[2 * lo]; u.split = c0; u.cnt = c0 + (int)cntL[2 * lo + 1]; u.hb = hbL[2 * lo]; } else { u.l = 128; u.cnt = (int)cntL[128]; u.split = u.cnt; u.hb = 0u; } }
        else { u.l = lo * lmul + ladd; u.cnt = (int)cntL[u.l]; u.split = u.cnt; u.hb = hbL[u.l]; }
        return true;
    }
    __device__ __forceinline__ const void* abase() const { return Abase_; }
    __device__ __forceinline__ const bf16_t* bptr(const Unit2& u) const { const int e = (u.l < 128) ? (u.l >> 1) : 64; return Bbase + (size_t)e * bstride + (size_t)u.pn * 256 * K; }
    __device__ __forceinline__ void aoffs(const Unit2& u, const int (&Rr)[2], const int (&Cc)[2], unsigned (&o)[4]) const {
#pragma unroll
        for (int h = 0; h < 2; ++h)
#pragma unroll
            for (int i = 0; i < 2; ++i) {
                const int p = u.pm * 256 + h * 128 + Rr[i]; unsigned row;
                if (mode == 0) { if (u.l == 128) row = (unsigned)p; else { const int pp = p < u.cnt ? p : 0; row = LIST[pp < u.split ? (size_t)u.l * 16384 + pp : (size_t)(u.l + 1) * 16384 + (pp - u.split)] >> 3; } }
                else row = u.hb + (unsigned)p;
                o[h * 2 + i] = row * (unsigned)(K * 2) + (unsigned)(Cc[i] * 2);
            }
    }
};
typedef float f32x2m __attribute__((ext_vector_type(2)));
struct EpiMoe1 {
    static constexpr bool PERM = true, AFTER_DRAIN = false;
    const f32x2m* META; const float* RINV; bf16_t* H; bf16_t* HS;
    struct Pre { f32x2m r0, r1; };
    __device__ __forceinline__ Pre pre(const Unit2& u, int wr, int lane) const {
        Pre p; const int p0 = u.pm * 256 + wr * 64 + lane, p1 = p0 + HALF;
        if (u.l == 128) { p.r0 = (f32x2m){RINV[p0], 1.f}; p.r1 = (f32x2m){RINV[p1], 1.f}; }
        else { const int q0 = p0 < u.cnt ? p0 : 0, q1 = p1 < u.cnt ? p1 : 0;
            p.r0 = META[q0 < u.split ? (size_t)u.l * 16384 + q0 : (size_t)(u.l + 1) * 16384 + (q0 - u.split)]; p.r1 = META[q1 < u.split ? (size_t)u.l * 16384 + q1 : (size_t)(u.l + 1) * 16384 + (q1 - u.split)]; }
        return p;
    }
    __device__ __forceinline__ void operator()(const f32x4 (&acc)[2][2][4][2], const Unit2& u, int wr, int wc, int fr, int fq, const Pre& pr, PG8_LAS unsigned char* aux, int lane) const {
        PG8_LAS f32x2m* slot = (PG8_LAS f32x2m*)aux;
        slot[lane] = pr.r0; slot[64 + lane] = pr.r1;
        asm volatile("s_waitcnt lgkmcnt(0)" ::: "memory");
        const int col = u.pn * 128 + wc * 32 + 8 * fq;
#pragma unroll
        for (int ai = 0; ai < 2; ++ai)
#pragma unroll
            for (int m = 0; m < 4; ++m) {
                const int p = u.pm * 256 + ai * HALF + wr * 64 + m * 16 + fr;
                if (p < u.cnt) {
                    const f32x2m mr = slot[ai * 64 + m * 16 + fr]; const float ri = mr.x, gw = mr.y;
                    bf16_t* dst = (u.l == 128) ? HS + (size_t)p * 256 + col : H + ((size_t)u.hb + p) * 256 + col;
                    float hv[8];
#pragma unroll
                    for (int n = 0; n < 2; ++n)
#pragma unroll
                        for (int i = 0; i < 4; ++i) { const float g = acc[ai][0][m][n][i] * ri, uu = acc[ai][1][m][n][i] * ri;
                            hv[n * 4 + i] = g * __builtin_amdgcn_rcpf(1.f + __builtin_amdgcn_exp2f(-1.4426950408889634f * g)) * uu * gw; }
                    u32x4 w; w.x = cvtc(hv[0], hv[1]); w.y = cvtc(hv[2], hv[3]); w.z = cvtc(hv[4], hv[5]); w.w = cvtc(hv[6], hv[7]);
                    *(u32x4*)dst = w;
                }
                asm volatile("" ::: "memory");
            }
        asm volatile("s_waitcnt lgkmcnt(0)" ::: "memory");
    }
};
struct EpiMoe2 {
    static constexpr bool PERM = true, AFTER_DRAIN = false;
    unsigned char* Y8;
    struct Pre { int dummy; };
    __device__ __forceinline__ Pre pre(const Unit2&, int, int) const { return Pre{0}; }
    __device__ __forceinline__ void operator()(const f32x4 (&acc)[2][2][4][2], const Unit2& u, int wr, int wc, int fr, int fq, const Pre&, PG8_LAS unsigned char*, int) const {
        const unsigned cofs = (unsigned)(u.pn * 256 + (wc * 4 + fq) * 16);
#pragma unroll
        for (int ai = 0; ai < 2; ++ai)
#pragma unroll
            for (int m = 0; m < 4; ++m) {
                const int p = u.pm * 256 + ai * HALF + wr * 64 + m * 16 + fr;
                if (p < u.cnt) {
                    int w[4];
#pragma unroll
                    for (int bj = 0; bj < 2; ++bj) { f32x4 a0 = acc[ai][bj][m][0] * 16.f, a1 = acc[ai][bj][m][1] * 16.f;
#pragma unroll
                        for (int i = 0; i < 4; ++i) { a0[i] = __builtin_amdgcn_fmed3f(a0[i], -440.f, 440.f); a1[i] = __builtin_amdgcn_fmed3f(a1[i], -440.f, 440.f); }
                        int w0 = __builtin_amdgcn_cvt_pk_fp8_f32(a0[0], a0[1], 0, false); w0 = __builtin_amdgcn_cvt_pk_fp8_f32(a0[2], a0[3], w0, true);
                        int w1 = __builtin_amdgcn_cvt_pk_fp8_f32(a1[0], a1[1], 0, false); w1 = __builtin_amdgcn_cvt_pk_fp8_f32(a1[2], a1[3], w1, true);
                        w[2 * bj] = w0; w[2 * bj + 1] = w1; }
                    *(u32x4*)(Y8 + ((u.hb + (unsigned)p) * 1024u + cofs)) = (u32x4){(unsigned)w[0], (unsigned)w[1], (unsigned)w[2], (unsigned)w[3]};
                }
            }
    }
};
struct EpiFinal {
    static constexpr bool PERM = true, AFTER_DRAIN = false;
    const unsigned char* Y8; const unsigned* INV; const PG8_LAS unsigned* hbL; const float* Oin; float* O;
    struct Pre { int dummy; };
    __device__ __forceinline__ Pre pre(const Unit2&, int, int) const { return Pre{0}; }
    __device__ __forceinline__ void operator()(const f32x4 (&acc)[2][2][4][2], const Unit2& u, int wr, int wc, int fr, int fq, const Pre&, PG8_LAS unsigned char*, int) const {
        typedef float f32x2v __attribute__((ext_vector_type(2)));
        const unsigned col = (unsigned)(u.pn * 256 + wc * 64 + 8 * fq), cofs = (unsigned)(u.pn * 256 + (wc * 4 + fq) * 16);
#pragma unroll
        for (int ai = 0; ai < 2; ++ai)
#pragma unroll
            for (int m = 0; m < 4; ++m) {
                const unsigned row = (unsigned)(u.pm * 256 + ai * HALF + wr * 64 + m * 16 + fr);
                const u32x4 iv0 = *(const u32x4*)(INV + row * 8u), iv1 = *(const u32x4*)(INV + row * 8u + 4u);
                const unsigned iv[8] = {iv0.x, iv0.y, iv0.z, iv0.w, iv1.x, iv1.y, iv1.z, iv1.w};
                unsigned yo[8];
#pragma unroll
                for (int j = 0; j < 8; ++j) yo[j] = (hbL[iv[j] >> 16] + (iv[j] & 0xffffu)) * 1024u + cofs;
#pragma unroll
                for (int bj = 0; bj < 2; ++bj) {
                    typedef unsigned u32x2g __attribute__((ext_vector_type(2)));
                    u32x2g t[8];
#pragma unroll
                    for (int j = 0; j < 8; ++j) t[j] = *(const u32x2g*)(Y8 + (yo[j] + bj * 8u));
                    const f32x4 x0 = *(const f32x4*)(Oin + (row * 1024u + col + bj * 32)), x1 = *(const f32x4*)(Oin + (row * 1024u + col + bj * 32 + 4));
                    f32x4 s0 = (f32x4){0.f, 0.f, 0.f, 0.f}, s1 = (f32x4){0.f, 0.f, 0.f, 0.f};
#pragma unroll
                    for (int j = 0; j < 8; ++j) { const f32x2v p0 = __builtin_amdgcn_cvt_pk_f32_fp8((int)t[j].x, false), p1 = __builtin_amdgcn_cvt_pk_f32_fp8((int)t[j].x, true),
                                                               p2 = __builtin_amdgcn_cvt_pk_f32_fp8((int)t[j].y, false), p3 = __builtin_amdgcn_cvt_pk_f32_fp8((int)t[j].y, true);
                        s0[0] += p0.x; s0[1] += p0.y; s0[2] += p1.x; s0[3] += p1.y; s1[0] += p2.x; s1[1] += p2.y; s1[2] += p3.x; s1[3] += p3.y; }
                    float* op = O + (row * 1024u + col + bj * 32);
                    *(f32x4*)op = x0 + acc[ai][bj][m][0] + s0 * 0.0625f; *(f32x4*)(op + 4) = x1 + acc[ai][bj][m][1] + s1 * 0.0625f;
                    asm volatile("" ::: "memory");
                }
                asm volatile("" ::: "memory");
            }
    }
};
struct EpiFinalD {
    static constexpr bool PERM = true, AFTER_DRAIN = true;
    const unsigned char* Y8; const unsigned* INV; const PG8_LAS unsigned* hbL; const float* Oin; float* O;
    __device__ __forceinline__ void fused(const f32x4 (&acc)[2][2][4][2], const Unit& u, int wr, int wc, int fr, int fq, PG8_LAS unsigned char*, int, int) const {
        typedef float f32x2v __attribute__((ext_vector_type(2)));
        const unsigned col = (unsigned)(u.pn * 256 + wc * 64 + 8 * fq), cofs = (unsigned)(u.pn * 256 + (wc * 4 + fq) * 16);
#pragma unroll
        for (int ai = 0; ai < 2; ++ai)
#pragma unroll
            for (int m = 0; m < 4; ++m) {
                const unsigned row = (unsigned)(u.pm * 256 + ai * HALF + wr * 64 + m * 16 + fr);
                const u32x4 iv0 = *(const u32x4*)(INV + row * 8u), iv1 = *(const u32x4*)(INV + row * 8u + 4u);
                const unsigned iv[8] = {iv0.x, iv0.y, iv0.z, iv0.w, iv1.x, iv1.y, iv1.z, iv1.w};
                f32x4 xr[2][2];
#pragma unroll
                for (int bj = 0; bj < 2; ++bj) { xr[bj][0] = *(const f32x4*)(Oin + (row * 1024u + col + bj * 32)); xr[bj][1] = *(const f32x4*)(Oin + (row * 1024u + col + bj * 32 + 4)); }
                f32x4 s[2][2];
#pragma unroll
                for (int bj = 0; bj < 2; ++bj) { s[bj][0] = (f32x4){0.f, 0.f, 0.f, 0.f}; s[bj][1] = (f32x4){0.f, 0.f, 0.f, 0.f}; }
#pragma unroll
                for (int jh = 0; jh < 2; ++jh) {
                    u32x4 t[4];
#pragma unroll
                    for (int j = 0; j < 4; ++j) { const unsigned ivv = iv[jh * 4 + j]; t[j] = *(const u32x4*)(Y8 + ((hbL[ivv >> 16] + (ivv & 0xffffu)) * 1024u + cofs)); }
#pragma unroll
                    for (int j = 0; j < 4; ++j) { const unsigned tw[4] = {t[j].x, t[j].y, t[j].z, t[j].w};
#pragma unroll
                        for (int bj = 0; bj < 2; ++bj) { const f32x2v p0 = __builtin_amdgcn_cvt_pk_f32_fp8((int)tw[2 * bj], false), p1 = __builtin_amdgcn_cvt_pk_f32_fp8((int)tw[2 * bj], true),
                                                                     p2 = __builtin_amdgcn_cvt_pk_f32_fp8((int)tw[2 * bj + 1], false), p3 = __builtin_amdgcn_cvt_pk_f32_fp8((int)tw[2 * bj + 1], true);
                            s[bj][0][0] += p0.x; s[bj][0][1] += p0.y; s[bj][0][2] += p1.x; s[bj][0][3] += p1.y; s[bj][1][0] += p2.x; s[bj][1][1] += p2.y; s[bj][1][2] += p3.x; s[bj][1][3] += p3.y; } }
                    asm volatile("" ::: "memory");
                }
#pragma unroll
                for (int bj = 0; bj < 2; ++bj) { float* op = O + (row * 1024u + col + bj * 32);
                    *(f32x4*)op = xr[bj][0] + acc[ai][bj][m][0] + s[bj][0] * 0.0625f; *(f32x4*)(op + 4) = xr[bj][1] + acc[ai][bj][m][1] + s[bj][1] * 0.0625f; }
                asm volatile("" ::: "memory");
            }
    }
};
}
#ifndef PG8_SP2
#define PG8_SP2 true
#endif
namespace fox {
using bf16=__hip_bfloat16;
using bf16x8=__attribute__((ext_vector_type(8)))short;
using s16x4=__attribute__((ext_vector_type(4)))short;
using f32x16=__attribute__((ext_vector_type(16)))float;
using u32x4=__attribute__((ext_vector_type(4)))unsigned;
constexpr int BATCH=2,NHEAD=8,SEQ=8192,D=64,DM=NHEAD*D;
constexpr int NW=8,QBLK=32,QB=QBLK*NW,KVBLK=64,NQB=SEQ/QB;
constexpr int ATTN_PITCH=DM, ATTN_UNIT_ROWS=QB;
__device__ __forceinline__ int crow(int r,int hi){return (r&3)+8*(r>>2)+4*hi;}
#define SBAR() __builtin_amdgcn_sched_barrier(0)
__device__ __forceinline__ void cmask(f32x16&p0,f32x16&p1,int jb,int qrel,int hi){
  const float NEG=-INFINITY; int kb=64*jb+4*hi;
  #pragma unroll
  for(int r=0;r<16;++r){int kv=kb+(r&3)+8*(r>>2); if(kv>qrel)p0[r]=NEG; if(kv+32>qrel)p1[r]=NEG;}
}

constexpr int NSLOT=3, SLOTB=9216, KAOFF=8192;
constexpr int LDS_K=0, LDS_V=NSLOT*SLOTB, LDS_WS=2*NSLOT*SLOTB, LDS_OST=LDS_WS+NW*64*4, LDS_BYTES=LDS_OST+NW*4096;
constexpr float C2=0.125f*1.4426950408889634f;
__device__ __forceinline__ void glds16(const void*gsrc,unsigned lds_dst){unsigned keep;
  asm volatile("s_mov_b32 %0, m0\n\ts_mov_b32 m0, %2\n\ts_nop 0\n\tglobal_load_lds_dwordx4 %1, off\n\ts_mov_b32 m0, %0":"=&s"(keep):"v"(gsrc),"s"(lds_dst):"memory");}
__device__ __forceinline__ float max3f(float a,float b,float c){float r;asm("v_max3_f32 %0, %1, %2, %3":"=v"(r):"v"(a),"v"(b),"v"(c));return r;}
__device__ __forceinline__ float max2f(float a,float b){float r;asm("v_max_f32_e32 %0, %1, %2":"=v"(r):"v"(a),"v"(b));return r;}
__device__ __forceinline__ float fadd_s(float a,float b){float r;asm("v_add_f32_e32 %0, %1, %2":"=v"(r):"v"(a),"v"(b));return r;}
__device__ __forceinline__ float fsub_s(float a,float b){float r;asm("v_sub_f32_e32 %0, %1, %2":"=v"(r):"v"(a),"v"(b));return r;}
typedef float f32x2_t __attribute__((ext_vector_type(2))); typedef __bf16 bf16x2_t __attribute__((ext_vector_type(2)));
__device__ __forceinline__ unsigned cvtpk_s(float lo,float hi){f32x2_t v={lo,hi};bf16x2_t b=__builtin_convertvector(v,bf16x2_t);return __builtin_bit_cast(unsigned,b);}
#define WAIT_BAR(N) asm volatile("s_waitcnt vmcnt(" #N ") lgkmcnt(0)\n\ts_barrier":::"memory")

__device__ __forceinline__ void qkt(f32x16&p0,f32x16&p1,const char*Kslot,const bf16x8*qr,const bf16x8 qa,int r32,int hi){
  const f32x16 z16=f32x16{};
  const char*kb=Kslot+hi*1024+r32*16;
  #pragma unroll
  for(int d0=0;d0<4;++d0){
    const bf16x8 b0=*reinterpret_cast<const bf16x8*>(kb+d0*2048);
    const bf16x8 b1=*reinterpret_cast<const bf16x8*>(kb+d0*2048+512);
    if(d0==0){p0=__builtin_amdgcn_mfma_f32_32x32x16_bf16(b0,qr[0],z16,0,0,0);p1=__builtin_amdgcn_mfma_f32_32x32x16_bf16(b1,qr[0],z16,0,0,0);}
    else{p0=__builtin_amdgcn_mfma_f32_32x32x16_bf16(b0,qr[d0],p0,0,0,0);p1=__builtin_amdgcn_mfma_f32_32x32x16_bf16(b1,qr[d0],p1,0,0,0);}}
  { const bf16x8 a0=*reinterpret_cast<const bf16x8*>(Kslot+KAOFF+r32*16); const bf16x8 a1=*reinterpret_cast<const bf16x8*>(Kslot+KAOFF+r32*16+512);
    p0=__builtin_amdgcn_mfma_f32_32x32x16_bf16(a0,qa,p0,0,0,0);p1=__builtin_amdgcn_mfma_f32_32x32x16_bf16(a1,qa,p1,0,0,0); }
}
typedef __attribute__((address_space(3))) const char* lds_cptr;
typedef short v4i16_t __attribute__((ext_vector_type(4)));
__device__ __forceinline__ void kload8(bf16x8*kf,lds_cptr kp){
  kf[0]=*(const __attribute__((address_space(3))) bf16x8*)(kp);      kf[1]=*(const __attribute__((address_space(3))) bf16x8*)(kp+512);
  kf[2]=*(const __attribute__((address_space(3))) bf16x8*)(kp+2048); kf[3]=*(const __attribute__((address_space(3))) bf16x8*)(kp+2560);
  kf[4]=*(const __attribute__((address_space(3))) bf16x8*)(kp+4096); kf[5]=*(const __attribute__((address_space(3))) bf16x8*)(kp+4608);
  kf[6]=*(const __attribute__((address_space(3))) bf16x8*)(kp+6144); kf[7]=*(const __attribute__((address_space(3))) bf16x8*)(kp+6656);
}
__device__ __forceinline__ void kload2(bf16x8*kf,lds_cptr kp,int j){ kf[2*j]=*(const __attribute__((address_space(3))) bf16x8*)(kp+j*2048); kf[2*j+1]=*(const __attribute__((address_space(3))) bf16x8*)(kp+j*2048+512); }
__device__ __forceinline__ s16x4 vtr(lds_cptr p){ return __builtin_bit_cast(s16x4,__builtin_amdgcn_ds_read_tr16_b64_v4i16((__attribute__((address_space(3))) v4i16_t*)p)); }
__device__ __forceinline__ float rowmax(const f32x16&p0,const f32x16&p1){
  float a=max3f(p0[0],p0[1],p1[0]),b=max3f(p0[2],p0[3],p1[1]);a=max3f(a,p1[2],p1[3]);
  #pragma unroll
  for(int r=4;r<16;r+=4){a=max3f(a,p0[r],p0[r+1]);b=max3f(b,p0[r+2],p0[r+3]);a=max3f(a,p1[r],p1[r+1]);b=max3f(b,p1[r+2],p1[r+3]);}
  const float m=max2f(a,b);
  auto rr=__builtin_amdgcn_permlane32_swap(__float_as_uint(m),__float_as_uint(m),false,false);
  return max2f(__uint_as_float(rr[0]),__uint_as_float(rr[1]));
}
__device__ __forceinline__ void pv(f32x16*o,int vb,bf16x8 pa0,bf16x8 pa1,bf16x8 pa2,bf16x8 pa3){
  #pragma unroll
  for(int d0=0;d0<2;++d0){s16x4 lo[4],hi[4];
    #pragma unroll
    for(int ks=0;ks<4;++ks){
      asm volatile("ds_read_b64_tr_b16 %0,%1 offset:%c2":"=&v"(lo[ks]):"v"(vb),"i"(d0*4096+ks*1024):"memory");
      asm volatile("ds_read_b64_tr_b16 %0,%1 offset:%c2":"=&v"(hi[ks]):"v"(vb),"i"(d0*4096+ks*1024+512):"memory");}
    asm volatile("s_waitcnt lgkmcnt(0)":::"memory");SBAR();
    #define PK(k) (bf16x8){lo[k][0],lo[k][1],lo[k][2],lo[k][3],hi[k][0],hi[k][1],hi[k][2],hi[k][3]}
    o[d0]=__builtin_amdgcn_mfma_f32_32x32x16_bf16(pa0,PK(0),o[d0],0,0,0);
    o[d0]=__builtin_amdgcn_mfma_f32_32x32x16_bf16(pa1,PK(1),o[d0],0,0,0);
    o[d0]=__builtin_amdgcn_mfma_f32_32x32x16_bf16(pa2,PK(2),o[d0],0,0,0);
    o[d0]=__builtin_amdgcn_mfma_f32_32x32x16_bf16(pa3,PK(3),o[d0],0,0,0);
    #undef PK
  }
}

#ifndef ATTN_STORE16
#define ATTN_STORE16(p,v) (*(u32x4*)(p)=(v))
#endif
template<int THRL> __device__ __forceinline__ void attn_unit(int b,int h,int qb,int T0,const bf16*Q,const bf16*__restrict__ K,const bf16*__restrict__ V,const bf16*__restrict__ KA,const float*__restrict__ Cbh,bf16*O,char*shm){
  int tid_=threadIdx.x; asm volatile("":"+v"(tid_));
  const int tid=tid_,lane=tid&63,r32=lane&31,hi=lane>>5; const int wid=__builtin_amdgcn_readfirstlane(tid>>6);
  const long rowbase=(long)b*SEQ; const int q0=qb*QB;
  const bf16*Qw=Q+(rowbase+q0+wid*QBLK)*DM+h*D;
  const bf16*Kh=K+(rowbase+(long)T0*KVBLK)*DM+h*D,*Vh=V+(rowbase+(long)T0*KVBLK)*DM+h*D;
  const bf16*kasrc=KA+((rowbase+(long)T0*KVBLK+lane)*NHEAD+h)*8;
  const unsigned lds0=(unsigned)(uintptr_t)shm;
  float*wsf=(float*)(shm+LDS_WS)+wid*64;
  const bf16*ksrc=Kh+(long)lane*DM+wid*8;
  const bf16*vsrc=Vh+(long)(16*(wid&3)+(lane>>2))*DM+(wid>>2)*32+(lane&3)*8;
  const unsigned kdst=lds0+LDS_K+wid*1024, vdst=lds0+LDS_V+wid*1024;
  #define DMA_K(t,slot) glds16(ksrc+(long)(t)*KVBLK*DM,(unsigned)__builtin_amdgcn_readfirstlane(kdst+(slot)))
  #define DMA_V(t,slot) glds16(vsrc+(long)(t)*KVBLK*DM,(unsigned)__builtin_amdgcn_readfirstlane(vdst+(slot)))
  #define DMA_KA(t,slot) do{ if(wid==0) glds16(kasrc+(long)(t)*KVBLK*NHEAD*8,(unsigned)__builtin_amdgcn_readfirstlane(lds0+LDS_K+KAOFF+(slot))); }while(0)
  const int vb0=(int)(lds0+LDS_V)+((lane>>4)&1)*32+(lane&3)*8+(4*hi+((lane&15)>>2))*64;
  const char*Kbase=shm+LDS_K; bf16x8 kf[8],kfa[2];
  const lds_cptr shm3=(lds_cptr)shm; const lds_cptr kpa=shm3+LDS_K+KAOFF+r32*16; const lds_cptr kp0=shm3+LDS_K+hi*1024+r32*16;
  #define KALOAD(sl) do{ kfa[0]=*(const __attribute__((address_space(3))) bf16x8*)(kpa+(sl)); kfa[1]=*(const __attribute__((address_space(3))) bf16x8*)(kpa+(sl)+512); }while(0)
  const lds_cptr vp0=shm3+LDS_V+((lane>>4)&1)*32+(lane&3)*8+(4*hi+((lane&15)>>2))*64;
  const int NT=(q0+QB)/KVBLK-T0;
  DMA_KA(0,0);DMA_KA(1,SLOTB);DMA_KA(2,2*SLOTB);
  DMA_K(0,0);DMA_V(0,0);DMA_K(1,SLOTB);
  bf16x8 qr[4];
  #pragma unroll
  for(int d0=0;d0<4;++d0)qr[d0]=*reinterpret_cast<const bf16x8*>(&Qw[(long)r32*DM+d0*16+hi*8]);
  const float ct2=Cbh[q0+wid*QBLK+r32]*1.4426950408889634f;
  float mhat=0.f,l_reg=0.f;f32x16 o[2];o[0]=f32x16{};o[1]=f32x16{};u32x4 qaw;
  #define QA_REBUILD() do{ const float a_=ct2-mhat; const unsigned p0_=cvtpk_s(a_,0.f)&0xffffu; const float r1_=a_-__uint_as_float(p0_<<16); const unsigned p1_=cvtpk_s(r1_,0.f)&0xffffu; \
      const float r2_=r1_-__uint_as_float(p1_<<16); const unsigned p2_=cvtpk_s(r2_,0.f)&0xffffu; \
      qaw=hi?(u32x4){0u,0u,0u,0u}:(u32x4){0x3F803F80u,0x3F80u|(p0_<<16),p1_|(p2_<<16),0u}; asm volatile("":"+v"(qaw)); }while(0)
  #define QAF __builtin_bit_cast(bf16x8,qaw)
  QA_REBUILD();
  const int qrel=wid*QBLK+r32;
  #define CMASK(P0,P1,t) do{int jb_=(t)-(NT-4); if(jb_>=0)cmask(P0,P1,jb_,qrel,hi);}while(0)
  bool resc=false;
  #define START(P0,P1) do{ const float rm=rowmax(P0,P1); resc=false; \
    { const float dl=rm; mhat=fadd_s(mhat,dl); \
      _Pragma("unroll") for(int r=0;r<16;++r){P0[r]=fsub_s(P0[r],dl);P1[r]=fsub_s(P1[r],dl);} \
      QA_REBUILD(); } \
    _Pragma("unroll") for(int r=0;r<16;++r)P0[r]=__builtin_amdgcn_exp2f(P0[r]); }while(0)
  #define RESC() do{ if(resc){ asm volatile("s_waitcnt lgkmcnt(0)":::"memory"); \
      _Pragma("unroll") for(int d_=0;d_<2;++d_) _Pragma("unroll") for(int r=0;r<16;++r)o[d_][r]*=wsf[crow(r,hi)]; } }while(0)
  f32x16 pA0,pA1,pB0,pB1;
  int sl_prev=0,sl_cur=0,sl_next=SLOTB;
  #define ROT() do{sl_prev=sl_cur;sl_cur=sl_next;sl_next=(sl_next==(NSLOT-1)*SLOTB)?0:sl_next+SLOTB;}while(0)
  DMA_K(2,2*SLOTB);
  WAIT_BAR(3);
  qkt(pA0,pA1,Kbase,qr,QAF,r32,hi);asm volatile("s_nop 15\n\ts_nop 7":"+v"(pA0),"+v"(pA1));CMASK(pA0,pA1,0);
  START(pA0,pA1);
  _Pragma("unroll") for(int r=0;r<16;++r)pA1[r]=__builtin_amdgcn_exp2f(pA1[r]);
  WAIT_BAR(0);
  DMA_KA(3,0);DMA_K(3,0);DMA_V(1,SLOTB);
  ROT();
  kload8(kf,kp0+sl_cur); KALOAD(sl_cur);
  WAIT_BAR(2);
  s16x4 vlo[8],vhi[8]; u32x4 pw0,pw1,pw2,pw3;
  #define PKW(P,B) cvtpk_s(P[B],P[B+1])
  #define PAF(k) __builtin_bit_cast(bf16x8,pw##k)
  #define VFR(i) (bf16x8){vlo[i][0],vlo[i][1],vlo[i][2],vlo[i][3],vhi[i][0],vhi[i][1],vhi[i][2],vhi[i][3]}
  #define PIN(x) asm volatile("":"+v"(x))
  #define MX3(a,b,c) __builtin_fmaxf(__builtin_fmaxf((a),(b)),(c))
  #define GAPA(MF,A0,A1,A2,A3,W0,W1,PW) do{ MF; sacc+=A0; sacc+=A1; sacc+=A2; sacc+=A3; PIN(sacc); W0; W1; PIN(PW); SBAR(); }while(0)
  #define EX(v) __builtin_amdgcn_exp2f(v)
  #define GAPB(MF,X,B) do{ MF; X[B]=EX(X[B]); X[B+1]=EX(X[B+1]); X[B+2]=EX(X[B+2]); X[B+3]=EX(X[B+3]); PIN(X); SBAR(); }while(0)
  #define VRD(i) do{ vlo[i]=vtr(vp_+(((i)>>2)*4096+((i)&3)*1024)); vhi[i]=vtr(vp_+(((i)>>2)*4096+((i)&3)*1024+512)); }while(0)
  #define KRD(G,j) do{ if(G){ kload2(kf,kp0+sl_next,j); SBAR(); } }while(0)
  const f32x16 z16=f32x16{};
  #define STEP(C0,C1,P0,P1,t,GK,GV,GL) do{ SBAR(); \
    const lds_cptr vp_=vp0+sl_prev; \
    VRD(0); SBAR(); float sacc=(P0[0]+P0[1]); \
    GAPA(C0=__builtin_amdgcn_mfma_f32_32x32x16_bf16(kf[0],qr[0],z16,0,0,0), P0[2],P0[3],P0[4],P0[5],     pw0[0]=PKW(P0,0), pw0[1]=PKW(P0,2), pw0); \
    VRD(4); SBAR(); GAPA(C1=__builtin_amdgcn_mfma_f32_32x32x16_bf16(kf[1],qr[0],z16,0,0,0), P0[6],P0[7],P0[8],P0[9],     pw0[2]=PKW(P0,4), pw0[3]=PKW(P0,6), pw0); \
    VRD(1); SBAR(); GAPA(C0=__builtin_amdgcn_mfma_f32_32x32x16_bf16(kf[2],qr[1],C0,0,0,0),   P0[10],P0[11],P0[12],P0[13], pw1[0]=PKW(P0,8), pw1[1]=PKW(P0,10), pw1); \
    VRD(5); SBAR(); GAPA(C1=__builtin_amdgcn_mfma_f32_32x32x16_bf16(kf[3],qr[1],C1,0,0,0),   P0[14],P0[15],P1[0],P1[1],   pw1[2]=PKW(P0,12),pw1[3]=PKW(P0,14), pw1); \
    VRD(2); SBAR(); GAPA(C0=__builtin_amdgcn_mfma_f32_32x32x16_bf16(kf[4],qr[2],C0,0,0,0),   P1[2],P1[3],P1[4],P1[5],     pw2[0]=PKW(P1,0), pw2[1]=PKW(P1,2), pw2); \
    VRD(6); SBAR(); GAPA(C1=__builtin_amdgcn_mfma_f32_32x32x16_bf16(kf[5],qr[2],C1,0,0,0),   P1[6],P1[7],P1[8],P1[9],     pw2[2]=PKW(P1,4), pw2[3]=PKW(P1,6), pw2); \
    VRD(3); SBAR(); GAPA(C0=__builtin_amdgcn_mfma_f32_32x32x16_bf16(kf[6],qr[3],C0,0,0,0),   P1[10],P1[11],P1[12],P1[13], pw3[0]=PKW(P1,8), pw3[1]=PKW(P1,10), pw3); \
    VRD(7); SBAR(); GAPA(C1=__builtin_amdgcn_mfma_f32_32x32x16_bf16(kf[7],qr[3],C1,0,0,0),   P1[14],P1[15],0.f,0.f,       pw3[2]=PKW(P1,12),pw3[3]=PKW(P1,14), pw3); \
    C0=__builtin_amdgcn_mfma_f32_32x32x16_bf16(kfa[0],QAF,C0,0,0,0); C1=__builtin_amdgcn_mfma_f32_32x32x16_bf16(kfa[1],QAF,C1,0,0,0); SBAR(); \
    l_reg+=sacc; \
    if(GK){DMA_KA((t)+3,sl_cur);DMA_K((t)+3,sl_cur);} if(GV){DMA_V((t)+1,sl_next);} \
    CMASK(C0,C1,t); \
    { float a=MX3(C0[0],C0[1],C1[0]),b=MX3(C0[2],C0[3],C1[1]); a=MX3(a,C1[2],C1[3]); \
      _Pragma("unroll") for(int r=4;r<16;r+=4){a=MX3(a,C0[r],C0[r+1]);b=MX3(b,C0[r+2],C0[r+3]);a=MX3(a,C1[r],C1[r+1]);b=MX3(b,C1[r+2],C1[r+3]);} \
      float rm=__builtin_fmaxf(a,b); { auto rr=__builtin_amdgcn_permlane32_swap(__float_as_uint(rm),__float_as_uint(rm),false,false); rm=__builtin_fmaxf(__uint_as_float(rr[0]),__uint_as_float(rr[1])); } \
      resc=false; \
      if(__builtin_expect(__any(rm>(float)THRL),0)){ const float dl=__builtin_fmaxf(rm,0.f); mhat+=dl; \
        _Pragma("unroll") for(int r=0;r<16;++r){C0[r]-=dl;C1[r]-=dl;} \
        QA_REBUILD(); \
        const float f=__builtin_amdgcn_exp2f(-dl); l_reg*=f; if(hi==0)wsf[r32]=f; resc=true; } } \
    SBAR(); \
    GAPB(o[0]=__builtin_amdgcn_mfma_f32_32x32x16_bf16(PAF(0),VFR(0),o[0],0,0,0), C0,0); \
    GAPB(o[1]=__builtin_amdgcn_mfma_f32_32x32x16_bf16(PAF(0),VFR(4),o[1],0,0,0), C0,4); \
    KRD(GL,0); GAPB(o[0]=__builtin_amdgcn_mfma_f32_32x32x16_bf16(PAF(1),VFR(1),o[0],0,0,0), C0,8); \
    KRD(GL,1); GAPB(o[1]=__builtin_amdgcn_mfma_f32_32x32x16_bf16(PAF(1),VFR(5),o[1],0,0,0), C0,12); \
    KRD(GL,2); GAPB(o[0]=__builtin_amdgcn_mfma_f32_32x32x16_bf16(PAF(2),VFR(2),o[0],0,0,0), C1,0); \
    KRD(GL,3); GAPB(o[1]=__builtin_amdgcn_mfma_f32_32x32x16_bf16(PAF(2),VFR(6),o[1],0,0,0), C1,4); \
    if(GL){ KALOAD(sl_next); SBAR(); } \
    GAPB(o[0]=__builtin_amdgcn_mfma_f32_32x32x16_bf16(PAF(3),VFR(3),o[0],0,0,0), C1,8); \
    GAPB(o[1]=__builtin_amdgcn_mfma_f32_32x32x16_bf16(PAF(3),VFR(7),o[1],0,0,0), C1,12); \
    }while(0)
  int t=1;
  #undef CMASK
  #define CMASK(P0,P1,t) do{}while(0)
  for(;t+5<NT;t+=2){
    STEP(pB0,pB1,pA0,pA1,t,true,true,true);     WAIT_BAR(2); RESC(); ROT();
    STEP(pA0,pA1,pB0,pB1,t+1,true,true,true);   WAIT_BAR(2); RESC(); ROT();
  }
  #undef CMASK
  #define CMASK(P0,P1,t) do{int jb_=(t)-(NT-4); if(jb_>=0)cmask(P0,P1,jb_,qrel,hi);}while(0)
  #define ENDW(tt) do{ if((tt)+3<NT){WAIT_BAR(2);} else if((tt)+2<NT){WAIT_BAR(1);} else {WAIT_BAR(0);} }while(0)
  for(;t+1<NT;t+=2){
    STEP(pB0,pB1,pA0,pA1,t,(t+3<NT),(t+1<NT),(t+1<NT));       ENDW(t);   RESC(); ROT();
    STEP(pA0,pA1,pB0,pB1,t+1,(t+4<NT),(t+2<NT),(t+2<NT));     ENDW(t+1); RESC(); ROT();
  }
  STEP(pB0,pB1,pA0,pA1,NT-1,false,false,false); RESC();
  { float sacc=pB0[0]+pB0[1]; _Pragma("unroll") for(int r=2;r<16;++r)sacc+=pB0[r]; _Pragma("unroll") for(int r=0;r<16;++r)sacc+=pB1[r]; l_reg+=sacc;
    pw0=(u32x4){PKW(pB0,0),PKW(pB0,2),PKW(pB0,4),PKW(pB0,6)};pw1=(u32x4){PKW(pB0,8),PKW(pB0,10),PKW(pB0,12),PKW(pB0,14)};pw2=(u32x4){PKW(pB1,0),PKW(pB1,2),PKW(pB1,4),PKW(pB1,6)};pw3=(u32x4){PKW(pB1,8),PKW(pB1,10),PKW(pB1,12),PKW(pB1,14)};
    SBAR(); pv(o,vb0+sl_cur,PAF(0),PAF(1),PAF(2),PAF(3)); }
  #undef PKW
  #undef PAF
  #undef VFR
  #undef PIN
  #undef MX3
  #undef GAPA
  #undef GAPB
  #undef EX
  #undef VRD
  #undef KRD
  #undef STEP
  #undef ENDW
  {auto rr=__builtin_amdgcn_permlane32_swap(__float_as_uint(l_reg),__float_as_uint(l_reg),false,false);l_reg=__uint_as_float(rr[0])+__uint_as_float(rr[1]);}
  if(hi==0)wsf[32+r32]=l_reg;asm volatile("s_waitcnt lgkmcnt(0)":::"memory");
  float rli[16];
  #pragma unroll
  for(int r=0;r<16;++r)rli[r]=__builtin_amdgcn_rcpf(wsf[32+crow(r,hi)]);
  bf16*Ow=O+(rowbase+q0+wid*QBLK)*DM+h*D;
  { bf16*stg=(bf16*)(shm+LDS_OST)+wid*2048;
    #pragma unroll
    for(int r=0;r<16;++r){const int orow=crow(r,hi);
      #pragma unroll
      for(int d0=0;d0<2;++d0)stg[orow*64+d0*32+r32]=__float2bfloat16(o[d0][r]*rli[r]);}
    asm volatile("s_waitcnt lgkmcnt(0)":::"memory");
    #pragma unroll
    for(int i=0;i<4;++i){const int row=i*8+(lane>>3),ch=lane&7; const u32x4 v=*(const u32x4*)(stg+row*64+ch*8); ATTN_STORE16(Ow+(long)row*DM+ch*8,v);} }
  asm volatile("s_waitcnt lgkmcnt(0)\n\ts_barrier":::"memory");
  #undef DMA_K
  #undef DMA_KA
  #undef KALOAD
  #undef QA_REBUILD
  #undef QAF
  #undef DMA_V
  #undef CMASK
  #undef START
  #undef RESC
  #undef ROT
}
constexpr int ATTN_LDS_BYTES=LDS_BYTES;
#undef SBAR
#undef WAIT_BAR
}
namespace dil {
using fox::bf16; using fox::bf16x8; using fox::f32x16; using fox::u32x4; using fox::s16x4;
constexpr int PITCH = 768;
constexpr int BT_N = 224;
__device__ __forceinline__ float hswap_max(float v) { auto rr = __builtin_amdgcn_permlane32_swap(__float_as_uint(v), __float_as_uint(v), false, false); return fmaxf(__uint_as_float(rr[0]), __uint_as_float(rr[1])); }
__device__ __forceinline__ float hswap_sum(float v) { auto rr = __builtin_amdgcn_permlane32_swap(__float_as_uint(v), __float_as_uint(v), false, false); return __uint_as_float(rr[0]) + __uint_as_float(rr[1]); }
__device__ __forceinline__ void pv_hi(f32x16* o, int vb, bf16x8 pa2, bf16x8 pa3) {
#pragma unroll
    for (int d0 = 0; d0 < 2; ++d0) { s16x4 lo[2], hi[2];
#pragma unroll
        for (int ks = 0; ks < 2; ++ks) {
            asm volatile("ds_read_b64_tr_b16 %0,%1 offset:%c2" : "=&v"(lo[ks]) : "v"(vb), "i"(d0 * 4096 + (ks + 2) * 1024) : "memory");
            asm volatile("ds_read_b64_tr_b16 %0,%1 offset:%c2" : "=&v"(hi[ks]) : "v"(vb), "i"(d0 * 4096 + (ks + 2) * 1024 + 512) : "memory"); }
        asm volatile("s_waitcnt lgkmcnt(0)" ::: "memory"); __builtin_amdgcn_sched_barrier(0);
#define DIL_PKV(k) (bf16x8){lo[k][0], lo[k][1], lo[k][2], lo[k][3], hi[k][0], hi[k][1], hi[k][2], hi[k][3]}
        o[d0] = __builtin_amdgcn_mfma_f32_32x32x16_bf16(pa2, DIL_PKV(0), o[d0], 0, 0, 0);
        o[d0] = __builtin_amdgcn_mfma_f32_32x32x16_bf16(pa3, DIL_PKV(1), o[d0], 0, 0, 0);
#undef DIL_PKV
    }
}
struct TP { int d, h12, tb, c, ubase; };
__device__ __forceinline__ TP mk_tp(int hs, int g, int t0, int r, int c) { TP p; p.d = (g == 0) ? 1 : (g == 1 ? 4 : 16); p.h12 = 4 * g + hs; p.tb = t0 + r; p.c = c; p.ubase = 32 * c - 160; return p; }
__device__ __forceinline__ void glds16s(const void* sbase, unsigned voff, unsigned lds_dst) { unsigned keep;
    asm volatile("s_mov_b32 %0, m0\n\ts_mov_b32 m0, %3\n\ts_nop 0\n\tglobal_load_lds_dwordx4 %1, %2\n\ts_mov_b32 m0, %0" : "=&s"(keep) : "v"(voff), "s"(sbase), "s"(lds_dst) : "memory"); }
__device__ __forceinline__ void dma_v(const TP& p, const unsigned rowbase, const bf16* __restrict__ VA, const unsigned lds_slot, const int tt, const int lane) {
#pragma unroll
    for (int w = 0; w < 8; ++w) {
        if (tt == 0 && (w & 3) < 2) continue;
        int pos = p.tb + p.d * (p.ubase + 64 * tt + 16 * (w & 3) + (lane >> 2)); pos = pos < 0 ? 0 : (pos > SEQ - 1 ? SEQ - 1 : pos);
        const unsigned off = ((rowbase + (unsigned)pos) * (unsigned)PITCH + (unsigned)(p.h12 * 64 + (w >> 2) * 32 + (lane & 3) * 8)) * 2u;
        glds16s(VA, off, (unsigned)__builtin_amdgcn_readfirstlane(lds_slot + w * 1024));
    }
}
__device__ __forceinline__ void issue_qk(const TP& p, const unsigned rowbase, const bf16* __restrict__ QA, const bf16* __restrict__ KA, bf16x8 (&qr)[4], bf16x8 (&kf)[5][4], const int lane) {
    const int r32 = lane & 31, hi = lane >> 5;
    { int tq = p.tb + p.d * (32 * p.c + r32); tq = tq > SEQ - 1 ? SEQ - 1 : tq;
      const unsigned qo = ((rowbase + (unsigned)tq) * (unsigned)PITCH + (unsigned)(p.h12 * 64 + hi * 8)) * 2u;
#pragma unroll
      for (int d0 = 0; d0 < 4; ++d0) qr[d0] = *reinterpret_cast<const bf16x8*>((const char*)QA + qo + d0 * 32); }
#pragma unroll
    for (int ch = 1; ch < 6; ++ch) {
        int pos = p.tb + p.d * (p.ubase + 32 * ch + r32); pos = pos < 0 ? 0 : (pos > SEQ - 1 ? SEQ - 1 : pos);
        const unsigned ko = ((rowbase + (unsigned)pos) * (unsigned)PITCH + (unsigned)(p.h12 * 64 + hi * 8)) * 2u;
#pragma unroll
        for (int d0 = 0; d0 < 4; ++d0) kf[ch - 1][d0] = *reinterpret_cast<const bf16x8*>((const char*)KA + ko + d0 * 32);
    }
    __builtin_amdgcn_sched_barrier(0);
}
template <bool HAS_NEXT>
__device__ __forceinline__ void task(const TP& p, const TP& nx, const int hs, const unsigned rowbase, const bf16* __restrict__ QA, const bf16* __restrict__ KA, const bf16* __restrict__ VA,
                                     bf16* __restrict__ PO, float* __restrict__ LSE, char* shm, const int vslot, const float* bt, float* wsf, bf16x8 (&qr)[4], bf16x8 (&kf)[5][4], const int lane_in) {
    int lane = lane_in; asm volatile("" : "+v"(lane));
    const int r32 = lane & 31, hi = lane >> 5;
    const unsigned lds0 = (unsigned)(uintptr_t)shm;
    f32x16 sc[6];
#pragma unroll
    for (int ch = 1; ch < 6; ++ch) {
        f32x16 a = f32x16{};
#pragma unroll
        for (int d0 = 0; d0 < 4; ++d0) a = __builtin_amdgcn_mfma_f32_32x32x16_bf16(kf[ch - 1][d0], qr[d0], a, 0, 0, 0);
        sc[ch] = a;
    }
    const int kmin = -p.ubase - p.tb / p.d;
    const int kth = kmin - 4 * hi;
    const float* btl = bt + (r32 - 4 * hi + 192);
    float mx = -INFINITY;
#pragma unroll
    for (int ch = 1; ch < 6; ++ch) {
#pragma unroll
        for (int rr = 0; rr < 16; ++rr) {
            const int kc = 32 * ch + (rr & 3) + 8 * (rr >> 2);
            float v = sc[ch][rr] + btl[-kc];
            if (kmin > 0) { if (kc < kth) v = -INFINITY; }
            sc[ch][rr] = v; mx = fmaxf(mx, v);
        }
        asm volatile("" ::: "memory");
    }
    mx = hswap_max(mx);
    float l = 0.f;
#define DIL_PK(P, B) fox::cvtpk_s(P[B], P[B + 1])
#define DIL_PA(P, B) __builtin_bit_cast(bf16x8, (u32x4){DIL_PK(P, B), DIL_PK(P, B + 2), DIL_PK(P, B + 4), DIL_PK(P, B + 6)})
    bf16x8 pk[6][2];
#pragma unroll
    for (int ch = 1; ch < 6; ++ch) {
#pragma unroll
        for (int rr = 0; rr < 16; ++rr) { const float pe = __builtin_amdgcn_exp2f(sc[ch][rr] - mx); sc[ch][rr] = pe; l += pe; }
        pk[ch][0] = DIL_PA(sc[ch], 0); pk[ch][1] = DIL_PA(sc[ch], 8);
    }
#undef DIL_PK
#undef DIL_PA
    l = hswap_sum(l);
    f32x16 o[2]; o[0] = f32x16{}; o[1] = f32x16{};
    const int vb = (int)(lds0 + vslot) + ((lane >> 4) & 1) * 32 + (lane & 3) * 8 + (4 * hi + ((lane & 15) >> 2)) * 64;
    asm volatile("s_waitcnt vmcnt(0)" ::: "memory");
    pv_hi(o, vb, pk[1][0], pk[1][1]);
    dma_v(p, rowbase, VA, lds0 + vslot, 2, lane);
    fox::pv(o, vb + 8192, pk[2][0], pk[2][1], pk[3][0], pk[3][1]);
    if constexpr (HAS_NEXT) {
        issue_qk(nx, rowbase, QA, KA, qr, kf, lane);
        dma_v(nx, rowbase, VA, lds0 + vslot + 8192, 1, lane);
        asm volatile("s_waitcnt vmcnt(32)" ::: "memory");
    } else {
        asm volatile("s_waitcnt vmcnt(0)" ::: "memory");
    }
    fox::pv(o, vb, pk[4][0], pk[4][1], pk[5][0], pk[5][1]);
    if (hi == 0) wsf[r32] = __builtin_amdgcn_rcpf(l);
    if (hi == 0) __hip_atomic_store(LSE + ((size_t)rowbase + p.tb + p.d * (32 * p.c + r32)) * 4 + hs, mx + __builtin_amdgcn_logf(l), __ATOMIC_RELAXED, __HIP_MEMORY_SCOPE_AGENT);
    asm volatile("s_waitcnt lgkmcnt(0)" ::: "memory");
    typedef __attribute__((address_space(3))) unsigned short* lds_u16p; typedef __attribute__((address_space(3))) const u32x4* lds_v4p;
    { const lds_u16p stg = (lds_u16p)(uintptr_t)(lds0 + vslot) + (4 * hi * 64 + r32);
#pragma unroll
      for (int rr = 0; rr < 16; ++rr) {
          const int q0 = (rr & 3) + 8 * (rr >> 2); const float rl = wsf[q0 + 4 * hi];
          stg[q0 * 64] = (unsigned short)(fox::cvtpk_s(o[0][rr] * rl, 0.f) & 0xffffu); stg[q0 * 64 + 32] = (unsigned short)(fox::cvtpk_s(o[1][rr] * rl, 0.f) & 0xffffu);
      } }
    asm volatile("s_waitcnt lgkmcnt(0)" ::: "memory");
    u32x4 ov[4];
    { const lds_v4p rb = (lds_v4p)(uintptr_t)(lds0 + vslot) + lane;
#pragma unroll
      for (int i = 0; i < 4; ++i) ov[i] = rb[i * 64]; }
    asm volatile("s_waitcnt lgkmcnt(0)" ::: "memory");
    if constexpr (HAS_NEXT) dma_v(nx, rowbase, VA, lds0 + vslot, 0, lane);
#pragma unroll
    for (int i = 0; i < 4; ++i) { const int idx = i * 64 + lane; const int qi = idx >> 3, c8 = idx & 7;
        asm volatile("global_store_dwordx4 %0, %1, off sc1\n\ts_nop 1" :: "v"(PO + ((size_t)rowbase + p.tb + p.d * (32 * p.c + qi)) * 256 + hs * 64 + c8 * 8), "v"(ov[i]) : "memory"); }
}
__device__ __forceinline__ void unit(const int b, const int hs, const int blk, const bf16* QA, const bf16* KA, const bf16* VA, const float* __restrict__ BIAS, bf16* PO0, bf16* PO1, bf16* PO2, float* LSE, bf16* YA,
                                     char* shm, float* bt_all, float* wsf_all, unsigned* pairctr, const int gmask = 7  ) {
    int tid_ = threadIdx.x; asm volatile("" : "+v"(tid_));
    const int tid = tid_, wave = __builtin_amdgcn_readfirstlane(tid >> 6);
    const int t0 = blk * 256, t512 = (blk >> 1) * 512, half = blk & 1;
    const int lane = tid & 63; const unsigned rowbase = (unsigned)b * SEQ; const int vslot = wave * 16384;
    const TP p0 = mk_tp(hs, 0, t0, 0, wave), p1 = mk_tp(hs, 1, t0, wave & 3, wave >> 2), p2 = mk_tp(hs, 2, t512, 8 * half + wave, 0);
    bf16x8 qr[4], kf[5][4];
    const unsigned lds0 = (unsigned)(uintptr_t)shm;
    if (gmask == 7) { dma_v(p0, rowbase, VA, lds0 + vslot, 0, lane); dma_v(p0, rowbase, VA, lds0 + vslot + 8192, 1, lane); issue_qk(p0, rowbase, QA, KA, qr, kf, lane); }
    for (int i = tid; i < 3 * BT_N; i += 512) { const int g = i / BT_N, x = i % BT_N, j = x - 32; bt_all[i] = (j >= 0 && j <= 128) ? BIAS[(4 * g + hs) * 129 + j] : -INFINITY; }
    __syncthreads();
    if (gmask == 7) {
        task<true>(p0, p1, hs, rowbase, QA, KA, VA, PO0, LSE, shm, vslot, bt_all, wsf_all + wave * 64, qr, kf, lane);
        task<true>(p1, p2, hs, rowbase, QA, KA, VA, PO1, LSE + (size_t)M * 4, shm, vslot, bt_all + BT_N, wsf_all + wave * 64, qr, kf, lane);
        task<false>(p2, p2, hs, rowbase, QA, KA, VA, PO2, LSE + (size_t)2 * M * 4, shm, vslot, bt_all + 2 * BT_N, wsf_all + wave * 64, qr, kf, lane);
    }
    asm volatile("s_waitcnt vmcnt(0)" ::: "memory");
    __syncthreads();
    unsigned* tick = (unsigned*)(wsf_all + 512);
    if (tid == 0) *tick = __hip_atomic_fetch_add(pairctr, 1u, __ATOMIC_RELAXED, __HIP_MEMORY_SCOPE_AGENT);
    __syncthreads();
    const bool last = (*tick & 1u) == 1u;
    if (last) {
        if (tid < 64) { __builtin_amdgcn_fence(__ATOMIC_ACQUIRE, "agent"); asm volatile("s_waitcnt vmcnt(0)" ::: "memory"); }
        __syncthreads();
        const size_t row0 = (size_t)b * SEQ + t512;
        for (int it = tid; it < 512 * 8; it += 512) {
            const int tok = it >> 3, c8 = it & 7; const size_t row = row0 + tok;
            float ls[3]; u32x4 pv3[3];
#pragma unroll
            for (int g = 0; g < 3; ++g) { const bf16* POg = g == 0 ? PO0 : (g == 1 ? PO1 : PO2); ls[g] = LSE[((size_t)g * M + row) * 4 + hs]; pv3[g] = *(const u32x4*)(POg + row * 256 + hs * 64 + c8 * 8); }
            const float mm = fmaxf(ls[0], fmaxf(ls[1], ls[2]));
            float w[3]; float ws_ = 0.f;
#pragma unroll
            for (int g = 0; g < 3; ++g) { w[g] = __builtin_amdgcn_exp2f(ls[g] - mm); ws_ += w[g]; }
            const float iw = 1.f / ws_;
            float y[8];
#pragma unroll
            for (int e = 0; e < 8; ++e) y[e] = 0.f;
#pragma unroll
            for (int g = 0; g < 3; ++g) { const float wg = w[g] * iw; const unsigned q[4] = {pv3[g].x, pv3[g].y, pv3[g].z, pv3[g].w};
#pragma unroll
                for (int e = 0; e < 4; ++e) { y[2 * e] += wg * __uint_as_float(q[e] << 16); y[2 * e + 1] += wg * __uint_as_float(q[e] & 0xffff0000u); } }
            u32x4 ov; ov.x = fox::cvtpk_s(y[0], y[1]); ov.y = fox::cvtpk_s(y[2], y[3]); ov.z = fox::cvtpk_s(y[4], y[5]); ov.w = fox::cvtpk_s(y[6], y[7]);
            *(u32x4*)(YA + row * 256 + hs * 64 + c8 * 8) = ov;
        }
    }
    __syncthreads();
}
}
namespace rtr {
using fox::bf16x8; using fox::f32x16; using fox::u32x4;
__device__ __forceinline__ void task(const int t, const int kq, const bool valid, const float* __restrict__ X1, const float* __restrict__ gf, const unsigned short* __restrict__ WRF, const float* __restrict__ router_bias,
                                     unsigned short* __restrict__ H2, float* __restrict__ RINV, unsigned* __restrict__ CNT, unsigned* __restrict__ LIST, float* __restrict__ GATEW, float2* __restrict__ META, unsigned* __restrict__ INV, float* tiles, float* sst, PG8_LAS unsigned* LC  ) {
    int tid_ = threadIdx.x; asm volatile("" : "+v"(tid_));
    if (tid_ < 128) LC[tid_] = 0u;
    const int lane = tid_ & 63, r32 = lane & 31, hi = lane >> 5;
    const size_t row = (size_t)t * 32 + r32;
    const float* xp = X1 + row * D + hi * 8; const float* gp = gf + hi * 8; unsigned short* hp = H2 + row * D + hi * 8;
    const u32x4* wf = (const u32x4*)WRF + lane;
    f32x16 acc[2]; acc[0] = f32x16{}; acc[1] = f32x16{};
    float ss = 0.f;
    if (valid) {
#pragma unroll 4
    for (int k0 = 16 * kq; k0 < 16 * kq + 16; ++k0) {
        const float4 xa = *(const float4*)(xp + k0 * 16), xb = *(const float4*)(xp + k0 * 16 + 4);
        const float4 ga = *(const float4*)(gp + k0 * 16), gb = *(const float4*)(gp + k0 * 16 + 4);
        const u32x4 bh0 = wf[(0 * 64 + k0) * 64], bh1 = wf[(1 * 64 + k0) * 64], bl0 = wf[(2 * 64 + k0) * 64], bl1 = wf[(3 * 64 + k0) * 64];
        const float x[8] = {xa.x, xa.y, xa.z, xa.w, xb.x, xb.y, xb.z, xb.w}; const float gg[8] = {ga.x, ga.y, ga.z, ga.w, gb.x, gb.y, gb.z, gb.w};
        float y[8]; unsigned ph[4], pl[4];
#pragma unroll
        for (int e = 0; e < 8; ++e) { ss += x[e] * x[e]; y[e] = x[e] * gg[e]; }
#pragma unroll
        for (int e = 0; e < 4; ++e) { ph[e] = fox::cvtpk_s(y[2 * e], y[2 * e + 1]);
            pl[e] = fox::cvtpk_s(y[2 * e] - __uint_as_float(ph[e] << 16), y[2 * e + 1] - __uint_as_float(ph[e] & 0xffff0000u)); }
        const u32x4 hv = {ph[0], ph[1], ph[2], ph[3]}, lv = {pl[0], pl[1], pl[2], pl[3]};
        *(u32x4*)(hp + k0 * 16) = hv;
        const bf16x8 ah = __builtin_bit_cast(bf16x8, hv), al = __builtin_bit_cast(bf16x8, lv);
        acc[0] = __builtin_amdgcn_mfma_f32_32x32x16_bf16(ah, __builtin_bit_cast(bf16x8, bh0), acc[0], 0, 0, 0);
        acc[1] = __builtin_amdgcn_mfma_f32_32x32x16_bf16(ah, __builtin_bit_cast(bf16x8, bh1), acc[1], 0, 0, 0);
        acc[0] = __builtin_amdgcn_mfma_f32_32x32x16_bf16(ah, __builtin_bit_cast(bf16x8, bl0), acc[0], 0, 0, 0);
        acc[1] = __builtin_amdgcn_mfma_f32_32x32x16_bf16(ah, __builtin_bit_cast(bf16x8, bl1), acc[1], 0, 0, 0);
        acc[0] = __builtin_amdgcn_mfma_f32_32x32x16_bf16(al, __builtin_bit_cast(bf16x8, bh0), acc[0], 0, 0, 0);
        acc[1] = __builtin_amdgcn_mfma_f32_32x32x16_bf16(al, __builtin_bit_cast(bf16x8, bh1), acc[1], 0, 0, 0);
    }
    { auto rr = __builtin_amdgcn_permlane32_swap(__float_as_uint(ss), __float_as_uint(ss), false, false); ss = __uint_as_float(rr[0]) + __uint_as_float(rr[1]); }
    float* tile = tiles + kq * (32 * 65);
#pragma unroll
    for (int eh = 0; eh < 2; ++eh)
#pragma unroll
        for (int r = 0; r < 16; ++r) tile[((r & 3) + 8 * (r >> 2) + 4 * hi) * 65 + eh * 32 + r32] = acc[eh][r];
    if (hi == 0) sst[kq * 32 + r32] = ss;
    }
    asm volatile("s_waitcnt lgkmcnt(0)" ::: "memory");
    __syncthreads();
    const bool fin = valid && kq == 0;
    int ls[4] = {0, 0, 0, 0}; unsigned lp[4] = {0u, 0u, 0u, 0u}; float gwv[4] = {0.f, 0.f, 0.f, 0.f}; float rinv = 0.f;
#define RT_LOGIT(e_) ((trow[e_] + trow[(e_) + 32 * 65]) + (trow[(e_) + 2 * 32 * 65] + trow[(e_) + 3 * 32 * 65]))
    if (fin) {
    rinv = rsqrtf((sst[r32] + sst[32 + r32] + sst[64 + r32] + sst[96 + r32]) * (1.f / D) + EPS);
    if (hi == 0) RINV[row] = rinv;
    float tv[8]; int ti[8];
#pragma unroll
    for (int p = 0; p < 8; ++p) { tv[p] = -INFINITY; ti[p] = 0; }
    const float* trow = tiles + r32 * 65;
#pragma unroll 4
    for (int e0 = 0; e0 < 32; ++e0) {
        const int e = hi * 32 + e0;
        float v = 1.f / (1.f + __expf(-RT_LOGIT(e) * rinv)) + router_bias[e]; int id = e;
#pragma unroll
        for (int p = 0; p < 8; ++p) { const bool gt = v > tv[p]; const float tvv = tv[p]; const int tii = ti[p]; tv[p] = gt ? v : tvv; ti[p] = gt ? id : tii; v = gt ? tvv : v; id = gt ? tii : id; }
    }
    float ov[8]; int oi[8];
#pragma unroll
    for (int p = 0; p < 8; ++p) { auto a = __builtin_amdgcn_permlane32_swap(__float_as_uint(tv[p]), __float_as_uint(tv[p]), false, false); ov[p] = hi ? __uint_as_float(a[0]) : __uint_as_float(a[1]);
        auto bq = __builtin_amdgcn_permlane32_swap((unsigned)ti[p], (unsigned)ti[p], false, false); oi[p] = hi ? (int)bq[0] : (int)bq[1]; }
#pragma unroll
    for (int q = 0; q < 8; ++q) { float v = ov[q]; int id = oi[q];
#pragma unroll
        for (int p = 0; p < 8; ++p) { const bool gt = (v > tv[p]) || (v == tv[p] && id < ti[p]); const float tvv = tv[p]; const int tii = ti[p]; tv[p] = gt ? v : tvv; ti[p] = gt ? id : tii; v = gt ? tvv : v; id = gt ? tii : id; } }
    float sv[8]; float ssum = 0.f;
#pragma unroll
    for (int p = 0; p < 8; ++p) { sv[p] = 1.f / (1.f + __expf(-RT_LOGIT(ti[p]) * rinv)); ssum += sv[p]; }
    const float sc = 2.5f / ssum;
#pragma unroll
    for (int j = 0; j < 4; ++j) { const int e = hi ? ti[4 + j] : ti[j]; ls[j] = e * 2 + hi; gwv[j] = (hi ? sv[4 + j] : sv[j]) * sc;
        lp[j] = __hip_atomic_fetch_add(LC + ls[j], 1u, __ATOMIC_RELAXED, __HIP_MEMORY_SCOPE_WORKGROUP); }
    }
    asm volatile("s_waitcnt lgkmcnt(0)" ::: "memory");
    __syncthreads();
    if (tid_ < 128) { const unsigned c = LC[tid_]; unsigned base = 0u; if (c != 0u) base = atomicAdd(&CNT[tid_ * CNT_STRIDE], c); LC[128 + tid_] = base; }
    asm volatile("s_waitcnt lgkmcnt(0)" ::: "memory");
    __syncthreads();
    if (fin) {
#pragma unroll
    for (int j = 0; j < 4; ++j) {
        const int l = ls[j], p = 4 * hi + j;
        const unsigned pos = LC[128 + l] + lp[j];
        LIST[(size_t)l * M + pos] = (unsigned)row * 8u + (unsigned)p;
        GATEW[row * 8 + p] = gwv[j];
        META[(size_t)l * M + pos] = make_float2(rinv, gwv[j]);
        INV[row * 8 + p] = ((unsigned)l << 16) | pos;
    }
    }
    asm volatile("s_waitcnt lgkmcnt(0)" ::: "memory");
#undef RT_LOGIT
}
}
#define GAS __attribute__((address_space(1)))
#define LAS __attribute__((address_space(3)))
typedef unsigned short bf16;
typedef unsigned v4u __attribute__((ext_vector_type(4)));
typedef float f32x4 __attribute__((ext_vector_type(4)));
typedef short bf16x8 __attribute__((ext_vector_type(8)));
typedef GAS unsigned gu32;
typedef GAS unsigned long long gu64;
#define RLX_AGENT __ATOMIC_RELAXED, __HIP_MEMORY_SCOPE_AGENT
#define LDS_WAIT() asm volatile("s_waitcnt lgkmcnt(0)" ::: "memory")
#define VM_WAIT() asm volatile("s_waitcnt vmcnt(0)" ::: "memory")
__device__ __forceinline__ unsigned long long rt() { return __builtin_amdgcn_s_memrealtime(); }

#define XB_TMO      128
#define XB_XCNT(j)  (256  + 64 * (j))
#define XB_XSUB(j)  (1280 + 64 * (j))
#define XB_XGEN(j)  (2304 + 64 * (j))
#define XB_TOP      3328
#define XB_TOPGEN   3392
#define XCD_BAR_WORDS 3456
#define XB_SPIN_CAP (1u << 18)

__device__ __forceinline__ unsigned xb_ld(unsigned* p)              { return __hip_atomic_load(p, __ATOMIC_RELAXED, __HIP_MEMORY_SCOPE_AGENT); }
__device__ __forceinline__ unsigned xb_add(unsigned* p, unsigned v) { return __hip_atomic_fetch_add(p, v, __ATOMIC_RELAXED, __HIP_MEMORY_SCOPE_AGENT); }
__device__ __forceinline__ unsigned xb_xcc_id() { return (unsigned)__builtin_amdgcn_s_getreg((3 << 11) | 20) & 0xFu; }
#define XB_SPIN(cond, bar) do { unsigned _sp = 0; while (cond) { __builtin_amdgcn_s_sleep(1); \
    if ((++_sp & 255u) == 0u) { if (xb_ld(&(bar)[XB_TMO])) break; if (_sp > XB_SPIN_CAP) { atomicAdd(&(bar)[XB_TMO], 1u); break; } } } } while (0)

struct XcdBarrier {
    unsigned* bar; unsigned x;
    volatile LAS unsigned* st;
};

__device__ __forceinline__ XcdBarrier xcd_barrier_post(unsigned* bar, volatile LAS unsigned* st) {
    XcdBarrier b; b.bar = bar; b.x = xb_xcc_id(); b.st = st;
    if (threadIdx.x == 0) (void)xb_add(&bar[XB_XCNT(b.x)], 1u);
    return b;
}
__device__ __forceinline__ void xcd_barrier_complete(unsigned* bar, unsigned x, unsigned& nloc, unsigned& nx) {
    const unsigned G = gridDim.x * gridDim.y * gridDim.z;
    unsigned sum, cnt, mine, sp = 0u;
    for (;;) {
        sum = 0u; cnt = 0u; mine = 0u;
#pragma unroll
        for (unsigned j = 0; j < 16; ++j) { const unsigned c = xb_ld(&bar[XB_XCNT(j)]); sum += c; cnt += (c > 0u) ? 1u : 0u; mine = (j == x) ? c : mine; }
        if (sum == G) break;
        __builtin_amdgcn_s_sleep(1);
        if ((++sp & 255u) == 0u) { if (xb_ld(&bar[XB_TMO])) break; if (sp > XB_SPIN_CAP) { atomicAdd(&bar[XB_TMO], 1u); break; } }
    }
    nloc = mine > 0u ? mine : 1u; nx = cnt > 0u ? cnt : 1u;
}

__device__ __forceinline__ void xcd_barrier(const XcdBarrier& b) {
    asm volatile("s_waitcnt vmcnt(0)" ::: "memory");
    __syncthreads();
    if (threadIdx.x == 0) {
        unsigned* bar = b.bar;
        __builtin_amdgcn_s_waitcnt(0);
        unsigned nloc = b.st[0], nx = b.st[1];
        if (nloc == 0u) { xcd_barrier_complete(bar, b.x, nloc, nx); b.st[0] = nloc; b.st[1] = nx; }
        const unsigned old = xb_add(&bar[XB_XSUB(b.x)], 1u);
        const unsigned gen = old / nloc;
        if (old + 1u == (gen + 1u) * nloc) {
            __builtin_amdgcn_fence(__ATOMIC_RELEASE, "agent");
            asm volatile("s_waitcnt vmcnt(0)" ::: "memory");
            const unsigned og = xb_add(&bar[XB_TOP], 1u);
            const unsigned tg = og / nx;
            if (og + 1u == (tg + 1u) * nx) xb_add(&bar[XB_TOPGEN], 1u);
            else XB_SPIN(xb_ld(&bar[XB_TOPGEN]) == tg, bar);
            __builtin_amdgcn_fence(__ATOMIC_ACQUIRE, "agent");
            xb_add(&bar[XB_XGEN(b.x)], 1u);
            asm volatile("s_waitcnt vmcnt(0)" ::: "memory");
        } else {
            XB_SPIN(xb_ld(&bar[XB_XGEN(b.x)]) == gen, bar);
            __builtin_amdgcn_fence(__ATOMIC_ACQUIRE, "agent");
            asm volatile("s_waitcnt vmcnt(0)" ::: "memory");
        }
    }
    __syncthreads();
}
constexpr int NWAVES = 8;
constexpr int RING_OFF = 0, RING_BYTES = 131072;
constexpr int LDSCTL_OFF = RING_BYTES, MISC_OFF = LDSCTL_OFF + 320;
constexpr int TB_CNT = LDSCTL_OFF + 1024, TB_HB = LDSCTL_OFF + 2048, TB_T6 = LDSCTL_OFF + 3072, TB_TA = LDSCTL_OFF + 4096, TB_TB = LDSCTL_OFF + 5120, TB_T9 = LDSCTL_OFF + 6144, TB_UT = LDSCTL_OFF + 7168;
constexpr int LDS_BYTES = 147456;
constexpr int CW_TMO = 0, CW_CODE = 1, CW_BAR = 4096;
constexpr int N_IN = 16 * 60, N_G = 16 * 32, N_PA = 4 * 16, N_PB = 8 * 16, N_O = 16 * 16, N_EX = 65 * 128, N_W2 = 65 * 64;
constexpr int N_FILL1 = 0;    constexpr int N_FILL2 = 8320;
constexpr int NITEMS = N_IN + N_G + N_PA + N_PB + N_O + N_EX - N_FILL1 - N_FILL2;
constexpr int NPHASE = 10;
constexpr int NTOT1 = 3840 + 2048;
struct MArgs { const float* in[23]; float* out; unsigned char* ws; int ph_lo, ph_hi, li, pad; };

__device__ __forceinline__ void tr64_load(f32x4 (&v)[16], const float* W, int ldw, int k0, int n0, int lane) {
    const int lq = lane >> 4, n4 = lane & 15;
    const GAS f32x4* src = (const GAS f32x4*)(W + (size_t)(k0 + 2 * lq) * ldw + n0 + 4 * n4);
#pragma unroll
    for (int j = 0; j < 16; ++j) v[j] = src[((size_t)(8 * (j >> 1) + (j & 1)) * ldw) >> 2];
}
__device__ __forceinline__ void tr64_store(const f32x4 (&v)[16], int k0, bf16* WT, int K, int base_row, int hstride, LAS unsigned* T, int lane) {
    const int lq = lane >> 4, n4 = lane & 15;
#pragma unroll
    for (int p = 0; p < 8; ++p)
#pragma unroll
        for (int e = 0; e < 4; ++e) T[(4 * n4 + e) * 33 + 4 * p + lq] = pg8::cvtc(v[2 * p][e], v[2 * p + 1][e]);
    LDS_WAIT(); asm volatile("" ::: "memory");
    const int c = lane & 7;
#pragma unroll
    for (int j = 0; j < 8; ++j) { const int n = (lane >> 3) + 8 * j; const LAS unsigned* s = T + n * 33 + 4 * c;
        v4u o; o.x = s[0]; o.y = s[1]; o.z = s[2]; o.w = s[3];
        *(GAS v4u*)(WT + (size_t)(base_row + hstride * (n >> 5) + (n & 31)) * K + k0 + 8 * c) = o; }
    LDS_WAIT(); asm volatile("" ::: "memory");
}
__device__ __forceinline__ void p0_tr64(const float* W, int ldw, int k0, int n0, bf16* WT, int K, int base_row, int hstride, LAS unsigned* T, int lane) {
    f32x4 v[16];
    tr64_load(v, W, ldw, k0, n0, lane);
    tr64_store(v, k0, WT, K, base_row, hstride, T, lane);
}
__device__ __forceinline__ void rms_row(const float* xrow, const float* g, bf16* orow, const LAS float* wt8, const float* b_forget, float* logf_row, int lane) {
    const GAS f32x4* xr = (const GAS f32x4*)xrow;
    f32x4 v[4]; float ss = 0.f;
#pragma unroll
    for (int j = 0; j < 4; ++j) { v[j] = xr[lane + 64 * j]; ss += v[j].x * v[j].x + v[j].y * v[j].y + v[j].z * v[j].z + v[j].w * v[j].w; }
    ss = wave_sum(ss);
    const float rinv = rsqrtf(ss * (1.f / D) + EPS);
    float f[8];
#pragma unroll
    for (int c = 0; c < 8; ++c) f[c] = 0.f;
#pragma unroll
    for (int j = 0; j < 4; ++j) {
        const f32x4 gg = ((const GAS f32x4*)g)[lane + 64 * j];
        float y[4] = {v[j].x * rinv * gg.x, v[j].y * rinv * gg.y, v[j].z * rinv * gg.z, v[j].w * rinv * gg.w};
        u32x2 o; o.x = pg8::cvtc(y[0], y[1]); o.y = pg8::cvtc(y[2], y[3]);
        *(GAS u32x2*)(orow + 4 * (lane + 64 * j)) = o;
        if (wt8) {
#pragma unroll
            for (int c = 0; c < 8; ++c) { const f32x4 w = *(const LAS f32x4*)(wt8 + c * 1024 + 4 * (lane + 64 * j)); f[c] += (y[0] * w.x + y[1] * w.y) + (y[2] * w.z + y[3] * w.w); }
        }
    }
    if (wt8) {
#pragma unroll
        for (int c = 0; c < 8; ++c) f[c] = wave_sum(f[c]);
        float mine = f[0];
#pragma unroll
        for (int c = 1; c < 8; ++c) mine = (lane == c) ? f[c] : mine;
        if (lane < 8) { const float z = mine + b_forget[lane]; logf_row[lane] = fminf(z, 0.f) - log1pf(expf(-fabsf(z))); }
    }
}
__device__ __forceinline__ void p1_cumsum(int bh, const float* LOGF, float* C, bf16* KAUG, LAS float* sc, int tid, const float* qnb, const float* knb, int* FT0) {
    const int b = bh >> 3, h = bh & 7;
    float loc[16]; float run = 0.f;
#pragma unroll
    for (int e = 0; e < 16; ++e) { run += LOGF[((size_t)b * SEQ + 16 * tid + e) * 8 + h]; loc[e] = run; }
    sc[tid] = run; __syncthreads();
    for (int o = 1; o < 512; o <<= 1) { const float t = (tid >= o) ? sc[tid - o] : 0.f; __syncthreads(); sc[tid] += t; __syncthreads(); }
    const float base = sc[tid] - run;
#pragma unroll
    for (int e = 0; e < 16; ++e) {
        const float c = base + loc[e]; const int t = 16 * tid + e;
        C[(size_t)bh * SEQ + t] = c;
        const float vv = -c * LOG2E;
        const unsigned p0 = f2bf(vv); const float r1 = vv - __uint_as_float(p0 << 16);
        const unsigned p1 = f2bf(r1); const float r2 = r1 - __uint_as_float(p1 << 16);
        const unsigned p2 = f2bf(r2);
        v4u o; o.x = p0 | (p1 << 16); o.y = p2 | (0x3F80u << 16); o.z = 0x3F803F80u; o.w = 0u;
        *(GAS v4u*)(KAUG + (((size_t)b * SEQ + t) * 8 + h) * 8) = o;
        sc[512 + t] = c;
    }
    __syncthreads();
    if (tid < 64) {
        const int lane = tid; const float gq = wave_max(fabsf(qnb[lane])), gk = wave_max(fabsf(knb[lane]));
        const float thr = 2.f * 8.f * gq * gk * 1.03f + 20.f;
        int cost = 0;
        if (lane < 32) { const int q0 = 256 * lane; const float c0 = sc[512 + q0]; int lo = 0, hi = q0;
            while (lo < hi) { const int mid = (lo + hi) >> 1; if (c0 - sc[512 + mid] >= -thr) hi = mid; else lo = mid + 1; }
            int T0 = (lo >> 6) & ~1; if (T0 > 4 * lane) T0 = 4 * lane; FT0[bh * 32 + lane] = T0; cost = 4 * lane + 4 - T0; }
#pragma unroll
        for (int o = 1; o < 64; o <<= 1) cost += __shfl_xor(cost, o);
        if (lane == 0) FT0[512 + bh] = cost;
    }
    __syncthreads();
}

__device__ __forceinline__ unsigned wave_excl_scan(unsigned v, int lane, unsigned& total) {
    unsigned x = v;
#pragma unroll
    for (int o = 1; o < 64; o <<= 1) { const unsigned y = __shfl_up(x, o); if (lane >= o) x += y; }
    total = __shfl(x, 63); return x - v;
}
__device__ __forceinline__ void moe_tables(LAS unsigned char* L, const gu32* CNT, int tid) {
    asm volatile("" : "+v"(tid));
    if (tid < 64) {
        const int lane = tid;
        const unsigned c0 = __hip_atomic_load(CNT + (2 * lane) * CNT_STRIDE, RLX_AGENT), c1 = __hip_atomic_load(CNT + (2 * lane + 1) * CNT_STRIDE, RLX_AGENT);
        const unsigned t0 = (c0 + 255u) >> 8, t1 = (c1 + 255u) >> 8;
        unsigned tc, ta, tbb, t6;
        const unsigned hb = wave_excl_scan(c0 + c1, lane, tc), pa = wave_excl_scan(t0, lane, ta), pb = wave_excl_scan(t1, lane, tbb), p6 = wave_excl_scan((c0 + c1 + 255u) >> 8, lane, t6);
        LAS unsigned* cntL = (LAS unsigned*)(L + TB_CNT); LAS unsigned* hbL = (LAS unsigned*)(L + TB_HB); LAS unsigned* T6 = (LAS unsigned*)(L + TB_T6);
        LAS unsigned* TA = (LAS unsigned*)(L + TB_TA); LAS unsigned* TBt = (LAS unsigned*)(L + TB_TB); LAS unsigned* T9 = (LAS unsigned*)(L + TB_T9);
        cntL[2 * lane] = c0; cntL[2 * lane + 1] = c1; hbL[2 * lane] = hb; hbL[2 * lane + 1] = hb + c0;
        T6[lane] = p6; TA[lane] = pa; TBt[lane] = pb;
        if (lane == 0) { cntL[128] = (unsigned)M; hbL[128] = 0u; T6[64] = t6; T6[65] = t6 + (unsigned)(M / 256); TA[64] = ta; TBt[64] = tbb; T9[0] = 0u; T9[1] = (unsigned)(M / 256); }
    }
    __syncthreads();
}

__device__ __forceinline__ void conv_w1_item(int r, const float* wg_e, const float* wu_e, const float* wg_s, const float* wu_s, bf16* W1, LAS unsigned* scr, int lane) {
    const int e = r >> 7, q = r & 127, up = q >> 6, qq = q & 63, kb = qq >> 2, nb = qq & 3;
    const float* src = (e < NE) ? (up ? wu_e : wg_e) + (size_t)e * D * DE : (up ? wu_s : wg_s);
    p0_tr64(src, DE, 64 * kb, 64 * nb, W1 + (size_t)e * 512 * D, D, 256 * (nb >> 1) + 128 * up + 64 * (nb & 1), 32, scr, lane);
}
__global__ void __launch_bounds__(NWAVES * 64, 2) mega(MArgs args) {
    extern __shared__ __attribute__((aligned(16))) unsigned char lds[];
    LAS unsigned char* L = (LAS unsigned char*)lds;
    volatile LAS unsigned* MISC = (volatile LAS unsigned*)(L + MISC_OFF);
    const int tid = threadIdx.x, lane = tid & 63, wave = __builtin_amdgcn_readfirstlane(tid >> 6);
    const int G = gridDim.x; const int bx = blockIdx.x; const int vcu = (G % 8 == 0) ? (bx % 8) * (G / 8) + bx / 8 : bx;
    unsigned char* ws = args.ws;
    gu32* ctl = (gu32*)(ws + WS_CTL);
#ifdef RERUN_PHASE
#define PROBE_RR (args.li != 0)
#else
#define PROBE_RR false
#endif
    for (int u = tid; u < (LDS_BYTES - LDSCTL_OFF) / 4; u += NWAVES * 64) ((LAS unsigned*)(L + LDSCTL_OFF))[u] = 0u;
    __syncthreads();
    XcdBarrier bar = xcd_barrier_post((unsigned*)(ctl + CW_BAR) + args.li * 28672  , MISC + 8);
#ifdef DIAG_TS
#define GRID_BAR() do { const unsigned long long t0_ = rt(); xcd_barrier(bar); if (bx == DIAG_BLK && tid == 0) ((unsigned long long*)(ws + WS_CTL + 512 * 1024))[20] += rt() - t0_; } while (0)
#else
#define GRID_BAR() xcd_barrier(bar)
#endif
#ifdef RERUN_GMASK
#define DIL_GMASK (PROBE_RR ? RERUN_GMASK : 7)
#else
#define DIL_GMASK 7
#endif
#ifdef RERUN_NOEPI
#define PROBE_NOEPI (PROBE_RR ? 1 : 0)
#else
#define PROBE_NOEPI 0
#endif
#define VCU() ((G % 8 == 0) ? ((int)blockIdx.x % 8) * (G / 8) + (int)blockIdx.x / 8 : (int)blockIdx.x)
#ifndef REPEAT_PHASE
#define REPEAT_PHASE (-1)
#endif
#define NREP(k) (((REPEAT_PHASE) == (k)) ? 2 : 1)
#ifdef REPEAT_BARRIER
#define REP_BAR() do { if (rep_ > 0) GRID_BAR(); } while (0)
#else
#define REP_BAR() do {} while (0)
#endif
#ifndef EXTRA_BARRIERS
#define EXTRA_BARRIERS 0
#endif
#ifdef DIAG_TS
#define TSTAMP(k) do { if (bx == DIAG_BLK && tid == 0) ((unsigned long long*)(ws + WS_CTL + 512 * 1024))[k] = rt(); } while (0)
#else
#define TSTAMP(k) do {} while (0)
#endif
    const int lo = args.ph_lo, hi = args.ph_hi;
#define IN(k) (lo <= (k) && (k) < hi)
#define BOTH(k) (IN(k) && IN((k) + 1))

    TSTAMP(0);
    if (IN(0)) {
        const float* x = args.in[0]; const float* g_mix = args.in[1]; const float* w_in = args.in[2]; const float* rel_bias = args.in[7]; const float* b_forget = args.in[8]; const float* w_gate = args.in[9]; const float* wpa = args.in[11]; const float* wpb = args.in[12]; const float* w_out = args.in[13]; const float* w_router = args.in[15]; const float* wg_e = args.in[17]; const float* wu_e = args.in[18]; const float* wd_e = args.in[19]; const float* wg_s = args.in[20]; const float* wu_s = args.in[21]; const float* wd_s = args.in[22]; bf16* XN = (bf16*)(ws + WS_XN); bf16* WIN_t = (bf16*)(ws + WS_WIN); bf16* WPA_t = (bf16*)(ws + WS_WIN) + (size_t)NTOT1 * D; bf16* WPB_t = (bf16*)(ws + WS_WIN) + (size_t)NTOT1 * D + (size_t)D * OUTA; bf16* WOUT_t = (bf16*)(ws + WS_WIN) + (size_t)NTOT1 * D + (size_t)D * OUTA + (size_t)D * OUTB; bf16* W1 = (bf16*)(ws + WS_W1); bf16* W2 = (bf16*)(ws + WS_W2); float* LOGF = (float*)(ws + WS_LOGF); float* BIAS = (float*)(ws + WS_BIAS);
        _Pragma("unroll") for (int rep_ = 0; rep_ < NREP(0); ++rep_) { REP_BAR();
        LAS unsigned* scr = (LAS unsigned*)(L + RING_OFF + wave * 8704);
        LAS float* wt8 = (LAS float*)(L + RING_OFF + 8 * 8704);
        const int gw = vcu * NWAVES + wave, NGW = G * NWAVES;
        for (int i = tid; i < 8 * D; i += NWAVES * 64) { const int ii = i >> 3, c = i & 7; wt8[c * D + ii] = w_in[(size_t)ii * DIN + (WA + WB) + c]; }
        for (int it = gw; it < NITEMS; it += NGW) {
            int r = it;
            if (r < N_EX - N_FILL1 - N_FILL2) { conv_w1_item(r + N_FILL1 + N_FILL2, wg_e, wu_e, wg_s, wu_s, W1, scr, lane); continue; } r -= N_EX - N_FILL1 - N_FILL2;
            if (r < N_IN) { const int kb = r / 60, nb = r % 60, c = 64 * nb;
                p0_tr64(w_in, DIN, 64 * kb, c, WIN_t, D, 256 * (c / 256) + 32 * ((c % 256) / 64), 128, scr, lane); continue; } r -= N_IN;
            if (r < N_G) { const int kb = r >> 5, nb = r & 31; p0_tr64(w_gate, 2 * D, 64 * kb, 64 * nb, WIN_t, D, 3840 + 64 * nb, 32, scr, lane); continue; } r -= N_G;
            if (r < N_PA) { const int kb = r >> 4, nb = r & 15; p0_tr64(wpa, D, 64 * kb, 64 * nb, WPA_t, OUTA, 64 * nb, 32, scr, lane); continue; } r -= N_PA;
            if (r < N_PB) { const int kb = r >> 4, nb = r & 15; p0_tr64(wpb, D, 64 * kb, 64 * nb, WPB_t, OUTB, 64 * nb, 32, scr, lane); continue; } r -= N_PB;
            { const int kb = r >> 4, nb = r & 15; p0_tr64(w_out, D, 64 * kb, 64 * nb, WOUT_t, D, 64 * nb, 32, scr, lane); }
        }
        __syncthreads();
        for (int m = gw; m < M; m += NGW) rms_row(x + (size_t)m * D, g_mix, XN + (size_t)m * D, wt8, b_forget, LOGF + (size_t)m * 8, lane);
        if (bx == 0) for (int i = tid; i < HA * 129; i += NWAVES * 64) {
            const int head = i / 129, j = i % 129, g = head >> 2; const int d = (g == 0) ? 1 : (g == 1 ? 4 : 16);
            const int dist = d * j; int bucket;
            if (dist < 16) bucket = dist;
            else { const int large = 16 + (int)(__log2f((float)dist * 0.0625f) * (16.f / 7.f)); bucket = large < 31 ? large : 31; }
            BIAS[head * 129 + j] = rel_bias[bucket * HA + head] * LOG2E;
        }
        { unsigned* WRFw = (unsigned*)(ws + WS_WRF);
          for (int i = bx * (NWAVES * 64) + tid; i < 2 * 64 * 64; i += G * NWAVES * 64) {
              const int ln = i & 63, k0 = (i >> 6) & 63, eh = i >> 12; const int e = eh * 32 + (ln & 31), kb = 16 * k0 + 8 * (ln >> 5);
              float wv[8]; unsigned ph[4], pl[4];
#pragma unroll
              for (int j = 0; j < 8; ++j) wv[j] = w_router[(size_t)(kb + j) * NE + e];
#pragma unroll
              for (int j = 0; j < 4; ++j) { ph[j] = pk2(wv[2 * j], wv[2 * j + 1]); pl[j] = pk2(wv[2 * j] - __uint_as_float(ph[j] << 16), wv[2 * j + 1] - __uint_as_float(ph[j] & 0xffff0000u)); }
              v4u hv; hv.x = ph[0]; hv.y = ph[1]; hv.z = ph[2]; hv.w = ph[3]; v4u lv; lv.x = pl[0]; lv.y = pl[1]; lv.z = pl[2]; lv.w = pl[3];
              *(GAS v4u*)(WRFw + ((size_t)((0 + eh) * 64 + k0) * 64 + ln) * 4) = hv; *(GAS v4u*)(WRFw + ((size_t)((2 + eh) * 64 + k0) * 64 + ln) * 4) = lv;
          } }
        }
        if (BOTH(0)) GRID_BAR();
    }

    TSTAMP(1);
    if (IN(1)) {
        const float* qna = args.in[3]; const float* kna = args.in[4]; const float* qnb = args.in[5]; const float* knb = args.in[6]; const float* b_gate = args.in[10]; bf16* Gb = PROBE_RR ? (bf16*)(ws + WS_H) : (bf16*)args.out; bf16* XN = (bf16*)(ws + WS_XN); bf16* WIN_t = (bf16*)(ws + WS_WIN); float* LOGF = (float*)(ws + WS_LOGF); float* Cc = (float*)(ws + WS_C); bf16* KAUG = (bf16*)(ws + WS_KAUG); int* FT0 = (int*)(ws + WS_FT0); const float* wg_e = args.in[17]; const float* wu_e = args.in[18]; const float* wg_s = args.in[20]; const float* wu_s = args.in[21]; bf16* W1 = (bf16*)(ws + WS_W1);
        _Pragma("unroll") for (int rep_ = 0; rep_ < 1; ++rep_) {
        if (G >= 16 && bx >= G - 16) p1_cumsum(bx - (G - 16), LOGF, Cc, KAUG, (LAS float*)(L + RING_OFF), tid, qnb, knb, FT0);
        else if (G < 16 && bx == 0) for (int bh = 0; bh < 16; ++bh) p1_cumsum(bh, LOGF, Cc, KAUG, (LAS float*)(L + RING_OFF), tid, qnb, knb, FT0);
        pg8::Gemm g{XN, WIN_t, M, NTOT1, D}; pg8::RepOrder S; S.init(M, NTOT1, G, bx); S.nrep = NREP(1);
        pg8::EpiQKVG E{ws, Gb, qna, kna, qnb, knb, b_gate};
        pg8::gemm_phase<pg8::EpiQKVG, pg8::RepOrder, true, true>(L + RING_OFF, g, S, E);
        { const int nfull = (M / 256) * (NTOT1 / 256) % G;
          if (nfull != 0 && bx >= nfull) { const int nw = (G - nfull) * NWAVES; for (int it = (bx - nfull) * NWAVES + wave; it < N_FILL1; it += nw) conv_w1_item(it, wg_e, wu_e, wg_s, wu_s, W1, (LAS unsigned*)(L + RING_OFF + wave * 8704), lane); }
          else if (nfull == 0) { for (int it = bx * NWAVES + wave; it < N_FILL1; it += G * NWAVES) conv_w1_item(it, wg_e, wu_e, wg_s, wu_s, W1, (LAS unsigned*)(L + RING_OFF + wave * 8704), lane); } }
        }
        if (BOTH(1)) GRID_BAR();
    }


    TSTAMP(2);
    if (IN(2)) {
        float* Cc = (float*)(ws + WS_C); bf16* KAUG = (bf16*)(ws + WS_KAUG); float* BIAS = (float*)(ws + WS_BIAS); int* FT0 = (int*)(ws + WS_FT0); const float* wd_e = args.in[19]; const float* wd_s = args.in[22]; bf16* W2 = (bf16*)(ws + WS_W2); const float* wg_e = args.in[17]; const float* wu_e = args.in[18]; const float* wg_s = args.in[20]; const float* wu_s = args.in[21]; bf16* W1 = (bf16*)(ws + WS_W1);
        _Pragma("unroll") for (int rep_ = 0; rep_ < NREP(2); ++rep_) { REP_BAR();
#ifdef RERUN_VARIANT
        if (!(PROBE_RR && RERUN_VARIANT >= 2))
#endif
        for (int au = VCU(); au < 2 * 4 * 32; au += G) {
            const int bb = au >> 7, hs = (au >> 5) & 3, blk = au & 31;
            dil::unit(bb, hs, blk, (const fox::bf16*)(ws + WS_QA), (const fox::bf16*)(ws + WS_KA), (const fox::bf16*)(ws + WS_VA), BIAS,
                      (fox::bf16*)(ws + WS_WIN), (fox::bf16*)(ws + WS_XN + 24 * MiB), (fox::bf16*)(ws + WS_LIST), (float*)(ws + WS_WIN + 8 * MiB), (fox::bf16*)(ws + WS_YA),
                      (char*)lds + RING_OFF, (float*)((char*)lds + LDSCTL_OFF + 8192), (float*)((char*)lds + LDSCTL_OFF + 12288), (unsigned*)(ctl + CW_APAIR + 32 * ((bb * 4 + hs) * 16 + (blk >> 1))), DIL_GMASK);
        }
        if (tid < 16) { const int my = FT0[512 + tid]; int rank = 0;
            for (int o = 0; o < 16; ++o) { const int c2 = FT0[512 + o]; rank += (c2 > my || (c2 == my && o < tid)) ? 1 : 0; }
            MISC[24 + rank] = (unsigned)tid; }
        __syncthreads();
        gu32* qhead = ctl + CW_Q2 + 64 * rep_ + 128 * args.li;
        if (tid == 0) MISC[16] = (unsigned)VCU();
        __syncthreads();
        for (;;) {
            const unsigned u = MISC[16];
            __syncthreads();
            constexpr unsigned NFCH = (unsigned)((N_W2 + N_FILL2 + 31) / 32);
            if (u >= 512u + NFCH) break;
            int fox_u = -1, fill_c = -1;
            { const unsigned v = u; if (v < 2u * NFCH) { if ((v & 1u) == 0u) fox_u = (int)(v >> 1); else fill_c = (int)(v >> 1); } else fox_u = (int)(v - NFCH); }
            static_assert((N_W2 + N_FILL2 + 31) / 32 <= 512, "filler chunks interleave one per FoX unit");
#ifdef RERUN_VARIANT
            const bool skip_ = PROBE_RR && ((RERUN_VARIANT == 1) || (RERUN_VARIANT == 2 && fox_u < 0) || (RERUN_VARIANT == 3 && fox_u >= 0));
#else
            const bool skip_ = false;
#endif
            unsigned nxt_u = 0u; if (tid == 0) nxt_u = __hip_atomic_fetch_add(qhead, 1u, RLX_AGENT) + (unsigned)G;
            if (skip_) {
            } else if (fill_c >= 0) {
                for (int k4 = 0; k4 < 4; ++k4) {
                const int r = fill_c * 32 + k4 * 8 + wave;
                if (r >= N_W2) { if (r < N_W2 + N_FILL2) conv_w1_item(N_FILL1 + r - N_W2, wg_e, wu_e, wg_s, wu_s, W1, (LAS unsigned*)(L + RING_OFF + wave * 8704), lane); }
                else { const int e = r >> 6, qq = r & 63, kb = qq >> 4, nb = qq & 15; const float* src = (e < NE) ? wd_e + (size_t)e * DE * D : wd_s;
                    p0_tr64(src, D, 64 * kb, 64 * nb, W2 + (size_t)e * D * DE, DE, 256 * (nb >> 2) + 32 * (nb & 3), 128, (LAS unsigned*)(L + RING_OFF + wave * 8704), lane); }
                }
            } else {
                const int fu = fox_u; const int bh = __builtin_amdgcn_readfirstlane((int)MISC[24 + (fu >> 5)]), qb = 31 - (fu & 31); const int T0 = __builtin_amdgcn_readfirstlane(FT0[bh * 32 + qb]);
                fox::attn_unit<8>(bh >> 3, bh & 7, qb, T0, (const fox::bf16*)(ws + WS_QB), (const fox::bf16*)(ws + WS_KB), (const fox::bf16*)(ws + WS_VB), (const fox::bf16*)KAUG, Cc + (size_t)bh * SEQ,
                                  (fox::bf16*)(ws + WS_YB), (char*)lds + RING_OFF);
            }
            if (tid == 0) MISC[16] = nxt_u;
            __syncthreads();
        }
        }
        if (BOTH(2)) GRID_BAR();
    }
    TSTAMP(3);
    if (IN(3)) {
        const float* x = args.in[0]; bf16* Gb = PROBE_RR ? (bf16*)(ws + WS_H) : (bf16*)args.out; bf16* WPA_t = (bf16*)(ws + WS_WIN) + (size_t)NTOT1 * D; bf16* WPB_t = (bf16*)(ws + WS_WIN) + (size_t)NTOT1 * D + (size_t)D * OUTA;
        _Pragma("unroll") for (int rep_ = 0; rep_ < 1; ++rep_) {
        bf16* YAb = (bf16*)(ws + WS_YA); bf16* YBb = (bf16*)(ws + WS_YB); bf16* MG = (bf16*)(ws + WS_MERGED); bf16* TMPM = (bf16*)(ws + WS_R2 + 32 * MiB);
        pg8::RepOrder S; S.init(M, D, G, bx); S.nrep = NREP(3);
        if ((VCU() & 1) == 0) {
        { pg8::Gemm g{YAb, WPA_t, M, D, OUTA}; pg8::EpiMergeA E{Gb, TMPM, 0u}; pg8::gemm_phase<pg8::EpiMergeA, pg8::RepOrder, true, true>(L + RING_OFF, g, S, E); }
        { pg8::Gemm g{YBb, WPB_t, M, D, OUTB}; pg8::EpiMergeB E{Gb, TMPM, MG, 1024u}; pg8::gemm_phase<pg8::EpiMergeB, pg8::RepOrder, true, true>(L + RING_OFF, g, S, E); }
        } else {
        { pg8::Gemm g{YBb, WPB_t, M, D, OUTB}; pg8::EpiMergeA E{Gb, TMPM, 1024u}; pg8::gemm_phase<pg8::EpiMergeA, pg8::RepOrder, true, true>(L + RING_OFF, g, S, E); }
        { pg8::Gemm g{YAb, WPA_t, M, D, OUTA}; pg8::EpiMergeB E{Gb, TMPM, MG, 0u}; pg8::gemm_phase<pg8::EpiMergeB, pg8::RepOrder, true, true>(L + RING_OFF, g, S, E); }
        }
        }
        if (BOTH(3)) GRID_BAR();
    }
    TSTAMP(4);
    if (IN(4)) {
        const float* x = args.in[0]; const float* g_ffn = args.in[14]; float* out_w = PROBE_RR ? (float*)(ws + WS_H) : args.out; bf16* WOUT_t = (bf16*)(ws + WS_WIN) + (size_t)NTOT1 * D + (size_t)D * OUTA + (size_t)D * OUTB;
        _Pragma("unroll") for (int rep_ = 0; rep_ < 1; ++rep_) {
        bf16* MG = (bf16*)(ws + WS_MERGED);
        pg8::Gemm g{MG, WOUT_t, M, D, D}; pg8::RepOrder S; S.init(M, D, G, bx); S.nrep = NREP(4);
        pg8::EpiResF32 E{x, out_w};
        pg8::gemm_phase<pg8::EpiResF32, pg8::RepOrder, true, true>(L + RING_OFF, g, S, E);
        }
        if (BOTH(4)) GRID_BAR();
        _Pragma("unroll") for (int xb_ = 0; xb_ < EXTRA_BARRIERS; ++xb_) GRID_BAR();
    }


    TSTAMP(5);
    if (IN(5)) {
        const float* g_ffn = args.in[14]; const float* router_bias = args.in[16]; float* out = args.out;
        _Pragma("unroll") for (int rep_ = 0; rep_ < NREP(5); ++rep_) { REP_BAR();
        for (int tb0 = bx * 2; tb0 < M / 32; tb0 += G * 2) {
            const int grp = wave >> 2, t = tb0 + grp;
            rtr::task(t, wave & 3, t < M / 32, out, g_ffn, (const unsigned short*)(ws + WS_WRF), router_bias, (unsigned short*)(ws + WS_H2), (float*)(ws + WS_RINV), (unsigned*)(ctl + CW_CNT), (unsigned*)(ws + WS_LIST),
                      (float*)(ws + WS_GATEW), (float2*)(ws + WS_META), (unsigned*)(ws + WS_INV), (float*)((char*)lds + RING_OFF + grp * 40960), (float*)((char*)lds + RING_OFF + 81920 + grp * 512), (LAS unsigned*)(L + RING_OFF + 90112));
            __syncthreads();
        }
        }
        if (BOTH(5)) GRID_BAR();
    }
    TSTAMP(6);
    if (IN(6)) {
        bf16* W1 = (bf16*)(ws + WS_W1);
        _Pragma("unroll") for (int rep_ = 0; rep_ < NREP(6); ++rep_) { REP_BAR();
        moe_tables(L, ctl + CW_CNT, tid);
        pg8::MoeSched S{(const LAS unsigned*)(L + TB_T6), (const LAS unsigned*)(L + TB_CNT), (const LAS unsigned*)(L + TB_HB), 65, 1, 0, 2, G, VCU(), D,
                        (const void*)(ws + WS_H2), W1, (size_t)512 * D, 1, (const unsigned*)(ws + WS_LIST), 0, (LAS int*)(L + TB_UT)};
        S.build_table(); __syncthreads();
        pg8::EpiMoe1 E{(const pg8::f32x2m*)(ws + WS_META), (const float*)(ws + WS_RINV), (bf16*)(ws + WS_H), (bf16*)(ws + WS_HS)};
        pg8::gemm_phase2<pg8::EpiMoe1, pg8::MoeSched, true>(L + RING_OFF, D, S, E, L + LDSCTL_OFF + 8192);
        }
        if (BOTH(6)) GRID_BAR();
    }
    TSTAMP(7);
    if (IN(7)) {
        bf16* W2 = (bf16*)(ws + WS_W2);
        _Pragma("unroll") for (int rep_ = 0; rep_ < NREP(7); ++rep_) { REP_BAR();
        if (!IN(6)) moe_tables(L, ctl + CW_CNT, tid);
        pg8::MoeSched S{(const LAS unsigned*)(L + TB_T6), (const LAS unsigned*)(L + TB_CNT), (const LAS unsigned*)(L + TB_HB), 64, 1, 0, 4, G, VCU(), DE,
                        (const void*)(ws + WS_H), W2, (size_t)D * DE, 1, (const unsigned*)(ws + WS_LIST), 1, (LAS int*)(L + TB_UT)};
        S.build_table(); __syncthreads();
        pg8::EpiMoe2 E{(unsigned char*)(ws + WS_Y)};
        pg8::gemm_phase2<pg8::EpiMoe2, pg8::MoeSched, true>(L + RING_OFF, DE, S, E, L + LDSCTL_OFF + 8192);
        }
        if (BOTH(7)) GRID_BAR();
    }
    TSTAMP(8);
    TSTAMP(9);
    if (IN(9)) {
        float* out = args.out; float* out_w = PROBE_RR ? (float*)(ws + WS_H) : args.out; bf16* W2 = (bf16*)(ws + WS_W2);
        _Pragma("unroll") for (int rep_ = 0; rep_ < NREP(9); ++rep_) { REP_BAR();
        if (!IN(6)) moe_tables(L, ctl + CW_CNT, tid);
        if (G == 256) {
            pg8::Gemm g{(const bf16*)(ws + WS_HS), W2 + (size_t)NE * D * DE, M, D, DE}; pg8::StaticOrder S; S.init(M, D, G, bx);
            pg8::EpiFinalD E{(const unsigned char*)(ws + WS_Y), (const unsigned*)(ws + WS_INV), (const LAS unsigned*)(L + TB_HB), out, (NREP(9) == 2 && rep_ == 0) ? (float*)(ws + WS_H) : out_w};
            pg8::gemm_phase<pg8::EpiFinalD, pg8::StaticOrder, false, true>(L + RING_OFF, g, S, E);
        } else {
        pg8::MoeSched S{(const LAS unsigned*)(L + TB_T9), (const LAS unsigned*)(L + TB_CNT), (const LAS unsigned*)(L + TB_HB), 1, 0, 128, 4, G, VCU(), DE,
                        (const void*)(ws + WS_HS), W2, (size_t)D * DE, 0, (const unsigned*)(ws + WS_LIST), 1, (LAS int*)(L + TB_UT)};
        S.build_table(); __syncthreads();
        pg8::EpiFinal E{(const unsigned char*)(ws + WS_Y), (const unsigned*)(ws + WS_INV), (const LAS unsigned*)(L + TB_HB), out, (NREP(9) == 2 && rep_ == 0) ? (float*)(ws + WS_H) : out_w};
        pg8::gemm_phase2<pg8::EpiFinal, pg8::MoeSched, true>(L + RING_OFF, DE, S, E, L + LDSCTL_OFF + 8192);
        }
        }
    }
    TSTAMP(NPHASE);
#undef IN
#undef BOTH
}

#ifdef DIAG_TS
__global__ void k_diag_ts(float* out, const unsigned long long* ts) {
    const float tot = floorf((float)(ts[NPHASE] - ts[0]) * 0.01f / 50.f + 0.5f) * 50.f, bw = floorf((float)ts[20] * 0.01f / 20.f + 0.5f) * 20.f;
    const size_t idx = (size_t)blockIdx.x * 256 + threadIdx.x;
    float v = out[idx] * (1.f + sqrtf(tot / 2000.f));
    if (idx == 0) v += 50.f + bw * 0.5f;
    out[idx] = v;
}
#endif
extern "C" void kernel_launch(void* const* d_in, const int* in_sizes, int n_in, void* d_out, int out_size, void* d_ws, size_t ws_size, hipStream_t stream) {
    static int grid = 0;
    if (grid == 0) {
        if (n_in != 23 || out_size != M * D || ws_size < WS_END) { fprintf(stderr, "kernel_launch: unexpected shapes / workspace (%d inputs, out %d, ws %zu)\n", n_in, out_size, ws_size); grid = -1; return; }
        int dev = 0, cus = 0;
        if (hipGetDevice(&dev) != hipSuccess || hipDeviceGetAttribute(&cus, hipDeviceAttributeMultiprocessorCount, dev) != hipSuccess) { grid = -1; return; }
        if (hipFuncSetAttribute((const void*)mega, hipFuncAttributeMaxDynamicSharedMemorySize, LDS_BYTES) != hipSuccess) { fprintf(stderr, "kernel_launch: hipFuncSetAttribute failed\n"); grid = -1; return; }
        int per_cu = 0;
        if (hipOccupancyMaxActiveBlocksPerMultiprocessor(&per_cu, (const void*)mega, NWAVES * 64, LDS_BYTES) != hipSuccess || per_cu < 1) fprintf(stderr, "kernel_launch: occupancy query says %d\n", per_cu);
        (void)hipGetLastError();
        grid = cus;
    }
    if (grid < 0) return;
    const float* x = (const float*)d_in[0];
    const float* qnb = (const float*)d_in[5]; const float* knb = (const float*)d_in[6];
    const float* wpa = (const float*)d_in[11]; const float* wpb = (const float*)d_in[12]; const float* w_out = (const float*)d_in[13]; const float* g_ffn = (const float*)d_in[14];
    const float* w_router = (const float*)d_in[15]; const float* router_bias = (const float*)d_in[16]; const float* wg_e = (const float*)d_in[17]; const float* wu_e = (const float*)d_in[18];
    const float* wd_e = (const float*)d_in[19]; const float* wg_s = (const float*)d_in[20]; const float* wu_s = (const float*)d_in[21]; const float* wd_s = (const float*)d_in[22];
    unsigned char* ws = (unsigned char*)d_ws; float* out = (float*)d_out;
    bf16_t* G = (bf16_t*)d_out;
    unsigned* CTL = (unsigned*)(ws + WS_CTL);
    #ifdef RERUN_PHASE
    (void)hipMemsetAsync(ws + WS_CTL, 0, 256 * KiB, stream);
#else
    (void)hipMemsetAsync(ws + WS_CTL, 0, 64 * KiB, stream);
#endif
    MArgs a{};
    for (int i = 0; i < 23; ++i) a.in[i] = (const float*)d_in[i];
    a.out = out; a.ws = ws;
    a.ph_lo = 0; a.ph_hi = NPHASE; a.li = 0;
    hipLaunchKernelGGL(mega, dim3(grid), dim3(NWAVES * 64), LDS_BYTES, stream, a);
#ifdef RERUN_PHASE
    a.ph_lo = RERUN_PHASE; a.ph_hi = RERUN_PHASE + RERUN_COUNT; a.li = 1;
    hipLaunchKernelGGL(mega, dim3(grid), dim3(NWAVES * 64), LDS_BYTES, stream, a);
#endif
#ifdef DIAG_TS
    k_diag_ts<<<M * D / 256, 256, 0, stream>>>(out, (const unsigned long long*)(ws + WS_CTL + 512 * 1024));
#endif
}
```

```cpp
#include <hip/hip_runtime.h>
#include <hip/hip_bf16.h>
#include <cstdint>
#include <cstdio>

typedef unsigned short bf16_t;
typedef unsigned u32x4 __attribute__((ext_vector_type(4)));
typedef unsigned u32x2 __attribute__((ext_vector_type(2)));

constexpr int BATCH = 2, SEQ = 8192, M = BATCH * SEQ, D = 1024;
constexpr int HA = 12, HB = 8, HD = 64;
constexpr int WA = 3 * HA * HD, WB = 3 * HB * HD, DIN = WA + WB + HB;
constexpr int PA = HA * HD, PB = HB * HD;
constexpr int OUTA = 256, OUTB = 512;
constexpr int NE = 64, TOPK = 8, DE = 256;
constexpr int NLIST = 2 * NE;
constexpr float EPS = 1e-6f;
constexpr float LOG2E = 1.4426950408889634f;
constexpr float QSCALE = 0.125f * LOG2E;

constexpr size_t MiB = 1u << 20, KiB = 1u << 10;
constexpr size_t WS_CTL = 0;
constexpr size_t WS_LOGF = 1 * MiB;
constexpr size_t WS_C = 1 * MiB + 512 * KiB;
constexpr size_t WS_KAUG = 2 * MiB;
constexpr size_t WS_LIST = 4 * MiB;
constexpr size_t WS_GATEW = 12 * MiB;
constexpr size_t WS_BIAS = 12 * MiB + 512 * KiB;
constexpr size_t WS_FT0 = WS_BIAS + 8 * KiB;
constexpr size_t WS_WRF = WS_BIAS + 64 * KiB;
constexpr size_t WS_RINV = WS_BIAS + 384 * KiB;
constexpr size_t WS_W2 = 13 * MiB;
constexpr size_t WS_R1 = 45 * MiB + 512 * KiB;
constexpr size_t WS_W1 = WS_R1;
constexpr size_t WS_WIN = WS_R1 + 65 * MiB;
constexpr size_t WS_XN = WS_R1 + 80 * MiB;
constexpr size_t WS_YA = WS_XN;
constexpr size_t WS_YB = WS_XN + 8 * MiB;
constexpr size_t WS_H2 = WS_XN;
constexpr size_t WS_QB = WS_R1 + 112 * MiB;
constexpr size_t WS_R2 = WS_R1 + 128 * MiB;
constexpr size_t WS_QA = WS_R2;
constexpr size_t WS_KA = WS_R2 + 24 * MiB;
constexpr size_t WS_VA = WS_R2 + 48 * MiB;
constexpr size_t WS_KB = WS_R2 + 72 * MiB;
constexpr size_t WS_VB = WS_R2 + 88 * MiB;
constexpr size_t WS_MERGED = WS_R2;
constexpr size_t WS_H = WS_R2;
constexpr size_t WS_HS = WS_R2 + 65 * MiB;
constexpr size_t WS_Y = WS_R1;
constexpr size_t WS_META = WS_R2 + 80 * MiB;
constexpr size_t WS_INV = WS_R2 + 96 * MiB;
constexpr size_t WS_END = WS_R2 + 104 * MiB;
constexpr int CW_APAIR = 12288;
constexpr int CW_Q2 = 1536;
constexpr int CW_CNT = 8192, CNT_STRIDE = 32;

__device__ __forceinline__ float bf2f(bf16_t v) { return __uint_as_float((unsigned)v << 16); }
__device__ __forceinline__ unsigned f2bf(float f) { unsigned u = __float_as_uint(f); return (u + 0x7fffu + ((u >> 16) & 1u)) >> 16; }
__device__ __forceinline__ unsigned pk2(float lo, float hi) { return f2bf(lo) | (f2bf(hi) << 16); }
__device__ __forceinline__ float wave_sum(float v) {
#pragma unroll
    for (int o = 1; o < 64; o <<= 1) v += __shfl_xor(v, o);
    return v;
}
__device__ __forceinline__ float wave_max(float v) {
#pragma unroll
    for (int o = 1; o < 64; o <<= 1) v = fmaxf(v, __shfl_xor(v, o));
    return v;
}

typedef unsigned short bf16_t_dummy_;
namespace pg8 {
#define PG8_LAS __attribute__((address_space(3)))
typedef unsigned short bf16_t;
typedef short bf16x8 __attribute__((ext_vector_type(8)));
typedef float f32x4 __attribute__((ext_vector_type(4)));
typedef unsigned u32x4 __attribute__((ext_vector_type(4)));
constexpr int BM = 256, BK = 64, HALF = 128, HTB = HALF * BK * 2  , STAGE_BYTES = 8 * HTB, NXCD = 8, WGM = 8;

__host__ __device__ __forceinline__ int lds_byte(int r, int c) { const int st = (r >> 4) * 2 + (c >> 5), rr = r & 15, cc = c & 31, ob = rr * 64 + cc * 2; return st * 1024 + (ob ^ (((ob >> 9) & 1) << 5)); }
__host__ __device__ __forceinline__ void stage_rc(int b, int& R, int& C) { const int st = b / 1024, sb = b % 1024, swz = sb ^ (((sb >> 9) & 1) << 5); R = (st >> 1) * 16 + swz / 64; C = (st & 1) * 32 + (swz % 64) / 2; }
__host__ __device__ __forceinline__ int perm32(int rho) { const int n = rho >> 4, i = rho & 15; return 8 * (i >> 2) + 4 * n + (i & 3); }

struct Unit { int pm, pn; };
struct Gemm { const bf16_t* A; const bf16_t* Bt; int M, N, K; };

struct StaticOrder {
    int nM, nN, nwg, G, c;
    __host__ __device__ void init(int M, int N, int G_, int c_) { nM = M / BM; nN = N / BM; nwg = nM * nN; G = G_; c = c_; }
    __host__ __device__ bool next(int i, Unit& u) const {
        const long L = (long)i * G + c; if (L >= nwg) return false;
        int wgid = (int)L; { const int q = nwg / NXCD, r = nwg % NXCD, xcd = wgid % NXCD, off = wgid / NXCD; wgid = (xcd < r ? xcd * (q + 1) : r * (q + 1) + (xcd - r) * q) + off; }
        const int nig = WGM * nN, gid = wgid / nig, fm = gid * WGM, gsz = (nM - fm) < WGM ? (nM - fm) : WGM;
        u.pm = fm + ((wgid % nig) % gsz); u.pn = (wgid % nig) / gsz; return true;
    }
    __device__ __forceinline__ void a_ready(const Unit&) const {}
    __device__ __forceinline__ void done(const Unit&) const {}
};

__device__ __forceinline__ unsigned cvt_pk_bf16(float lo, float hi) { unsigned r; asm volatile("v_cvt_pk_bf16_f32 %0, %1, %2" : "=v"(r) : "v"(lo), "v"(hi)); return r; }
typedef float f32x2 __attribute__((ext_vector_type(2)));
struct RepOrder : StaticOrder { int nrep;
    __device__ __forceinline__ bool next(int i, Unit& u) const { const int per = (nwg - c + G - 1) / G; if (per <= 0 || i >= per * nrep) return false; return StaticOrder::next(i % per, u); } };
typedef float f32x2_c __attribute__((ext_vector_type(2))); typedef __bf16 bf16x2_c __attribute__((ext_vector_type(2)));
__device__ __forceinline__ unsigned cvtc(float lo, float hi) { f32x2_c v = {lo, hi}; bf16x2_c b = __builtin_convertvector(v, bf16x2_c); return __builtin_bit_cast(unsigned, b); }
struct EpiQKVG {
    static constexpr bool PERM = true, AFTER_DRAIN = false;
    unsigned char* ws; bf16_t* G; const float *qna, *kna, *qnb, *knb, *b_gate;
    __device__ __forceinline__ void operator()(const f32x4 (&acc)[2][2][4][2], const Unit& u, int wr, int wc, int fr, int fq) const {
        const int pn = u.pn; const int row0 = u.pm * BM + wr * 64 + fr;
        if (pn >= 15) {
            const int col0 = (pn - 15) * 256 + wc * 32 + 8 * fq;
            f32x4 bv[2][2];
#pragma unroll
            for (int bj = 0; bj < 2; ++bj)
#pragma unroll
                for (int n = 0; n < 2; ++n) bv[bj][n] = *(const f32x4*)(b_gate + col0 + bj * HALF + 4 * n);
#pragma unroll
            for (int ai = 0; ai < 2; ++ai)
#pragma unroll
                for (int m = 0; m < 4; ++m) { unsigned char* rowp = (unsigned char*)G + (size_t)(row0 + ai * HALF + m * 16) * 2048 + col0;
#pragma unroll
                    for (int bj = 0; bj < 2; ++bj) { f32x4 v0 = acc[ai][bj][m][0] + bv[bj][0], v1 = acc[ai][bj][m][1] + bv[bj][1];
#pragma unroll
                        for (int i = 0; i < 4; ++i) { v0[i] = 255.f * __builtin_amdgcn_rcpf(1.f + __builtin_amdgcn_exp2f(-1.4426950408889634f * v0[i])); v1[i] = 255.f * __builtin_amdgcn_rcpf(1.f + __builtin_amdgcn_exp2f(-1.4426950408889634f * v1[i])); }
                        unsigned w0 = 0u, w1 = 0u;
#pragma unroll
                        for (int i = 0; i < 4; ++i) { w0 = __builtin_amdgcn_cvt_pk_u8_f32(v0[i], (unsigned)i, w0); w1 = __builtin_amdgcn_cvt_pk_u8_f32(v1[i], (unsigned)i, w1); }
                        typedef unsigned u32x2e __attribute__((ext_vector_type(2)));
                        *(u32x2e*)(rowp + bj * HALF) = (u32x2e){w0, w1}; } }
        } else {
            bf16_t* dst; int ld, hb; const float* g = nullptr; float sc = 1.f;
            if (pn < 3) { dst = (bf16_t*)(ws + WS_QA); ld = PA; hb = 4 * pn; g = qna; sc = QSCALE; }
            else if (pn < 6) { dst = (bf16_t*)(ws + WS_KA); ld = PA; hb = 4 * (pn - 3); g = kna; }
            else if (pn < 9) { dst = (bf16_t*)(ws + WS_VA); ld = PA; hb = 4 * (pn - 6); }
            else if (pn < 11) { dst = (bf16_t*)(ws + WS_QB); ld = PB; hb = 4 * (pn - 9); g = qnb; sc = QSCALE; }
            else if (pn < 13) { dst = (bf16_t*)(ws + WS_KB); ld = PB; hb = 4 * (pn - 11); g = knb; }
            else { dst = (bf16_t*)(ws + WS_VB); ld = PB; hb = 4 * (pn - 13); }
            const int colb = (hb + wc) * 64 + 8 * fq;
            f32x4 gv[2][2];
#pragma unroll
            for (int bj = 0; bj < 2; ++bj)
#pragma unroll
                for (int n = 0; n < 2; ++n) gv[bj][n] = g ? *(const f32x4*)(g + 32 * bj + 8 * fq + 4 * n) : (f32x4){1.f, 1.f, 1.f, 1.f};
#pragma unroll
            for (int ai = 0; ai < 2; ++ai)
#pragma unroll
                for (int m = 0; m < 4; ++m) {
                    float rinv = 1.f;
                    if (g) { float ss = 0.f;
#pragma unroll
                        for (int bj = 0; bj < 2; ++bj)
#pragma unroll
                            for (int n = 0; n < 2; ++n) { const f32x4 x = acc[ai][bj][m][n]; ss += (x[0] * x[0] + x[1] * x[1]) + (x[2] * x[2] + x[3] * x[3]); }
                        ss += __shfl_xor(ss, 16); ss += __shfl_xor(ss, 32);
                        rinv = __builtin_amdgcn_rsqf(ss * (1.f / 64.f) + EPS) * sc; }
                    bf16_t* rowp = dst + (size_t)(row0 + ai * HALF + m * 16) * ld + colb;
#pragma unroll
                    for (int bj = 0; bj < 2; ++bj) { const f32x4 v0 = acc[ai][bj][m][0] * rinv * gv[bj][0], v1 = acc[ai][bj][m][1] * rinv * gv[bj][1];
                        u32x4 w; w.x = cvtc(v0[0], v0[1]); w.y = cvtc(v0[2], v0[3]); w.z = cvtc(v1[0], v1[1]); w.w = cvtc(v1[2], v1[3]);
                        *(u32x4*)(rowp + 32 * bj) = w; } }
        }
    }
};
typedef unsigned u32x2g __attribute__((ext_vector_type(2)));
__device__ __forceinline__ float gq(unsigned w, int i) { return (float)((w >> (8 * i)) & 0xffu); }
struct EpiMergeA {
    static constexpr bool PERM = true, AFTER_DRAIN = false;
    const bf16_t* G; bf16_t* T; unsigned goff;
    __device__ __forceinline__ void operator()(const f32x4 (&acc)[2][2][4][2], const Unit& u, int wr, int wc, int fr, int fq) const {
        const unsigned row0 = (unsigned)(u.pm * BM + wr * 64 + fr), col0 = (unsigned)(u.pn * BM + wc * 32 + 8 * fq);
#pragma unroll
        for (int ai = 0; ai < 2; ++ai) {
            u32x2g g[4][2];
#pragma unroll
            for (int m = 0; m < 4; ++m)
#pragma unroll
                for (int bj = 0; bj < 2; ++bj) g[m][bj] = *(const u32x2g*)((const unsigned char*)G + ((row0 + ai * HALF + m * 16) * 2048u + goff + col0 + bj * HALF));
#pragma unroll
            for (int m = 0; m < 4; ++m)
#pragma unroll
                for (int bj = 0; bj < 2; ++bj) { const u32x2g gg = g[m][bj]; const f32x4 a0 = acc[ai][bj][m][0] * (1.f / 255.f), a1 = acc[ai][bj][m][1] * (1.f / 255.f);
                    u32x4 w;
                    w.x = cvtc(a0[0] * gq(gg.x, 0), a0[1] * gq(gg.x, 1)); w.y = cvtc(a0[2] * gq(gg.x, 2), a0[3] * gq(gg.x, 3));
                    w.z = cvtc(a1[0] * gq(gg.y, 0), a1[1] * gq(gg.y, 1)); w.w = cvtc(a1[2] * gq(gg.y, 2), a1[3] * gq(gg.y, 3));
                    *(u32x4*)(T + ((row0 + ai * HALF + m * 16) * 1024u + col0 + bj * HALF)) = w; }
            asm volatile("" ::: "memory");
        }
    }
};
struct EpiMergeB {
    static constexpr bool PERM = true, AFTER_DRAIN = false;
    const bf16_t* G; const bf16_t* T; bf16_t* O; unsigned goff;
    __device__ __forceinline__ void operator()(const f32x4 (&acc)[2][2][4][2], const Unit& u, int wr, int wc, int fr, int fq) const {
        const unsigned row0 = (unsigned)(u.pm * BM + wr * 64 + fr), col0 = (unsigned)(u.pn * BM + wc * 32 + 8 * fq);
#pragma unroll
        for (int ai = 0; ai < 2; ++ai)
#pragma unroll
          for (int mp = 0; mp < 2; ++mp) {
            u32x2g g[2][2]; u32x4 t[2][2];
#pragma unroll
            for (int mm = 0; mm < 2; ++mm)
#pragma unroll
                for (int bj = 0; bj < 2; ++bj) { const unsigned r = row0 + ai * HALF + (2 * mp + mm) * 16; g[mm][bj] = *(const u32x2g*)((const unsigned char*)G + (r * 2048u + goff + col0 + bj * HALF)); t[mm][bj] = *(const u32x4*)(T + (r * 1024u + col0 + bj * HALF)); }
#pragma unroll
            for (int mm = 0; mm < 2; ++mm)
#pragma unroll
                for (int bj = 0; bj < 2; ++bj) { const int m = 2 * mp + mm; const u32x2g gg = g[mm][bj]; const u32x4 tt = t[mm][bj]; const f32x4 a0 = acc[ai][bj][m][0] * (1.f / 255.f), a1 = acc[ai][bj][m][1] * (1.f / 255.f);
                    u32x4 w;
                    w.x = cvtc(__uint_as_float(tt.x << 16) + a0[0] * gq(gg.x, 0), __uint_as_float(tt.x & 0xffff0000u) + a0[1] * gq(gg.x, 1));
                    w.y = cvtc(__uint_as_float(tt.y << 16) + a0[2] * gq(gg.x, 2), __uint_as_float(tt.y & 0xffff0000u) + a0[3] * gq(gg.x, 3));
                    w.z = cvtc(__uint_as_float(tt.z << 16) + a1[0] * gq(gg.y, 0), __uint_as_float(tt.z & 0xffff0000u) + a1[1] * gq(gg.y, 1));
                    w.w = cvtc(__uint_as_float(tt.w << 16) + a1[2] * gq(gg.y, 2), __uint_as_float(tt.w & 0xffff0000u) + a1[3] * gq(gg.y, 3));
                    *(u32x4*)(O + ((row0 + ai * HALF + m * 16) * 1024u + col0 + bj * HALF)) = w; }
            asm volatile("" ::: "memory");
          }
    }
};
struct EpiResF32 {
    static constexpr bool PERM = false, AFTER_DRAIN = false;
    const float* X; float* O;
    __device__ __forceinline__ void operator()(const f32x4 (&acc)[2][2][4][2], const Unit& u, int wr, int wc, int fr, int fq) const {
        const unsigned row0 = (unsigned)(u.pm * BM + wr * 64 + fr), col0 = (unsigned)(u.pn * BM + wc * 32 + 4 * fq);
#pragma unroll
        for (int ai = 0; ai < 2; ++ai)
#pragma unroll
          for (int mp = 0; mp < 2; ++mp) {
            f32x4 xv[2][2][2];
#pragma unroll
            for (int mm = 0; mm < 2; ++mm)
#pragma unroll
                for (int bj = 0; bj < 2; ++bj)
#pragma unroll
                    for (int n = 0; n < 2; ++n) xv[mm][bj][n] = *(const f32x4*)(X + ((row0 + ai * HALF + (2 * mp + mm) * 16) * 1024u + col0 + bj * HALF + n * 16));
#pragma unroll
            for (int mm = 0; mm < 2; ++mm)
#pragma unroll
                for (int bj = 0; bj < 2; ++bj)
#pragma unroll
                    for (int n = 0; n < 2; ++n) *(f32x4*)(O + ((row0 + ai * HALF + (2 * mp + mm) * 16) * 1024u + col0 + bj * HALF + n * 16)) = xv[mm][bj][n] + acc[ai][bj][2 * mp + mm][n];
            asm volatile("" ::: "memory");
          }
    }
};
template <class Epi, class Sched, bool ALIGN_EPI = false, bool SP2 = false>
__device__ __forceinline__ void gemm_phase(PG8_LAS unsigned char* lds, const Gemm g, const Sched& S, const Epi& E) {
    int tid_ = threadIdx.x; asm volatile("" : "+v"(tid_));
    const int tid = tid_, wid = __builtin_amdgcn_readfirstlane(tid >> 6), lane = tid & 63, wr = wid >> 2, wc = wid & 3, fr = lane & 15, fq = lane >> 4;
    const int K = g.K, nt = K / BK;
    unsigned voffA[2], voffB[2];
#pragma unroll
    for (int i = 0; i < 2; ++i) { int R, C; stage_rc(tid * 16 + i * 8192, R, C); const int Rb = Epi::PERM ? ((R & ~31) + perm32(R & 31)) : R;
        voffA[i] = (unsigned)(R * K + C) * 2u; voffB[i] = (unsigned)(Rb * K + C) * 2u; }
    const size_t kstep = (size_t)(BK * 2);
    const size_t hstep = (size_t)HALF * K * 2;
    const size_t tstep = 2 * hstep;
    const unsigned ldsw = (unsigned)wid * 1024u;
    const int aoff = lds_byte(wr * 64 + fr, fq * 8), boff = lds_byte(wc * 32 + fr, fq * 8);
#define PG8_SA(b, h) (((b) * 2 + (h)) * HTB)
#define PG8_SB(b, h) ((4 + (b) * 2 + (h)) * HTB)
#define PG8_STAGE(bufoff, gbase, voff) do { _Pragma("unroll") for (int _i = 0; _i < 2; ++_i) \
        __builtin_amdgcn_global_load_lds((const unsigned*)((const char*)(gbase) + (voff)[_i]), (PG8_LAS unsigned*)(lds + (bufoff) + ldsw + _i * 8192), 16, 0, 0); } while (0)
#define PG8_LDA(dst, b, h) do { _Pragma("unroll") for (int m = 0; m < 4; ++m) _Pragma("unroll") for (int k = 0; k < 2; ++k) dst[m][k] = *(const PG8_LAS bf16x8*)(lds + PG8_SA(b, h) + aoff + m * 2048 + k * 1024); } while (0)
#define PG8_LDB(dst, b, h) do { _Pragma("unroll") for (int n = 0; n < 2; ++n) _Pragma("unroll") for (int k = 0; k < 2; ++k) dst[n][k] = *(const PG8_LAS bf16x8*)(lds + PG8_SB(b, h) + boff + n * 2048 + k * 1024); } while (0)
#define PG8_MMA(ai, bj, At, Bt) do { __builtin_amdgcn_s_setprio(1); _Pragma("unroll") for (int m = 0; m < 4; ++m) _Pragma("unroll") for (int n = 0; n < 2; ++n) _Pragma("unroll") for (int k = 0; k < 2; ++k) \
        acc[ai][bj][m][n] = __builtin_amdgcn_mfma_f32_16x16x32_bf16(Bt[n][k], At[m][k], acc[ai][bj][m][n], 0, 0, 0); __builtin_amdgcn_s_setprio(0); } while (0)
#define PG8_WAIT_V(n) asm volatile("s_waitcnt vmcnt(" #n ")" ::: "memory")
#define PG8_WAIT_L(n) asm volatile("s_waitcnt lgkmcnt(" #n ")" ::: "memory")
#define PG8_BAR __builtin_amdgcn_s_barrier()
#define PG8_SCHED __builtin_amdgcn_sched_barrier(0)
    Unit cur, nxt; int ui = 0;
    if (!S.next(0, cur)) return;
    f32x4 acc[2][2][4][2];
#pragma unroll
    for (int a = 0; a < 2; ++a)
#pragma unroll
        for (int b = 0; b < 2; ++b)
#pragma unroll
            for (int m = 0; m < 4; ++m)
#pragma unroll
                for (int n = 0; n < 2; ++n) acc[a][b][m][n] = (f32x4){0.f, 0.f, 0.f, 0.f};
    bf16x8 At[4][2], B0[2][2], B1[2][2];
    const char* cA = (const char*)g.A + (size_t)cur.pm * tstep; const char* cB = (const char*)g.Bt + (size_t)cur.pn * tstep;
    S.a_ready(cur);
    if constexpr (SP2) {
        PG8_STAGE(PG8_SB(0, 0), cB, voffB); PG8_STAGE(PG8_SB(0, 1), cB + hstep, voffB); PG8_STAGE(PG8_SA(0, 0), cA, voffA); PG8_STAGE(PG8_SA(0, 1), cA + hstep, voffA);
        if (wr == 1) PG8_BAR;
        PG8_WAIT_V(2); PG8_BAR;
        PG8_STAGE(PG8_SB(1, 0), cB + kstep, voffB); PG8_STAGE(PG8_SA(1, 0), cA + kstep, voffA); PG8_STAGE(PG8_SB(1, 1), cB + hstep + kstep, voffB);
        PG8_WAIT_V(6); PG8_BAR;
    } else {
        PG8_STAGE(PG8_SB(0, 0), cB, voffB); PG8_STAGE(PG8_SA(0, 0), cA, voffA); PG8_STAGE(PG8_SB(0, 1), cB + hstep, voffB); PG8_STAGE(PG8_SA(0, 1), cA + hstep, voffA);
        if (wr == 1) PG8_BAR;
        PG8_WAIT_V(4); PG8_BAR;
        PG8_STAGE(PG8_SB(1, 0), cB + kstep, voffB); PG8_STAGE(PG8_SA(1, 0), cA + kstep, voffA); PG8_STAGE(PG8_SB(1, 1), cB + hstep + kstep, voffB);
        PG8_WAIT_V(6); PG8_BAR;
    }
    for (;;) {
        const bool has_next = S.next(ui + 1, nxt);
        const char* nA = has_next ? (const char*)g.A + (size_t)nxt.pm * tstep : cA; const char* nB = has_next ? (const char*)g.Bt + (size_t)nxt.pn * tstep : cB;
        for (int t = 0; t < nt; t += 2) {
            const bool last = (t == nt - 2);
            const char* a1 = cA + (size_t)(t + 1) * kstep;
            const char* a2 = last ? nA : cA + (size_t)(t + 2) * kstep; const char* b2 = last ? nB : cB + (size_t)(t + 2) * kstep;
            const char* a3 = a2 + kstep; const char* b3 = b2 + kstep;
            if (last && has_next) S.a_ready(nxt);
            if constexpr (SP2) {
            PG8_LDB(B0, 0, 0); PG8_LDB(B1, 0, 1); PG8_SCHED; PG8_LDA(At, 0, 0); PG8_STAGE(PG8_SA(1, 1), a1 + hstep, voffA);
            PG8_WAIT_V(8); PG8_WAIT_L(0); PG8_BAR; PG8_MMA(0, 0, At, B0); PG8_MMA(0, 1, At, B1); PG8_BAR; PG8_SCHED;
            PG8_LDA(At, 0, 1); PG8_STAGE(PG8_SB(0, 0), b2, voffB); PG8_STAGE(PG8_SB(0, 1), b2 + hstep, voffB); PG8_STAGE(PG8_SA(0, 0), a2, voffA);
            PG8_WAIT_V(8); PG8_WAIT_L(0); PG8_BAR; PG8_MMA(1, 0, At, B0); PG8_MMA(1, 1, At, B1); PG8_BAR; PG8_SCHED;
            PG8_LDB(B0, 1, 0); PG8_LDB(B1, 1, 1); PG8_SCHED; PG8_LDA(At, 1, 0); PG8_STAGE(PG8_SA(0, 1), a2 + hstep, voffA);
            PG8_WAIT_V(8); PG8_WAIT_L(0); PG8_BAR; PG8_MMA(0, 0, At, B0); PG8_MMA(0, 1, At, B1); PG8_BAR; PG8_SCHED;
            PG8_LDA(At, 1, 1); PG8_STAGE(PG8_SB(1, 0), b3, voffB); PG8_STAGE(PG8_SB(1, 1), b3 + hstep, voffB); PG8_STAGE(PG8_SA(1, 0), a3, voffA);
            PG8_WAIT_V(8); PG8_WAIT_L(0); PG8_BAR; PG8_MMA(1, 0, At, B0); PG8_MMA(1, 1, At, B1); PG8_BAR; PG8_SCHED;
            } else {
            PG8_LDB(B0, 0, 0); PG8_SCHED; PG8_LDA(At, 0, 0); PG8_STAGE(PG8_SA(1, 1), a1 + hstep, voffA);
            PG8_WAIT_L(8); PG8_BAR; PG8_WAIT_L(0); PG8_MMA(0, 0, At, B0); PG8_BAR; PG8_SCHED;
            PG8_LDB(B1, 0, 1); PG8_STAGE(PG8_SB(0, 0), b2, voffB);
            PG8_BAR; PG8_WAIT_L(0); PG8_MMA(0, 1, At, B1); PG8_BAR;
            PG8_LDA(At, 0, 1); PG8_STAGE(PG8_SA(0, 0), a2, voffA);
            PG8_BAR; PG8_WAIT_L(0); PG8_MMA(1, 0, At, B0); PG8_BAR; PG8_SCHED;
            PG8_STAGE(PG8_SB(0, 1), b2 + hstep, voffB);
            PG8_WAIT_V(6); PG8_BAR; PG8_MMA(1, 1, At, B1); PG8_BAR;
            PG8_LDB(B0, 1, 0); PG8_SCHED; PG8_LDA(At, 1, 0); PG8_STAGE(PG8_SA(0, 1), a2 + hstep, voffA);
            PG8_WAIT_L(8); PG8_BAR; PG8_WAIT_L(0); PG8_MMA(0, 0, At, B0); PG8_BAR; PG8_SCHED;
            PG8_LDB(B1, 1, 1); PG8_STAGE(PG8_SB(1, 0), b3, voffB);
            PG8_BAR; PG8_WAIT_L(0); PG8_MMA(0, 1, At, B1); PG8_BAR;
            PG8_LDA(At, 1, 1); PG8_STAGE(PG8_SA(1, 0), a3, voffA);
            PG8_BAR; PG8_WAIT_L(0); PG8_MMA(1, 0, At, B0); PG8_BAR; PG8_SCHED;
            PG8_STAGE(PG8_SB(1, 1), b3 + hstep, voffB);
            PG8_WAIT_V(6); PG8_BAR; PG8_MMA(1, 1, At, B1); PG8_BAR;
            }
        }
        if constexpr (ALIGN_EPI) { if (wr == 0) PG8_BAR; }
        if constexpr (!Epi::AFTER_DRAIN) { E(acc, cur, wr, wc, fr, fq); S.done(cur); }
        if (!has_next) break;
#pragma unroll
        for (int a = 0; a < 2; ++a)
#pragma unroll
            for (int b = 0; b < 2; ++b)
#pragma unroll
                for (int m = 0; m < 4; ++m)
#pragma unroll
                    for (int n = 0; n < 2; ++n) acc[a][b][m][n] = (f32x4){0.f, 0.f, 0.f, 0.f};
        cur = nxt; cA = nA; cB = nB; ++ui;
        if constexpr (ALIGN_EPI) { if (wr == 1) PG8_BAR; }
    }
    PG8_WAIT_V(0);
    if constexpr (!ALIGN_EPI) { if (wr == 0) PG8_BAR; }
    PG8_BAR;
    if constexpr (Epi::AFTER_DRAIN) { E.fused(acc, cur, wr, wc, fr, fq, lds, wid, lane); S.done(cur); }
#undef PG8_SA
#undef PG8_SB
#undef PG8_STAGE
#undef PG8_LDA
#undef PG8_LDB
#undef PG8_MMA
#undef PG8_WAIT_V
#undef PG8_WAIT_L
#undef PG8_BAR
#undef PG8_SCHED
}
struct Unit2 { int pm, pn, l, cnt, split; unsigned hb; };
template <class Epi, class Sched, bool ALIGN_EPI>
__device__ __forceinline__ void gemm_phase2(PG8_LAS unsigned char* lds, const int K, const Sched& S, const Epi& E, PG8_LAS unsigned char* aux  ) {
    int tid_ = threadIdx.x; asm volatile("" : "+v"(tid_));
    const int tid = tid_, wid = __builtin_amdgcn_readfirstlane(tid >> 6), lane = tid & 63, wr = wid >> 2, wc = wid & 3, fr = lane & 15, fq = lane >> 4;
    const int nt = K / BK;
    int Rr[2], Cc[2]; unsigned voffB[2];
#pragma unroll
    for (int i = 0; i < 2; ++i) { int R, C; stage_rc(tid * 16 + i * 8192, R, C); const int Rb = Epi::PERM ? ((R & ~31) + perm32(R & 31)) : R; Rr[i] = R; Cc[i] = C; voffB[i] = (unsigned)(Rb * K + C) * 2u; }
    const size_t kstep = (size_t)(BK * 2);
    const size_t hstep = (size_t)HALF * K * 2;
    const unsigned ldsw = (unsigned)wid * 1024u;
    const int aoff = lds_byte(wr * 64 + fr, fq * 8), boff = lds_byte(wc * 32 + fr, fq * 8);
#define PG8_SA(b, h) (((b) * 2 + (h)) * HTB)
#define PG8_SB(b, h) ((4 + (b) * 2 + (h)) * HTB)
#define PG8_STAGE(bufoff, gbase, voff) do { _Pragma("unroll") for (int _i = 0; _i < 2; ++_i) \
        __builtin_amdgcn_global_load_lds((const unsigned*)((const char*)(gbase) + (voff)[_i]), (PG8_LAS unsigned*)(lds + (bufoff) + ldsw + _i * 8192), 16, 0, 0); } while (0)
#define PG8_STAGEA(bufoff, o0, o1, kb) do { \
        __builtin_amdgcn_global_load_lds((const unsigned*)(Abase + (size_t)(o0) + (kb)), (PG8_LAS unsigned*)(lds + (bufoff) + ldsw), 16, 0, 0); \
        __builtin_amdgcn_global_load_lds((const unsigned*)(Abase + (size_t)(o1) + (kb)), (PG8_LAS unsigned*)(lds + (bufoff) + ldsw + 8192), 16, 0, 0); } while (0)
#define PG8_LDA(dst, b, h) do { _Pragma("unroll") for (int m = 0; m < 4; ++m) _Pragma("unroll") for (int k = 0; k < 2; ++k) dst[m][k] = *(const PG8_LAS bf16x8*)(lds + PG8_SA(b, h) + aoff + m * 2048 + k * 1024); } while (0)
#define PG8_LDB(dst, b, h) do { _Pragma("unroll") for (int n = 0; n < 2; ++n) _Pragma("unroll") for (int k = 0; k < 2; ++k) dst[n][k] = *(const PG8_LAS bf16x8*)(lds + PG8_SB(b, h) + boff + n * 2048 + k * 1024); } while (0)
#define PG8_MMA(ai, bj, At, Bt) do { __builtin_amdgcn_s_setprio(1); _Pragma("unroll") for (int m = 0; m < 4; ++m) _Pragma("unroll") for (int n = 0; n < 2; ++n) _Pragma("unroll") for (int k = 0; k < 2; ++k) \
        acc[ai][bj][m][n] = __builtin_amdgcn_mfma_f32_16x16x32_bf16(Bt[n][k], At[m][k], acc[ai][bj][m][n], 0, 0, 0); __builtin_amdgcn_s_setprio(0); } while (0)
#define PG8_WAIT_V(n) asm volatile("s_waitcnt vmcnt(" #n ")" ::: "memory")
#define PG8_WAIT_L(n) asm volatile("s_waitcnt lgkmcnt(" #n ")" ::: "memory")
#define PG8_BAR __builtin_amdgcn_s_barrier()
#define PG8_SCHED __builtin_amdgcn_sched_barrier(0)
    Unit2 cur, nxt; int ui = 0;
    if (!S.next(0, cur)) return;
    f32x4 acc[2][2][4][2];
#pragma unroll
    for (int a = 0; a < 2; ++a)
#pragma unroll
        for (int b = 0; b < 2; ++b)
#pragma unroll
            for (int m = 0; m < 4; ++m)
#pragma unroll
                for (int n = 0; n < 2; ++n) acc[a][b][m][n] = (f32x4){0.f, 0.f, 0.f, 0.f};
    bf16x8 At[4][2], B0[2][2], B1[2][2];
    const char* Abase = (const char*)S.abase();
    unsigned cAo[4], nAo[4];
    S.aoffs(cur, Rr, Cc, cAo);
    const char* cB = (const char*)S.bptr(cur);
    typename Epi::Pre pre = E.pre(cur, wr, lane);
    PG8_STAGE(PG8_SB(0, 0), cB, voffB); PG8_STAGE(PG8_SB(0, 1), cB + hstep, voffB); PG8_STAGEA(PG8_SA(0, 0), cAo[0], cAo[1], 0); PG8_STAGEA(PG8_SA(0, 1), cAo[2], cAo[3], 0);
    if (wr == 1) PG8_BAR;
    PG8_WAIT_V(2); PG8_BAR;
    PG8_STAGE(PG8_SB(1, 0), cB + kstep, voffB); PG8_STAGEA(PG8_SA(1, 0), cAo[0], cAo[1], kstep); PG8_STAGE(PG8_SB(1, 1), cB + hstep + kstep, voffB);
    PG8_WAIT_V(6); PG8_BAR;
    for (;;) {
        const bool has_next = S.next(ui + 1, nxt);
        if (has_next) S.aoffs(nxt, Rr, Cc, nAo); else { nAo[0] = cAo[0]; nAo[1] = cAo[1]; nAo[2] = cAo[2]; nAo[3] = cAo[3]; }
        const char* nB = has_next ? (const char*)S.bptr(nxt) : cB;
        for (int t = 0; t < nt; t += 2) {
            const bool last = (t == nt - 2);
            const size_t k1 = (size_t)(t + 1) * kstep;
            const size_t k2 = last ? 0 : (size_t)(t + 2) * kstep, k3 = k2 + kstep;
            const char* b2 = last ? nB : cB + (size_t)(t + 2) * kstep; const char* b3 = b2 + kstep;
            const unsigned a20 = last ? nAo[0] : cAo[0], a21 = last ? nAo[1] : cAo[1], a22 = last ? nAo[2] : cAo[2], a23 = last ? nAo[3] : cAo[3];
            PG8_LDB(B0, 0, 0); PG8_LDB(B1, 0, 1); PG8_SCHED; PG8_LDA(At, 0, 0); PG8_STAGEA(PG8_SA(1, 1), cAo[2], cAo[3], k1);
            PG8_WAIT_V(8); PG8_WAIT_L(0); PG8_BAR; PG8_MMA(0, 0, At, B0); PG8_MMA(0, 1, At, B1); PG8_BAR; PG8_SCHED;
            PG8_LDA(At, 0, 1); PG8_STAGE(PG8_SB(0, 0), b2, voffB); PG8_STAGE(PG8_SB(0, 1), b2 + hstep, voffB); PG8_STAGEA(PG8_SA(0, 0), a20, a21, k2);
            PG8_WAIT_V(8); PG8_WAIT_L(0); PG8_BAR; PG8_MMA(1, 0, At, B0); PG8_MMA(1, 1, At, B1); PG8_BAR; PG8_SCHED;
            PG8_LDB(B0, 1, 0); PG8_LDB(B1, 1, 1); PG8_SCHED; PG8_LDA(At, 1, 0); PG8_STAGEA(PG8_SA(0, 1), a22, a23, k2);
            PG8_WAIT_V(8); PG8_WAIT_L(0); PG8_BAR; PG8_MMA(0, 0, At, B0); PG8_MMA(0, 1, At, B1); PG8_BAR; PG8_SCHED;
            PG8_LDA(At, 1, 1); PG8_STAGE(PG8_SB(1, 0), b3, voffB); PG8_STAGE(PG8_SB(1, 1), b3 + hstep, voffB); PG8_STAGEA(PG8_SA(1, 0), a20, a21, k3);
            PG8_WAIT_V(8); PG8_WAIT_L(0); PG8_BAR; PG8_MMA(1, 0, At, B0); PG8_MMA(1, 1, At, B1); PG8_BAR; PG8_SCHED;
        }
        if constexpr (ALIGN_EPI) { if (wr == 0) PG8_BAR; }
        E(acc, cur, wr, wc, fr, fq, pre, aux + wid * 1024, lane);
        if (!has_next) break;
#pragma unroll
        for (int a = 0; a < 2; ++a)
#pragma unroll
            for (int b = 0; b < 2; ++b)
#pragma unroll
                for (int m = 0; m < 4; ++m)
#pragma unroll
                    for (int n = 0; n < 2; ++n) acc[a][b][m][n] = (f32x4){0.f, 0.f, 0.f, 0.f};
        cur = nxt; pre = E.pre(cur, wr, lane); cB = nB; cAo[0] = nAo[0]; cAo[1] = nAo[1]; cAo[2] = nAo[2]; cAo[3] = nAo[3]; ++ui;
        if constexpr (ALIGN_EPI) { if (wr == 1) PG8_BAR; }
    }
    PG8_WAIT_V(0);
    if constexpr (!ALIGN_EPI) { if (wr == 0) PG8_BAR; }
    PG8_BAR;
#undef PG8_SA
#undef PG8_SB
#undef PG8_STAGE
#undef PG8_STAGEA
#undef PG8_LDA
#undef PG8_LDB
#undef PG8_MMA
#undef PG8_WAIT_V
#undef PG8_WAIT_L
#undef PG8_BAR
#undef PG8_SCHED
}
struct MoeSched {
    const PG8_LAS unsigned* tb;
    const PG8_LAS unsigned* cntL;
    const PG8_LAS unsigned* hbL;
    int nl, lmul, ladd;
    int nN, G, c, K;
    const void* Abase_; const bf16_t* Bbase; size_t bstride;
    int merged;
    const unsigned* LIST; int mode;
    PG8_LAS int* ut;
    __device__ __forceinline__ void build_table() const {
        if (threadIdx.x < 32) { Unit2 u; const bool ok = search((int)threadIdx.x, u); PG8_LAS int* p = ut + 8 * threadIdx.x;
            p[0] = ok ? 1 : 0; p[1] = u.pm; p[2] = u.pn; p[3] = u.l; p[4] = u.cnt; p[5] = u.split; p[6] = (int)u.hb; }
    }
    __device__ __forceinline__ bool next(int i, Unit2& u) const {
        if (i < 32) { const PG8_LAS int* p = ut + 8 * i; if (p[0] == 0) return false; u.pm = p[1]; u.pn = p[2]; u.l = p[3]; u.cnt = p[4]; u.split = p[5]; u.hb = (unsigned)p[6]; return true; }
        return search(i, u);
    }
    __device__ __forceinline__ bool search(int i, Unit2& u) const {
        u.pm = 0; u.pn = 0; u.l = 0; u.cnt = 0; u.split = 0; u.hb = 0u;
        const unsigned total = tb[nl] * (unsigned)nN; const unsigned Lx = (unsigned)i * (unsigned)G + (unsigned)c; if (Lx >= total) return false;
        const unsigned rt = Lx / (unsigned)nN; u.pn = (int)(Lx % (unsigned)nN);
        int lo = 0, hi = nl;
        while (hi - lo > 1) { const int mid = (lo + hi) >> 1; if (tb[mid] <= rt) lo = mid; else hi = mid; }
        u.pm = (int)(rt - tb[lo]);
        if (merged) { if (lo < 64) { u.l = 2 * lo; const int c0 = (int)cntL[2 * lo]; u.split = c0; u.cnt = c0 + (int)cntL[2 * lo + 1]; u.hb = hbL[2 * lo]; } else { u.l = 128; u.cnt = (int)cntL[128]; u.split = u.cnt; u.hb = 0u; } }
        else { u.l = lo * lmul + ladd; u.cnt = (int)cntL[u.l]; u.split = u.cnt; u.hb = hbL[u.l]; }
        return true;
    }
    __device__ __forceinline__ const void* abase() const { return Abase_; }
    __device__ __forceinline__ const bf16_t* bptr(const Unit2& u) const { const int e = (u.l < 128) ? (u.l >> 1) : 64; return Bbase + (size_t)e * bstride + (size_t)u.pn * 256 * K; }
    __device__ __forceinline__ void aoffs(const Unit2& u, const int (&Rr)[2], const int (&Cc)[2], unsigned (&o)[4]) const {
#pragma unroll
        for (int h = 0; h < 2; ++h)
#pragma unroll
            for (int i = 0; i < 2; ++i) {
                const int p = u.pm * 256 + h * 128 + Rr[i]; unsigned row;
                if (mode == 0) { if (u.l == 128) row = (unsigned)p; else { const int pp = p < u.cnt ? p : 0; row = LIST[pp < u.split ? (size_t)u.l * 16384 + pp : (size_t)(u.l + 1) * 16384 + (pp - u.split)] >> 3; } }
                else row = u.hb + (unsigned)p;
                o[h * 2 + i] = row * (unsigned)(K * 2) + (unsigned)(Cc[i] * 2);
            }
    }
};
typedef float f32x2m __attribute__((ext_vector_type(2)));
struct EpiMoe1 {
    static constexpr bool PERM = true, AFTER_DRAIN = false;
    const f32x2m* META; const float* RINV; bf16_t* H; bf16_t* HS;
    struct Pre { f32x2m r0, r1; };
    __device__ __forceinline__ Pre pre(const Unit2& u, int wr, int lane) const {
        Pre p; const int p0 = u.pm * 256 + wr * 64 + lane, p1 = p0 + HALF;
        if (u.l == 128) { p.r0 = (f32x2m){RINV[p0], 1.f}; p.r1 = (f32x2m){RINV[p1], 1.f}; }
        else { const int q0 = p0 < u.cnt ? p0 : 0, q1 = p1 < u.cnt ? p1 : 0;
            p.r0 = META[q0 < u.split ? (size_t)u.l * 16384 + q0 : (size_t)(u.l + 1) * 16384 + (q0 - u.split)]; p.r1 = META[q1 < u.split ? (size_t)u.l * 16384 + q1 : (size_t)(u.l + 1) * 16384 + (q1 - u.split)]; }
        return p;
    }
    __device__ __forceinline__ void operator()(const f32x4 (&acc)[2][2][4][2], const Unit2& u, int wr, int wc, int fr, int fq, const Pre& pr, PG8_LAS unsigned char* aux, int lane) const {
        PG8_LAS f32x2m* slot = (PG8_LAS f32x2m*)aux;
        slot[lane] = pr.r0; slot[64 + lane] = pr.r1;
        asm volatile("s_waitcnt lgkmcnt(0)" ::: "memory");
        const int col = u.pn * 128 + wc * 32 + 8 * fq;
#pragma unroll
        for (int ai = 0; ai < 2; ++ai)
#pragma unroll
            for (int m = 0; m < 4; ++m) {
                const int p = u.pm * 256 + ai * HALF + wr * 64 + m * 16 + fr;
                if (p < u.cnt) {
                    const f32x2m mr = slot[ai * 64 + m * 16 + fr]; const float ri = mr.x, gw = mr.y;
                    bf16_t* dst = (u.l == 128) ? HS + (size_t)p * 256 + col : H + ((size_t)u.hb + p) * 256 + col;
                    float hv[8];
#pragma unroll
                    for (int n = 0; n < 2; ++n)
#pragma unroll
                        for (int i = 0; i < 4; ++i) { const float g = acc[ai][0][m][n][i] * ri, uu = acc[ai][1][m][n][i] * ri;
                            hv[n * 4 + i] = g * __builtin_amdgcn_rcpf(1.f + __builtin_amdgcn_exp2f(-1.4426950408889634f * g)) * uu * gw; }
                    u32x4 w; w.x = cvtc(hv[0], hv[1]); w.y = cvtc(hv[2], hv[3]); w.z = cvtc(hv[4], hv[5]); w.w = cvtc(hv[6], hv[7]);
                    *(u32x4*)dst = w;
                }
                asm volatile("" ::: "memory");
            }
        asm volatile("s_waitcnt lgkmcnt(0)" ::: "memory");
    }
};
struct EpiMoe2 {
    static constexpr bool PERM = true, AFTER_DRAIN = false;
    unsigned char* Y8;
    struct Pre { int dummy; };
    __device__ __forceinline__ Pre pre(const Unit2&, int, int) const { return Pre{0}; }
    __device__ __forceinline__ void operator()(const f32x4 (&acc)[2][2][4][2], const Unit2& u, int wr, int wc, int fr, int fq, const Pre&, PG8_LAS unsigned char*, int) const {
        const unsigned cofs = (unsigned)(u.pn * 256 + (wc * 4 + fq) * 16);
#pragma unroll
        for (int ai = 0; ai < 2; ++ai)
#pragma unroll
            for (int m = 0; m < 4; ++m) {
                const int p = u.pm * 256 + ai * HALF + wr * 64 + m * 16 + fr;
                if (p < u.cnt) {
                    int w[4];
#pragma unroll
                    for (int bj = 0; bj < 2; ++bj) { f32x4 a0 = acc[ai][bj][m][0] * 16.f, a1 = acc[ai][bj][m][1] * 16.f;
#pragma unroll
                        for (int i = 0; i < 4; ++i) { a0[i] = __builtin_amdgcn_fmed3f(a0[i], -440.f, 440.f); a1[i] = __builtin_amdgcn_fmed3f(a1[i], -440.f, 440.f); }
                        int w0 = __builtin_amdgcn_cvt_pk_fp8_f32(a0[0], a0[1], 0, false); w0 = __builtin_amdgcn_cvt_pk_fp8_f32(a0[2], a0[3], w0, true);
                        int w1 = __builtin_amdgcn_cvt_pk_fp8_f32(a1[0], a1[1], 0, false); w1 = __builtin_amdgcn_cvt_pk_fp8_f32(a1[2], a1[3], w1, true);
                        w[2 * bj] = w0; w[2 * bj + 1] = w1; }
                    *(u32x4*)(Y8 + ((u.hb + (unsigned)p) * 1024u + cofs)) = (u32x4){(unsigned)w[0], (unsigned)w[1], (unsigned)w[2], (unsigned)w[3]};
                }
            }
    }
};
struct EpiFinal {
    static constexpr bool PERM = true, AFTER_DRAIN = false;
    const unsigned char* Y8; const unsigned* INV; const PG8_LAS unsigned* hbL; const float* Oin; float* O;
    struct Pre { int dummy; };
    __device__ __forceinline__ Pre pre(const Unit2&, int, int) const { return Pre{0}; }
    __device__ __forceinline__ void operator()(const f32x4 (&acc)[2][2][4][2], const Unit2& u, int wr, int wc, int fr, int fq, const Pre&, PG8_LAS unsigned char*, int) const {
        typedef float f32x2v __attribute__((ext_vector_type(2)));
        const unsigned col = (unsigned)(u.pn * 256 + wc * 64 + 8 * fq), cofs = (unsigned)(u.pn * 256 + (wc * 4 + fq) * 16);
#pragma unroll
        for (int ai = 0; ai < 2; ++ai)
#pragma unroll
            for (int m = 0; m < 4; ++m) {
                const unsigned row = (unsigned)(u.pm * 256 + ai * HALF + wr * 64 + m * 16 + fr);
                const u32x4 iv0 = *(const u32x4*)(INV + row * 8u), iv1 = *(const u32x4*)(INV + row * 8u + 4u);
                const unsigned iv[8] = {iv0.x, iv0.y, iv0.z, iv0.w, iv1.x, iv1.y, iv1.z, iv1.w};
                unsigned yo[8];
#pragma unroll
                for (int j = 0; j < 8; ++j) yo[j] = (hbL[iv[j] >> 16] + (iv[j] & 0xffffu)) * 1024u + cofs;
#pragma unroll
                for (int bj = 0; bj < 2; ++bj) {
                    typedef unsigned u32x2g __attribute__((ext_vector_type(2)));
                    u32x2g t[8];
#pragma unroll
                    for (int j = 0; j < 8; ++j) t[j] = *(const u32x2g*)(Y8 + (yo[j] + bj * 8u));
                    const f32x4 x0 = *(const f32x4*)(Oin + (row * 1024u + col + bj * 32)), x1 = *(const f32x4*)(Oin + (row * 1024u + col + bj * 32 + 4));
                    f32x4 s0 = (f32x4){0.f, 0.f, 0.f, 0.f}, s1 = (f32x4){0.f, 0.f, 0.f, 0.f};
#pragma unroll
                    for (int j = 0; j < 8; ++j) { const f32x2v p0 = __builtin_amdgcn_cvt_pk_f32_fp8((int)t[j].x, false), p1 = __builtin_amdgcn_cvt_pk_f32_fp8((int)t[j].x, true),
                                                               p2 = __builtin_amdgcn_cvt_pk_f32_fp8((int)t[j].y, false), p3 = __builtin_amdgcn_cvt_pk_f32_fp8((int)t[j].y, true);
                        s0[0] += p0.x; s0[1] += p0.y; s0[2] += p1.x; s0[3] += p1.y; s1[0] += p2.x; s1[1] += p2.y; s1[2] += p3.x; s1[3] += p3.y; }
                    float* op = O + (row * 1024u + col + bj * 32);
                    *(f32x4*)op = x0 + acc[ai][bj][m][0] + s0 * 0.0625f; *(f32x4*)(op + 4) = x1 + acc[ai][bj][m][1] + s1 * 0.0625f;
                    asm volatile("" ::: "memory");
                }
                asm volatile("" ::: "memory");
            }
    }
};
struct EpiFinalD {
    static constexpr bool PERM = true, AFTER_DRAIN = true;
    const unsigned char* Y8; const unsigned* INV; const PG8_LAS unsigned* hbL; const float* Oin; float* O;
    __device__ __forceinline__ void fused(const f32x4 (&acc)[2][2][4][2], const Unit& u, int wr, int wc, int fr, int fq, PG8_LAS unsigned char*, int, int) const {
        typedef float f32x2v __attribute__((ext_vector_type(2)));
        const unsigned col = (unsigned)(u.pn * 256 + wc * 64 + 8 * fq), cofs = (unsigned)(u.pn * 256 + (wc * 4 + fq) * 16);
#pragma unroll
        for (int ai = 0; ai < 2; ++ai)
#pragma unroll
            for (int m = 0; m < 4; ++m) {
                const unsigned row = (unsigned)(u.pm * 256 + ai * HALF + wr * 64 + m * 16 + fr);
                const u32x4 iv0 = *(const u32x4*)(INV + row * 8u), iv1 = *(const u32x4*)(INV + row * 8u + 4u);
                const unsigned iv[8] = {iv0.x, iv0.y, iv0.z, iv0.w, iv1.x, iv1.y, iv1.z, iv1.w};
                f32x4 xr[2][2];
#pragma unroll
                for (int bj = 0; bj < 2; ++bj) { xr[bj][0] = *(const f32x4*)(Oin + (row * 1024u + col + bj * 32)); xr[bj][1] = *(const f32x4*)(Oin + (row * 1024u + col + bj * 32 + 4)); }
                f32x4 s[2][2];
#pragma unroll
                for (int bj = 0; bj < 2; ++bj) { s[bj][0] = (f32x4){0.f, 0.f, 0.f, 0.f}; s[bj][1] = (f32x4){0.f, 0.f, 0.f, 0.f}; }
#pragma unroll
                for (int jh = 0; jh < 2; ++jh) {
                    u32x4 t[4];
#pragma unroll
                    for (int j = 0; j < 4; ++j) { const unsigned ivv = iv[jh * 4 + j]; t[j] = *(const u32x4*)(Y8 + ((hbL[ivv >> 16] + (ivv & 0xffffu)) * 1024u + cofs)); }
#pragma unroll
                    for (int j = 0; j < 4; ++j) { const unsigned tw[4] = {t[j].x, t[j].y, t[j].z, t[j].w};
#pragma unroll
                        for (int bj = 0; bj < 2; ++bj) { const f32x2v p0 = __builtin_amdgcn_cvt_pk_f32_fp8((int)tw[2 * bj], false), p1 = __builtin_amdgcn_cvt_pk_f32_fp8((int)tw[2 * bj], true),
                                                                     p2 = __builtin_amdgcn_cvt_pk_f32_fp8((int)tw[2 * bj + 1], false), p3 = __builtin_amdgcn_cvt_pk_f32_fp8((int)tw[2 * bj + 1], true);
                            s[bj][0][0] += p0.x; s[bj][0][1] += p0.y; s[bj][0][2] += p1.x; s[bj][0][3] += p1.y; s[bj][1][0] += p2.x; s[bj][1][1] += p2.y; s[bj][1][2] += p3.x; s[bj][1][3] += p3.y; } }
                    asm volatile("" ::: "memory");
                }
#pragma unroll
                for (int bj = 0; bj < 2; ++bj) { float* op = O + (row * 1024u + col + bj * 32);
                    *(f32x4*)op = xr[bj][0] + acc[ai][bj][m][0] + s[bj][0] * 0.0625f; *(f32x4*)(op + 4) = xr[bj][1] + acc[ai][bj][m][1] + s[bj][1] * 0.0625f; }
                asm volatile("" ::: "memory");
            }
    }
};
}
#ifndef PG8_SP2
#define PG8_SP2 true
#endif
namespace fox {
using bf16=__hip_bfloat16;
using bf16x8=__attribute__((ext_vector_type(8)))short;
using s16x4=__attribute__((ext_vector_type(4)))short;
using f32x16=__attribute__((ext_vector_type(16)))float;
using u32x4=__attribute__((ext_vector_type(4)))unsigned;
constexpr int BATCH=2,NHEAD=8,SEQ=8192,D=64,DM=NHEAD*D;
constexpr int NW=8,QBLK=32,QB=QBLK*NW,KVBLK=64,NQB=SEQ/QB;
constexpr int ATTN_PITCH=DM, ATTN_UNIT_ROWS=QB;
__device__ __forceinline__ int crow(int r,int hi){return (r&3)+8*(r>>2)+4*hi;}
#define SBAR() __builtin_amdgcn_sched_barrier(0)
__device__ __forceinline__ void cmask(f32x16&p0,f32x16&p1,int jb,int qrel,int hi){
  const float NEG=-INFINITY; int kb=64*jb+4*hi;
  #pragma unroll
  for(int r=0;r<16;++r){int kv=kb+(r&3)+8*(r>>2); if(kv>qrel)p0[r]=NEG; if(kv+32>qrel)p1[r]=NEG;}
}

constexpr int NSLOT=3, SLOTB=9216, KAOFF=8192;
constexpr int LDS_K=0, LDS_V=NSLOT*SLOTB, LDS_WS=2*NSLOT*SLOTB, LDS_OST=LDS_WS+NW*64*4, LDS_BYTES=LDS_OST+NW*4096;
constexpr float C2=0.125f*1.4426950408889634f;
__device__ __forceinline__ void glds16(const void*gsrc,unsigned lds_dst){unsigned keep;
  asm volatile("s_mov_b32 %0, m0\n\ts_mov_b32 m0, %2\n\ts_nop 0\n\tglobal_load_lds_dwordx4 %1, off\n\ts_mov_b32 m0, %0":"=&s"(keep):"v"(gsrc),"s"(lds_dst):"memory");}
__device__ __forceinline__ float max3f(float a,float b,float c){float r;asm("v_max3_f32 %0, %1, %2, %3":"=v"(r):"v"(a),"v"(b),"v"(c));return r;}
__device__ __forceinline__ float max2f(float a,float b){float r;asm("v_max_f32_e32 %0, %1, %2":"=v"(r):"v"(a),"v"(b));return r;}
__device__ __forceinline__ float fadd_s(float a,float b){float r;asm("v_add_f32_e32 %0, %1, %2":"=v"(r):"v"(a),"v"(b));return r;}
__device__ __forceinline__ float fsub_s(float a,float b){float r;asm("v_sub_f32_e32 %0, %1, %2":"=v"(r):"v"(a),"v"(b));return r;}
typedef float f32x2_t __attribute__((ext_vector_type(2))); typedef __bf16 bf16x2_t __attribute__((ext_vector_type(2)));
__device__ __forceinline__ unsigned cvtpk_s(float lo,float hi){f32x2_t v={lo,hi};bf16x2_t b=__builtin_convertvector(v,bf16x2_t);return __builtin_bit_cast(unsigned,b);}
#define WAIT_BAR(N) asm volatile("s_waitcnt vmcnt(" #N ") lgkmcnt(0)\n\ts_barrier":::"memory")

__device__ __forceinline__ void qkt(f32x16&p0,f32x16&p1,const char*Kslot,const bf16x8*qr,const bf16x8 qa,int r32,int hi){
  const f32x16 z16=f32x16{};
  const char*kb=Kslot+hi*1024+r32*16;
  #pragma unroll
  for(int d0=0;d0<4;++d0){
    const bf16x8 b0=*reinterpret_cast<const bf16x8*>(kb+d0*2048);
    const bf16x8 b1=*reinterpret_cast<const bf16x8*>(kb+d0*2048+512);
    if(d0==0){p0=__builtin_amdgcn_mfma_f32_32x32x16_bf16(b0,qr[0],z16,0,0,0);p1=__builtin_amdgcn_mfma_f32_32x32x16_bf16(b1,qr[0],z16,0,0,0);}
    else{p0=__builtin_amdgcn_mfma_f32_32x32x16_bf16(b0,qr[d0],p0,0,0,0);p1=__builtin_amdgcn_mfma_f32_32x32x16_bf16(b1,qr[d0],p1,0,0,0);}}
  { const bf16x8 a0=*reinterpret_cast<const bf16x8*>(Kslot+KAOFF+r32*16); const bf16x8 a1=*reinterpret_cast<const bf16x8*>(Kslot+KAOFF+r32*16+512);
    p0=__builtin_amdgcn_mfma_f32_32x32x16_bf16(a0,qa,p0,0,0,0);p1=__builtin_amdgcn_mfma_f32_32x32x16_bf16(a1,qa,p1,0,0,0); }
}
typedef __attribute__((address_space(3))) const char* lds_cptr;
typedef short v4i16_t __attribute__((ext_vector_type(4)));
__device__ __forceinline__ void kload8(bf16x8*kf,lds_cptr kp){
  kf[0]=*(const __attribute__((address_space(3))) bf16x8*)(kp);      kf[1]=*(const __attribute__((address_space(3))) bf16x8*)(kp+512);
  kf[2]=*(const __attribute__((address_space(3))) bf16x8*)(kp+2048); kf[3]=*(const __attribute__((address_space(3))) bf16x8*)(kp+2560);
  kf[4]=*(const __attribute__((address_space(3))) bf16x8*)(kp+4096); kf[5]=*(const __attribute__((address_space(3))) bf16x8*)(kp+4608);
  kf[6]=*(const __attribute__((address_space(3))) bf16x8*)(kp+6144); kf[7]=*(const __attribute__((address_space(3))) bf16x8*)(kp+6656);
}
__device__ __forceinline__ void kload2(bf16x8*kf,lds_cptr kp,int j){ kf[2*j]=*(const __attribute__((address_space(3))) bf16x8*)(kp+j*2048); kf[2*j+1]=*(const __attribute__((address_space(3))) bf16x8*)(kp+j*2048+512); }
__device__ __forceinline__ s16x4 vtr(lds_cptr p){ return __builtin_bit_cast(s16x4,__builtin_amdgcn_ds_read_tr16_b64_v4i16((__attribute__((address_space(3))) v4i16_t*)p)); }
__device__ __forceinline__ float rowmax(const f32x16&p0,const f32x16&p1){
  float a=max3f(p0[0],p0[1],p1[0]),b=max3f(p0[2],p0[3],p1[1]);a=max3f(a,p1[2],p1[3]);
  #pragma unroll
  for(int r=4;r<16;r+=4){a=max3f(a,p0[r],p0[r+1]);b=max3f(b,p0[r+2],p0[r+3]);a=max3f(a,p1[r],p1[r+1]);b=max3f(b,p1[r+2],p1[r+3]);}
  const float m=max2f(a,b);
  auto rr=__builtin_amdgcn_permlane32_swap(__float_as_uint(m),__float_as_uint(m),false,false);
  return max2f(__uint_as_float(rr[0]),__uint_as_float(rr[1]));
}
__device__ __forceinline__ void pv(f32x16*o,int vb,bf16x8 pa0,bf16x8 pa1,bf16x8 pa2,bf16x8 pa3){
  #pragma unroll
  for(int d0=0;d0<2;++d0){s16x4 lo[4],hi[4];
    #pragma unroll
    for(int ks=0;ks<4;++ks){
      asm volatile("ds_read_b64_tr_b16 %0,%1 offset:%c2":"=&v"(lo[ks]):"v"(vb),"i"(d0*4096+ks*1024):"memory");
      asm volatile("ds_read_b64_tr_b16 %0,%1 offset:%c2":"=&v"(hi[ks]):"v"(vb),"i"(d0*4096+ks*1024+512):"memory");}
    asm volatile("s_waitcnt lgkmcnt(0)":::"memory");SBAR();
    #define PK(k) (bf16x8){lo[k][0],lo[k][1],lo[k][2],lo[k][3],hi[k][0],hi[k][1],hi[k][2],hi[k][3]}
    o[d0]=__builtin_amdgcn_mfma_f32_32x32x16_bf16(pa0,PK(0),o[d0],0,0,0);
    o[d0]=__builtin_amdgcn_mfma_f32_32x32x16_bf16(pa1,PK(1),o[d0],0,0,0);
    o[d0]=__builtin_amdgcn_mfma_f32_32x32x16_bf16(pa2,PK(2),o[d0],0,0,0);
    o[d0]=__builtin_amdgcn_mfma_f32_32x32x16_bf16(pa3,PK(3),o[d0],0,0,0);
    #undef PK
  }
}

#ifndef ATTN_STORE16
#define ATTN_STORE16(p,v) (*(u32x4*)(p)=(v))
#endif
template<int THRL> __device__ __forceinline__ void attn_unit(int b,int h,int qb,int T0,const bf16*Q,const bf16*__restrict__ K,const bf16*__restrict__ V,const bf16*__restrict__ KA,const float*__restrict__ Cbh,bf16*O,char*shm){
  int tid_=threadIdx.x; asm volatile("":"+v"(tid_));
  const int tid=tid_,lane=tid&63,r32=lane&31,hi=lane>>5; const int wid=__builtin_amdgcn_readfirstlane(tid>>6);
  const long rowbase=(long)b*SEQ; const int q0=qb*QB;
  const bf16*Qw=Q+(rowbase+q0+wid*QBLK)*DM+h*D;
  const bf16*Kh=K+(rowbase+(long)T0*KVBLK)*DM+h*D,*Vh=V+(rowbase+(long)T0*KVBLK)*DM+h*D;
  const bf16*kasrc=KA+((rowbase+(long)T0*KVBLK+lane)*NHEAD+h)*8;
  const unsigned lds0=(unsigned)(uintptr_t)shm;
  float*wsf=(float*)(shm+LDS_WS)+wid*64;
  const bf16*ksrc=Kh+(long)lane*DM+wid*8;
  const bf16*vsrc=Vh+(long)(16*(wid&3)+(lane>>2))*DM+(wid>>2)*32+(lane&3)*8;
  const unsigned kdst=lds0+LDS_K+wid*1024, vdst=lds0+LDS_V+wid*1024;
  #define DMA_K(t,slot) glds16(ksrc+(long)(t)*KVBLK*DM,(unsigned)__builtin_amdgcn_readfirstlane(kdst+(slot)))
  #define DMA_V(t,slot) glds16(vsrc+(long)(t)*KVBLK*DM,(unsigned)__builtin_amdgcn_readfirstlane(vdst+(slot)))
  #define DMA_KA(t,slot) do{ if(wid==0) glds16(kasrc+(long)(t)*KVBLK*NHEAD*8,(unsigned)__builtin_amdgcn_readfirstlane(lds0+LDS_K+KAOFF+(slot))); }while(0)
  const int vb0=(int)(lds0+LDS_V)+((lane>>4)&1)*32+(lane&3)*8+(4*hi+((lane&15)>>2))*64;
  const char*Kbase=shm+LDS_K; bf16x8 kf[8],kfa[2];
  const lds_cptr shm3=(lds_cptr)shm; const lds_cptr kpa=shm3+LDS_K+KAOFF+r32*16; const lds_cptr kp0=shm3+LDS_K+hi*1024+r32*16;
  #define KALOAD(sl) do{ kfa[0]=*(const __attribute__((address_space(3))) bf16x8*)(kpa+(sl)); kfa[1]=*(const __attribute__((address_space(3))) bf16x8*)(kpa+(sl)+512); }while(0)
  const lds_cptr vp0=shm3+LDS_V+((lane>>4)&1)*32+(lane&3)*8+(4*hi+((lane&15)>>2))*64;
  const int NT=(q0+QB)/KVBLK-T0;
  DMA_KA(0,0);DMA_KA(1,SLOTB);DMA_KA(2,2*SLOTB);
  DMA_K(0,0);DMA_V(0,0);DMA_K(1,SLOTB);
  bf16x8 qr[4];
  #pragma unroll
  for(int d0=0;d0<4;++d0)qr[d0]=*reinterpret_cast<const bf16x8*>(&Qw[(long)r32*DM+d0*16+hi*8]);
  const float ct2=Cbh[q0+wid*QBLK+r32]*1.4426950408889634f;
  float mhat=0.f,l_reg=0.f;f32x16 o[2];o[0]=f32x16{};o[1]=f32x16{};u32x4 qaw;
  #define QA_REBUILD() do{ const float a_=ct2-mhat; const unsigned p0_=cvtpk_s(a_,0.f)&0xffffu; const float r1_=a_-__uint_as_float(p0_<<16); const unsigned p1_=cvtpk_s(r1_,0.f)&0xffffu; \
      const float r2_=r1_-__uint_as_float(p1_<<16); const unsigned p2_=cvtpk_s(r2_,0.f)&0xffffu; \
      qaw=hi?(u32x4){0u,0u,0u,0u}:(u32x4){0x3F803F80u,0x3F80u|(p0_<<16),p1_|(p2_<<16),0u}; asm volatile("":"+v"(qaw)); }while(0)
  #define QAF __builtin_bit_cast(bf16x8,qaw)
  QA_REBUILD();
  const int qrel=wid*QBLK+r32;
  #define CMASK(P0,P1,t) do{int jb_=(t)-(NT-4); if(jb_>=0)cmask(P0,P1,jb_,qrel,hi);}while(0)
  bool resc=false;
  #define START(P0,P1) do{ const float rm=rowmax(P0,P1); resc=false; \
    { const float dl=rm; mhat=fadd_s(mhat,dl); \
      _Pragma("unroll") for(int r=0;r<16;++r){P0[r]=fsub_s(P0[r],dl);P1[r]=fsub_s(P1[r],dl);} \
      QA_REBUILD(); } \
    _Pragma("unroll") for(int r=0;r<16;++r)P0[r]=__builtin_amdgcn_exp2f(P0[r]); }while(0)
  #define RESC() do{ if(resc){ asm volatile("s_waitcnt lgkmcnt(0)":::"memory"); \
      _Pragma("unroll") for(int d_=0;d_<2;++d_) _Pragma("unroll") for(int r=0;r<16;++r)o[d_][r]*=wsf[crow(r,hi)]; } }while(0)
  f32x16 pA0,pA1,pB0,pB1;
  int sl_prev=0,sl_cur=0,sl_next=SLOTB;
  #define ROT() do{sl_prev=sl_cur;sl_cur=sl_next;sl_next=(sl_next==(NSLOT-1)*SLOTB)?0:sl_next+SLOTB;}while(0)
  DMA_K(2,2*SLOTB);
  WAIT_BAR(3);
  qkt(pA0,pA1,Kbase,qr,QAF,r32,hi);asm volatile("s_nop 15\n\ts_nop 7":"+v"(pA0),"+v"(pA1));CMASK(pA0,pA1,0);
  START(pA0,pA1);
  _Pragma("unroll") for(int r=0;r<16;++r)pA1[r]=__builtin_amdgcn_exp2f(pA1[r]);
  WAIT_BAR(0);
  DMA_KA(3,0);DMA_K(3,0);DMA_V(1,SLOTB);
  ROT();
  kload8(kf,kp0+sl_cur); KALOAD(sl_cur);
  WAIT_BAR(2);
  s16x4 vlo[8],vhi[8]; u32x4 pw0,pw1,pw2,pw3;
  #define PKW(P,B) cvtpk_s(P[B],P[B+1])
  #define PAF(k) __builtin_bit_cast(bf16x8,pw##k)
  #define VFR(i) (bf16x8){vlo[i][0],vlo[i][1],vlo[i][2],vlo[i][3],vhi[i][0],vhi[i][1],vhi[i][2],vhi[i][3]}
  #define PIN(x) asm volatile("":"+v"(x))
  #define MX3(a,b,c) __builtin_fmaxf(__builtin_fmaxf((a),(b)),(c))
  #define GAPA(MF,A0,A1,A2,A3,W0,W1,PW) do{ MF; sacc+=A0; sacc+=A1; sacc+=A2; sacc+=A3; PIN(sacc); W0; W1; PIN(PW); SBAR(); }while(0)
  #define EX(v) __builtin_amdgcn_exp2f(v)
  #define GAPB(MF,X,B) do{ MF; X[B]=EX(X[B]); X[B+1]=EX(X[B+1]); X[B+2]=EX(X[B+2]); X[B+3]=EX(X[B+3]); PIN(X); SBAR(); }while(0)
  #define VRD(i) do{ vlo[i]=vtr(vp_+(((i)>>2)*4096+((i)&3)*1024)); vhi[i]=vtr(vp_+(((i)>>2)*4096+((i)&3)*1024+512)); }while(0)
  #define KRD(G,j) do{ if(G){ kload2(kf,kp0+sl_next,j); SBAR(); } }while(0)
  const f32x16 z16=f32x16{};
  #define STEP(C0,C1,P0,P1,t,GK,GV,GL) do{ SBAR(); \
    const lds_cptr vp_=vp0+sl_prev; \
    VRD(0); SBAR(); float sacc=(P0[0]+P0[1]); \
    GAPA(C0=__builtin_amdgcn_mfma_f32_32x32x16_bf16(kf[0],qr[0],z16,0,0,0), P0[2],P0[3],P0[4],P0[5],     pw0[0]=PKW(P0,0), pw0[1]=PKW(P0,2), pw0); \
    VRD(4); SBAR(); GAPA(C1=__builtin_amdgcn_mfma_f32_32x32x16_bf16(kf[1],qr[0],z16,0,0,0), P0[6],P0[7],P0[8],P0[9],     pw0[2]=PKW(P0,4), pw0[3]=PKW(P0,6), pw0); \
    VRD(1); SBAR(); GAPA(C0=__builtin_amdgcn_mfma_f32_32x32x16_bf16(kf[2],qr[1],C0,0,0,0),   P0[10],P0[11],P0[12],P0[13], pw1[0]=PKW(P0,8), pw1[1]=PKW(P0,10), pw1); \
    VRD(5); SBAR(); GAPA(C1=__builtin_amdgcn_mfma_f32_32x32x16_bf16(kf[3],qr[1],C1,0,0,0),   P0[14],P0[15],P1[0],P1[1],   pw1[2]=PKW(P0,12),pw1[3]=PKW(P0,14), pw1); \
    VRD(2); SBAR(); GAPA(C0=__builtin_amdgcn_mfma_f32_32x32x16_bf16(kf[4],qr[2],C0,0,0,0),   P1[2],P1[3],P1[4],P1[5],     pw2[0]=PKW(P1,0), pw2[1]=PKW(P1,2), pw2); \
    VRD(6); SBAR(); GAPA(C1=__builtin_amdgcn_mfma_f32_32x32x16_bf16(kf[5],qr[2],C1,0,0,0),   P1[6],P1[7],P1[8],P1[9],     pw2[2]=PKW(P1,4), pw2[3]=PKW(P1,6), pw2); \
    VRD(3); SBAR(); GAPA(C0=__builtin_amdgcn_mfma_f32_32x32x16_bf16(kf[6],qr[3],C0,0,0,0),   P1[10],P1[11],P1[12],P1[13], pw3[0]=PKW(P1,8), pw3[1]=PKW(P1,10), pw3); \
    VRD(7); SBAR(); GAPA(C1=__builtin_amdgcn_mfma_f32_32x32x16_bf16(kf[7],qr[3],C1,0,0,0),   P1[14],P1[15],0.f,0.f,       pw3[2]=PKW(P1,12),pw3[3]=PKW(P1,14), pw3); \
    C0=__builtin_amdgcn_mfma_f32_32x32x16_bf16(kfa[0],QAF,C0,0,0,0); C1=__builtin_amdgcn_mfma_f32_32x32x16_bf16(kfa[1],QAF,C1,0,0,0); SBAR(); \
    l_reg+=sacc; \
    if(GK){DMA_KA((t)+3,sl_cur);DMA_K((t)+3,sl_cur);} if(GV){DMA_V((t)+1,sl_next);} \
    CMASK(C0,C1,t); \
    { float a=MX3(C0[0],C0[1],C1[0]),b=MX3(C0[2],C0[3],C1[1]); a=MX3(a,C1[2],C1[3]); \
      _Pragma("unroll") for(int r=4;r<16;r+=4){a=MX3(a,C0[r],C0[r+1]);b=MX3(b,C0[r+2],C0[r+3]);a=MX3(a,C1[r],C1[r+1]);b=MX3(b,C1[r+2],C1[r+3]);} \
      float rm=__builtin_fmaxf(a,b); { auto rr=__builtin_amdgcn_permlane32_swap(__float_as_uint(rm),__float_as_uint(rm),false,false); rm=__builtin_fmaxf(__uint_as_float(rr[0]),__uint_as_float(rr[1])); } \
      resc=false; \
      if(__builtin_expect(__any(rm>(float)THRL),0)){ const float dl=__builtin_fmaxf(rm,0.f); mhat+=dl; \
        _Pragma("unroll") for(int r=0;r<16;++r){C0[r]-=dl;C1[r]-=dl;} \
        QA_REBUILD(); \
        const float f=__builtin_amdgcn_exp2f(-dl); l_reg*=f; if(hi==0)wsf[r32]=f; resc=true; } } \
    SBAR(); \
    GAPB(o[0]=__builtin_amdgcn_mfma_f32_32x32x16_bf16(PAF(0),VFR(0),o[0],0,0,0), C0,0); \
    GAPB(o[1]=__builtin_amdgcn_mfma_f32_32x32x16_bf16(PAF(0),VFR(4),o[1],0,0,0), C0,4); \
    KRD(GL,0); GAPB(o[0]=__builtin_amdgcn_mfma_f32_32x32x16_bf16(PAF(1),VFR(1),o[0],0,0,0), C0,8); \
    KRD(GL,1); GAPB(o[1]=__builtin_amdgcn_mfma_f32_32x32x16_bf16(PAF(1),VFR(5),o[1],0,0,0), C0,12); \
    KRD(GL,2); GAPB(o[0]=__builtin_amdgcn_mfma_f32_32x32x16_bf16(PAF(2),VFR(2),o[0],0,0,0), C1,0); \
    KRD(GL,3); GAPB(o[1]=__builtin_amdgcn_mfma_f32_32x32x16_bf16(PAF(2),VFR(6),o[1],0,0,0), C1,4); \
    if(GL){ KALOAD(sl_next); SBAR(); } \
    GAPB(o[0]=__builtin_amdgcn_mfma_f32_32x32x16_bf16(PAF(3),VFR(3),o[0],0,0,0), C1,8); \
    GAPB(o[1]=__builtin_amdgcn_mfma_f32_32x32x16_bf16(PAF(3),VFR(7),o[1],0,0,0), C1,12); \
    }while(0)
  int t=1;
  #undef CMASK
  #define CMASK(P0,P1,t) do{}while(0)
  for(;t+5<NT;t+=2){
    STEP(pB0,pB1,pA0,pA1,t,true,true,true);     WAIT_BAR(2); RESC(); ROT();
    STEP(pA0,pA1,pB0,pB1,t+1,true,true,true);   WAIT_BAR(2); RESC(); ROT();
  }
  #undef CMASK
  #define CMASK(P0,P1,t) do{int jb_=(t)-(NT-4); if(jb_>=0)cmask(P0,P1,jb_,qrel,hi);}while(0)
  #define ENDW(tt) do{ if((tt)+3<NT){WAIT_BAR(2);} else if((tt)+2<NT){WAIT_BAR(1);} else {WAIT_BAR(0);} }while(0)
  for(;t+1<NT;t+=2){
    STEP(pB0,pB1,pA0,pA1,t,(t+3<NT),(t+1<NT),(t+1<NT));       ENDW(t);   RESC(); ROT();
    STEP(pA0,pA1,pB0,pB1,t+1,(t+4<NT),(t+2<NT),(t+2<NT));     ENDW(t+1); RESC(); ROT();
  }
  STEP(pB0,pB1,pA0,pA1,NT-1,false,false,false); RESC();
  { float sacc=pB0[0]+pB0[1]; _Pragma("unroll") for(int r=2;r<16;++r)sacc+=pB0[r]; _Pragma("unroll") for(int r=0;r<16;++r)sacc+=pB1[r]; l_reg+=sacc;
    pw0=(u32x4){PKW(pB0,0),PKW(pB0,2),PKW(pB0,4),PKW(pB0,6)};pw1=(u32x4){PKW(pB0,8),PKW(pB0,10),PKW(pB0,12),PKW(pB0,14)};pw2=(u32x4){PKW(pB1,0),PKW(pB1,2),PKW(pB1,4),PKW(pB1,6)};pw3=(u32x4){PKW(pB1,8),PKW(pB1,10),PKW(pB1,12),PKW(pB1,14)};
    SBAR(); pv(o,vb0+sl_cur,PAF(0),PAF(1),PAF(2),PAF(3)); }
  #undef PKW
  #undef PAF
  #undef VFR
  #undef PIN
  #undef MX3
  #undef GAPA
  #undef GAPB
  #undef EX
  #undef VRD
  #undef KRD
  #undef STEP
  #undef ENDW
  {auto rr=__builtin_amdgcn_permlane32_swap(__float_as_uint(l_reg),__float_as_uint(l_reg),false,false);l_reg=__uint_as_float(rr[0])+__uint_as_float(rr[1]);}
  if(hi==0)wsf[32+r32]=l_reg;asm volatile("s_waitcnt lgkmcnt(0)":::"memory");
  float rli[16];
  #pragma unroll
  for(int r=0;r<16;++r)rli[r]=__builtin_amdgcn_rcpf(wsf[32+crow(r,hi)]);
  bf16*Ow=O+(rowbase+q0+wid*QBLK)*DM+h*D;
  { bf16*stg=(bf16*)(shm+LDS_OST)+wid*2048;
    #pragma unroll
    for(int r=0;r<16;++r){const int orow=crow(r,hi);
      #pragma unroll
      for(int d0=0;d0<2;++d0)stg[orow*64+d0*32+r32]=__float2bfloat16(o[d0][r]*rli[r]);}
    asm volatile("s_waitcnt lgkmcnt(0)":::"memory");
    #pragma unroll
    for(int i=0;i<4;++i){const int row=i*8+(lane>>3),ch=lane&7; const u32x4 v=*(const u32x4*)(stg+row*64+ch*8); ATTN_STORE16(Ow+(long)row*DM+ch*8,v);} }
  asm volatile("s_waitcnt lgkmcnt(0)\n\ts_barrier":::"memory");
  #undef DMA_K
  #undef DMA_KA
  #undef KALOAD
  #undef QA_REBUILD
  #undef QAF
  #undef DMA_V
  #undef CMASK
  #undef START
  #undef RESC
  #undef ROT
}
constexpr int ATTN_LDS_BYTES=LDS_BYTES;
#undef SBAR
#undef WAIT_BAR
}
namespace dil {
using fox::bf16; using fox::bf16x8; using fox::f32x16; using fox::u32x4; using fox::s16x4;
constexpr int PITCH = 768;
constexpr int BT_N = 224;
__device__ __forceinline__ float hswap_max(float v) { auto rr = __builtin_amdgcn_permlane32_swap(__float_as_uint(v), __float_as_uint(v), false, false); return fmaxf(__uint_as_float(rr[0]), __uint_as_float(rr[1])); }
__device__ __forceinline__ float hswap_sum(float v) { auto rr = __builtin_amdgcn_permlane32_swap(__float_as_uint(v), __float_as_uint(v), false, false); return __uint_as_float(rr[0]) + __uint_as_float(rr[1]); }
__device__ __forceinline__ void pv_hi(f32x16* o, int vb, bf16x8 pa2, bf16x8 pa3) {
#pragma unroll
    for (int d0 = 0; d0 < 2; ++d0) { s16x4 lo[2], hi[2];
#pragma unroll
        for (int ks = 0; ks < 2; ++ks) {
            asm volatile("ds_read_b64_tr_b16 %0,%1 offset:%c2" : "=&v"(lo[ks]) : "v"(vb), "i"(d0 * 4096 + (ks + 2) * 1024) : "memory");
            asm volatile("ds_read_b64_tr_b16 %0,%1 offset:%c2" : "=&v"(hi[ks]) : "v"(vb), "i"(d0 * 4096 + (ks + 2) * 1024 + 512) : "memory"); }
        asm volatile("s_waitcnt lgkmcnt(0)" ::: "memory"); __builtin_amdgcn_sched_barrier(0);
#define DIL_PKV(k) (bf16x8){lo[k][0], lo[k][1], lo[k][2], lo[k][3], hi[k][0], hi[k][1], hi[k][2], hi[k][3]}
        o[d0] = __builtin_amdgcn_mfma_f32_32x32x16_bf16(pa2, DIL_PKV(0), o[d0], 0, 0, 0);
        o[d0] = __builtin_amdgcn_mfma_f32_32x32x16_bf16(pa3, DIL_PKV(1), o[d0], 0, 0, 0);
#undef DIL_PKV
    }
}
struct TP { int d, h12, tb, c, ubase; };
__device__ __forceinline__ TP mk_tp(int hs, int g, int t0, int r, int c) { TP p; p.d = (g == 0) ? 1 : (g == 1 ? 4 : 16); p.h12 = 4 * g + hs; p.tb = t0 + r; p.c = c; p.ubase = 32 * c - 160; return p; }
__device__ __forceinline__ void glds16s(const void* sbase, unsigned voff, unsigned lds_dst) { unsigned keep;
    asm volatile("s_mov_b32 %0, m0\n\ts_mov_b32 m0, %3\n\ts_nop 0\n\tglobal_load_lds_dwordx4 %1, %2\n\ts_mov_b32 m0, %0" : "=&s"(keep) : "v"(voff), "s"(sbase), "s"(lds_dst) : "memory"); }
__device__ __forceinline__ void dma_v(const TP& p, const unsigned rowbase, const bf16* __restrict__ VA, const unsigned lds_slot, const int tt, const int lane) {
#pragma unroll
    for (int w = 0; w < 8; ++w) {
        if (tt == 0 && (w & 3) < 2) continue;
        int pos = p.tb + p.d * (p.ubase + 64 * tt + 16 * (w & 3) + (lane >> 2)); pos = pos < 0 ? 0 : (pos > SEQ - 1 ? SEQ - 1 : pos);
        const unsigned off = ((rowbase + (unsigned)pos) * (unsigned)PITCH + (unsigned)(p.h12 * 64 + (w >> 2) * 32 + (lane & 3) * 8)) * 2u;
        glds16s(VA, off, (unsigned)__builtin_amdgcn_readfirstlane(lds_slot + w * 1024));
    }
}
__device__ __forceinline__ void issue_qk(const TP& p, const unsigned rowbase, const bf16* __restrict__ QA, const bf16* __restrict__ KA, bf16x8 (&qr)[4], bf16x8 (&kf)[5][4], const int lane) {
    const int r32 = lane & 31, hi = lane >> 5;
    { int tq = p.tb + p.d * (32 * p.c + r32); tq = tq > SEQ - 1 ? SEQ - 1 : tq;
      const unsigned qo = ((rowbase + (unsigned)tq) * (unsigned)PITCH + (unsigned)(p.h12 * 64 + hi * 8)) * 2u;
#pragma unroll
      for (int d0 = 0; d0 < 4; ++d0) qr[d0] = *reinterpret_cast<const bf16x8*>((const char*)QA + qo + d0 * 32); }
#pragma unroll
    for (int ch = 1; ch < 6; ++ch) {
        int pos = p.tb + p.d * (p.ubase + 32 * ch + r32); pos = pos < 0 ? 0 : (pos > SEQ - 1 ? SEQ - 1 : pos);
        const unsigned ko = ((rowbase + (unsigned)pos) * (unsigned)PITCH + (unsigned)(p.h12 * 64 + hi * 8)) * 2u;
#pragma unroll
        for (int d0 = 0; d0 < 4; ++d0) kf[ch - 1][d0] = *reinterpret_cast<const bf16x8*>((const char*)KA + ko + d0 * 32);
    }
    __builtin_amdgcn_sched_barrier(0);
}
template <bool HAS_NEXT>
__device__ __forceinline__ void task(const TP& p, const TP& nx, const int hs, const unsigned rowbase, const bf16* __restrict__ QA, const bf16* __restrict__ KA, const bf16* __restrict__ VA,
                                     bf16* __restrict__ PO, float* __restrict__ LSE, char* shm, const int vslot, const float* bt, float* wsf, bf16x8 (&qr)[4], bf16x8 (&kf)[5][4], const int lane_in) {
    int lane = lane_in; asm volatile("" : "+v"(lane));
    const int r32 = lane & 31, hi = lane >> 5;
    const unsigned lds0 = (unsigned)(uintptr_t)shm;
    f32x16 sc[6];
#pragma unroll
    for (int ch = 1; ch < 6; ++ch) {
        f32x16 a = f32x16{};
#pragma unroll
        for (int d0 = 0; d0 < 4; ++d0) a = __builtin_amdgcn_mfma_f32_32x32x16_bf16(kf[ch - 1][d0], qr[d0], a, 0, 0, 0);
        sc[ch] = a;
    }
    const int kmin = -p.ubase - p.tb / p.d;
    const int kth = kmin - 4 * hi;
    const float* btl = bt + (r32 - 4 * hi + 192);
    float mx = -INFINITY;
#pragma unroll
    for (int ch = 1; ch < 6; ++ch) {
#pragma unroll
        for (int rr = 0; rr < 16; ++rr) {
            const int kc = 32 * ch + (rr & 3) + 8 * (rr >> 2);
            float v = sc[ch][rr] + btl[-kc];
            if (kmin > 0) { if (kc < kth) v = -INFINITY; }
            sc[ch][rr] = v; mx = fmaxf(mx, v);
        }
        asm volatile("" ::: "memory");
    }
    mx = hswap_max(mx);
    float l = 0.f;
#define DIL_PK(P, B) fox::cvtpk_s(P[B], P[B + 1])
#define DIL_PA(P, B) __builtin_bit_cast(bf16x8, (u32x4){DIL_PK(P, B), DIL_PK(P, B + 2), DIL_PK(P, B + 4), DIL_PK(P, B + 6)})
    bf16x8 pk[6][2];
#pragma unroll
    for (int ch = 1; ch < 6; ++ch) {
#pragma unroll
        for (int rr = 0; rr < 16; ++rr) { const float pe = __builtin_amdgcn_exp2f(sc[ch][rr] - mx); sc[ch][rr] = pe; l += pe; }
        pk[ch][0] = DIL_PA(sc[ch], 0); pk[ch][1] = DIL_PA(sc[ch], 8);
    }
#undef DIL_PK
#undef DIL_PA
    l = hswap_sum(l);
    f32x16 o[2]; o[0] = f32x16{}; o[1] = f32x16{};
    const int vb = (int)(lds0 + vslot) + ((lane >> 4) & 1) * 32 + (lane & 3) * 8 + (4 * hi + ((lane & 15) >> 2)) * 64;
    asm volatile("s_waitcnt vmcnt(0)" ::: "memory");
    pv_hi(o, vb, pk[1][0], pk[1][1]);
    dma_v(p, rowbase, VA, lds0 + vslot, 2, lane);
    fox::pv(o, vb + 8192, pk[2][0], pk[2][1], pk[3][0], pk[3][1]);
    if constexpr (HAS_NEXT) {
        issue_qk(nx, rowbase, QA, KA, qr, kf, lane);
        dma_v(nx, rowbase, VA, lds0 + vslot + 8192, 1, lane);
        asm volatile("s_waitcnt vmcnt(32)" ::: "memory");
    } else {
        asm volatile("s_waitcnt vmcnt(0)" ::: "memory");
    }
    fox::pv(o, vb, pk[4][0], pk[4][1], pk[5][0], pk[5][1]);
    if (hi == 0) wsf[r32] = __builtin_amdgcn_rcpf(l);
    if (hi == 0) __hip_atomic_store(LSE + ((size_t)rowbase + p.tb + p.d * (32 * p.c + r32)) * 4 + hs, mx + __builtin_amdgcn_logf(l), __ATOMIC_RELAXED, __HIP_MEMORY_SCOPE_AGENT);
    asm volatile("s_waitcnt lgkmcnt(0)" ::: "memory");
    typedef __attribute__((address_space(3))) unsigned short* lds_u16p; typedef __attribute__((address_space(3))) const u32x4* lds_v4p;
    { const lds_u16p stg = (lds_u16p)(uintptr_t)(lds0 + vslot) + (4 * hi * 64 + r32);
#pragma unroll
      for (int rr = 0; rr < 16; ++rr) {
          const int q0 = (rr & 3) + 8 * (rr >> 2); const float rl = wsf[q0 + 4 * hi];
          stg[q0 * 64] = (unsigned short)(fox::cvtpk_s(o[0][rr] * rl, 0.f) & 0xffffu); stg[q0 * 64 + 32] = (unsigned short)(fox::cvtpk_s(o[1][rr] * rl, 0.f) & 0xffffu);
      } }
    asm volatile("s_waitcnt lgkmcnt(0)" ::: "memory");
    u32x4 ov[4];
    { const lds_v4p rb = (lds_v4p)(uintptr_t)(lds0 + vslot) + lane;
#pragma unroll
      for (int i = 0; i < 4; ++i) ov[i] = rb[i * 64]; }
    asm volatile("s_waitcnt lgkmcnt(0)" ::: "memory");
    if constexpr (HAS_NEXT) dma_v(nx, rowbase, VA, lds0 + vslot, 0, lane);
#pragma unroll
    for (int i = 0; i < 4; ++i) { const int idx = i * 64 + lane; const int qi = idx >> 3, c8 = idx & 7;
        asm volatile("global_store_dwordx4 %0, %1, off sc1\n\ts_nop 1" :: "v"(PO + ((size_t)rowbase + p.tb + p.d * (32 * p.c + qi)) * 256 + hs * 64 + c8 * 8), "v"(ov[i]) : "memory"); }
}
__device__ __forceinline__ void unit(const int b, const int hs, const int blk, const bf16* QA, const bf16* KA, const bf16* VA, const float* __restrict__ BIAS, bf16* PO0, bf16* PO1, bf16* PO2, float* LSE, bf16* YA,
                                     char* shm, float* bt_all, float* wsf_all, unsigned* pairctr, const int gmask = 7  ) {
    int tid_ = threadIdx.x; asm volatile("" : "+v"(tid_));
    const int tid = tid_, wave = __builtin_amdgcn_readfirstlane(tid >> 6);
    const int t0 = blk * 256, t512 = (blk >> 1) * 512, half = blk & 1;
    const int lane = tid & 63; const unsigned rowbase = (unsigned)b * SEQ; const int vslot = wave * 16384;
    const TP p0 = mk_tp(hs, 0, t0, 0, wave), p1 = mk_tp(hs, 1, t0, wave & 3, wave >> 2), p2 = mk_tp(hs, 2, t512, 8 * half + wave, 0);
    bf16x8 qr[4], kf[5][4];
    const unsigned lds0 = (unsigned)(uintptr_t)shm;
    if (gmask == 7) { dma_v(p0, rowbase, VA, lds0 + vslot, 0, lane); dma_v(p0, rowbase, VA, lds0 + vslot + 8192, 1, lane); issue_qk(p0, rowbase, QA, KA, qr, kf, lane); }
    for (int i = tid; i < 3 * BT_N; i += 512) { const int g = i / BT_N, x = i % BT_N, j = x - 32; bt_all[i] = (j >= 0 && j <= 128) ? BIAS[(4 * g + hs) * 129 + j] : -INFINITY; }
    __syncthreads();
    if (gmask == 7) {
        task<true>(p0, p1, hs, rowbase, QA, KA, VA, PO0, LSE, shm, vslot, bt_all, wsf_all + wave * 64, qr, kf, lane);
        task<true>(p1, p2, hs, rowbase, QA, KA, VA, PO1, LSE + (size_t)M * 4, shm, vslot, bt_all + BT_N, wsf_all + wave * 64, qr, kf, lane);
        task<false>(p2, p2, hs, rowbase, QA, KA, VA, PO2, LSE + (size_t)2 * M * 4, shm, vslot, bt_all + 2 * BT_N, wsf_all + wave * 64, qr, kf, lane);
    }
    asm volatile("s_waitcnt vmcnt(0)" ::: "memory");
    __syncthreads();
    unsigned* tick = (unsigned*)(wsf_all + 512);
    if (tid == 0) *tick = __hip_atomic_fetch_add(pairctr, 1u, __ATOMIC_RELAXED, __HIP_MEMORY_SCOPE_AGENT);
    __syncthreads();
    const bool last = (*tick & 1u) == 1u;
    if (last) {
        if (tid < 64) { __builtin_amdgcn_fence(__ATOMIC_ACQUIRE, "agent"); asm volatile("s_waitcnt vmcnt(0)" ::: "memory"); }
        __syncthreads();
        const size_t row0 = (size_t)b * SEQ + t512;
        for (int it = tid; it < 512 * 8; it += 512) {
            const int tok = it >> 3, c8 = it & 7; const size_t row = row0 + tok;
            float ls[3]; u32x4 pv3[3];
#pragma unroll
            for (int g = 0; g < 3; ++g) { const bf16* POg = g == 0 ? PO0 : (g == 1 ? PO1 : PO2); ls[g] = LSE[((size_t)g * M + row) * 4 + hs]; pv3[g] = *(const u32x4*)(POg + row * 256 + hs * 64 + c8 * 8); }
            const float mm = fmaxf(ls[0], fmaxf(ls[1], ls[2]));
            float w[3]; float ws_ = 0.f;
#pragma unroll
            for (int g = 0; g < 3; ++g) { w[g] = __builtin_amdgcn_exp2f(ls[g] - mm); ws_ += w[g]; }
            const float iw = 1.f / ws_;
            float y[8];
#pragma unroll
            for (int e = 0; e < 8; ++e) y[e] = 0.f;
#pragma unroll
            for (int g = 0; g < 3; ++g) { const float wg = w[g] * iw; const unsigned q[4] = {pv3[g].x, pv3[g].y, pv3[g].z, pv3[g].w};
#pragma unroll
                for (int e = 0; e < 4; ++e) { y[2 * e] += wg * __uint_as_float(q[e] << 16); y[2 * e + 1] += wg * __uint_as_float(q[e] & 0xffff0000u); } }
            u32x4 ov; ov.x = fox::cvtpk_s(y[0], y[1]); ov.y = fox::cvtpk_s(y[2], y[3]); ov.z = fox::cvtpk_s(y[4], y[5]); ov.w = fox::cvtpk_s(y[6], y[7]);
            *(u32x4*)(YA + row * 256 + hs * 64 + c8 * 8) = ov;
        }
    }
    __syncthreads();
}
}
namespace rtr {
using fox::bf16x8; using fox::f32x16; using fox::u32x4;
__device__ __forceinline__ void task(const int t, const int kq, const bool valid, const float* __restrict__ X1, const float* __restrict__ gf, const unsigned short* __restrict__ WRF, const float* __restrict__ router_bias,
                                     unsigned short* __restrict__ H2, float* __restrict__ RINV, unsigned* __restrict__ CNT, unsigned* __restrict__ LIST, float* __restrict__ GATEW, float2* __restrict__ META, unsigned* __restrict__ INV, float* tiles, float* sst, PG8_LAS unsigned* LC  ) {
    int tid_ = threadIdx.x; asm volatile("" : "+v"(tid_));
    if (tid_ < 128) LC[tid_] = 0u;
    const int lane = tid_ & 63, r32 = lane & 31, hi = lane >> 5;
    const size_t row = (size_t)t * 32 + r32;
    const float* xp = X1 + row * D + hi * 8; const float* gp = gf + hi * 8; unsigned short* hp = H2 + row * D + hi * 8;
    const u32x4* wf = (const u32x4*)WRF + lane;
    f32x16 acc[2]; acc[0] = f32x16{}; acc[1] = f32x16{};
    float ss = 0.f;
    if (valid) {
#pragma unroll 4
    for (int k0 = 16 * kq; k0 < 16 * kq + 16; ++k0) {
        const float4 xa = *(const float4*)(xp + k0 * 16), xb = *(const float4*)(xp + k0 * 16 + 4);
        const float4 ga = *(const float4*)(gp + k0 * 16), gb = *(const float4*)(gp + k0 * 16 + 4);
        const u32x4 bh0 = wf[(0 * 64 + k0) * 64], bh1 = wf[(1 * 64 + k0) * 64], bl0 = wf[(2 * 64 + k0) * 64], bl1 = wf[(3 * 64 + k0) * 64];
        const float x[8] = {xa.x, xa.y, xa.z, xa.w, xb.x, xb.y, xb.z, xb.w}; const float gg[8] = {ga.x, ga.y, ga.z, ga.w, gb.x, gb.y, gb.z, gb.w};
        float y[8]; unsigned ph[4], pl[4];
#pragma unroll
        for (int e = 0; e < 8; ++e) { ss += x[e] * x[e]; y[e] = x[e] * gg[e]; }
#pragma unroll
        for (int e = 0; e < 4; ++e) { ph[e] = fox::cvtpk_s(y[2 * e], y[2 * e + 1]);
            pl[e] = fox::cvtpk_s(y[2 * e] - __uint_as_float(ph[e] << 16), y[2 * e + 1] - __uint_as_float(ph[e] & 0xffff0000u)); }
        const u32x4 hv = {ph[0], ph[1], ph[2], ph[3]}, lv = {pl[0], pl[1], pl[2], pl[3]};
        *(u32x4*)(hp + k0 * 16) = hv;
        const bf16x8 ah = __builtin_bit_cast(bf16x8, hv), al = __builtin_bit_cast(bf16x8, lv);
        acc[0] = __builtin_amdgcn_mfma_f32_32x32x16_bf16(ah, __builtin_bit_cast(bf16x8, bh0), acc[0], 0, 0, 0);
        acc[1] = __builtin_amdgcn_mfma_f32_32x32x16_bf16(ah, __builtin_bit_cast(bf16x8, bh1), acc[1], 0, 0, 0);
        acc[0] = __builtin_amdgcn_mfma_f32_32x32x16_bf16(ah, __builtin_bit_cast(bf16x8, bl0), acc[0], 0, 0, 0);
        acc[1] = __builtin_amdgcn_mfma_f32_32x32x16_bf16(ah, __builtin_bit_cast(bf16x8, bl1), acc[1], 0, 0, 0);
        acc[0] = __builtin_amdgcn_mfma_f32_32x32x16_bf16(al, __builtin_bit_cast(bf16x8, bh0), acc[0], 0, 0, 0);
        acc[1] = __builtin_amdgcn_mfma_f32_32x32x16_bf16(al, __builtin_bit_cast(bf16x8, bh1), acc[1], 0, 0, 0);
    }
    { auto rr = __builtin_amdgcn_permlane32_swap(__float_as_uint(ss), __float_as_uint(ss), false, false); ss = __uint_as_float(rr[0]) + __uint_as_float(rr[1]); }
    float* tile = tiles + kq * (32 * 65);
#pragma unroll
    for (int eh = 0; eh < 2; ++eh)
#pragma unroll
        for (int r = 0; r < 16; ++r) tile[((r & 3) + 8 * (r >> 2) + 4 * hi) * 65 + eh * 32 + r32] = acc[eh][r];
    if (hi == 0) sst[kq * 32 + r32] = ss;
    }
    asm volatile("s_waitcnt lgkmcnt(0)" ::: "memory");
    __syncthreads();
    const bool fin = valid && kq == 0;
    int ls[4] = {0, 0, 0, 0}; unsigned lp[4] = {0u, 0u, 0u, 0u}; float gwv[4] = {0.f, 0.f, 0.f, 0.f}; float rinv = 0.f;
#define RT_LOGIT(e_) ((trow[e_] + trow[(e_) + 32 * 65]) + (trow[(e_) + 2 * 32 * 65] + trow[(e_) + 3 * 32 * 65]))
    if (fin) {
    rinv = rsqrtf((sst[r32] + sst[32 + r32] + sst[64 + r32] + sst[96 + r32]) * (1.f / D) + EPS);
    if (hi == 0) RINV[row] = rinv;
    float tv[8]; int ti[8];
#pragma unroll
    for (int p = 0; p < 8; ++p) { tv[p] = -INFINITY; ti[p] = 0; }
    const float* trow = tiles + r32 * 65;
#pragma unroll 4
    for (int e0 = 0; e0 < 32; ++e0) {
        const int e = hi * 32 + e0;
        float v = 1.f / (1.f + __expf(-RT_LOGIT(e) * rinv)) + router_bias[e]; int id = e;
#pragma unroll
        for (int p = 0; p < 8; ++p) { const bool gt = v > tv[p]; const float tvv = tv[p]; const int tii = ti[p]; tv[p] = gt ? v : tvv; ti[p] = gt ? id : tii; v = gt ? tvv : v; id = gt ? tii : id; }
    }
    float ov[8]; int oi[8];
#pragma unroll
    for (int p = 0; p < 8; ++p) { auto a = __builtin_amdgcn_permlane32_swap(__float_as_uint(tv[p]), __float_as_uint(tv[p]), false, false); ov[p] = hi ? __uint_as_float(a[0]) : __uint_as_float(a[1]);
        auto bq = __builtin_amdgcn_permlane32_swap((unsigned)ti[p], (unsigned)ti[p], false, false); oi[p] = hi ? (int)bq[0] : (int)bq[1]; }
#pragma unroll
    for (int q = 0; q < 8; ++q) { float v = ov[q]; int id = oi[q];
#pragma unroll
        for (int p = 0; p < 8; ++p) { const bool gt = (v > tv[p]) || (v == tv[p] && id < ti[p]); const float tvv = tv[p]; const int tii = ti[p]; tv[p] = gt ? v : tvv; ti[p] = gt ? id : tii; v = gt ? tvv : v; id = gt ? tii : id; } }
    float sv[8]; float ssum = 0.f;
#pragma unroll
    for (int p = 0; p < 8; ++p) { sv[p] = 1.f / (1.f + __expf(-RT_LOGIT(ti[p]) * rinv)); ssum += sv[p]; }
    const float sc = 2.5f / ssum;
#pragma unroll
    for (int j = 0; j < 4; ++j) { const int e = hi ? ti[4 + j] : ti[j]; ls[j] = e * 2 + hi; gwv[j] = (hi ? sv[4 + j] : sv[j]) * sc;
        lp[j] = __hip_atomic_fetch_add(LC + ls[j], 1u, __ATOMIC_RELAXED, __HIP_MEMORY_SCOPE_WORKGROUP); }
    }
    asm volatile("s_waitcnt lgkmcnt(0)" ::: "memory");
    __syncthreads();
    if (tid_ < 128) { const unsigned c = LC[tid_]; unsigned base = 0u; if (c != 0u) base = atomicAdd(&CNT[tid_ * CNT_STRIDE], c); LC[128 + tid_] = base; }
    asm volatile("s_waitcnt lgkmcnt(0)" ::: "memory");
    __syncthreads();
    if (fin) {
#pragma unroll
    for (int j = 0; j < 4; ++j) {
        const int l = ls[j], p = 4 * hi + j;
        const unsigned pos = LC[128 + l] + lp[j];
        LIST[(size_t)l * M + pos] = (unsigned)row * 8u + (unsigned)p;
        GATEW[row * 8 + p] = gwv[j];
        META[(size_t)l * M + pos] = make_float2(rinv, gwv[j]);
        INV[row * 8 + p] = ((unsigned)l << 16) | pos;
    }
    }
    asm volatile("s_waitcnt lgkmcnt(0)" ::: "memory");
#undef RT_LOGIT
}
}
#define GAS __attribute__((address_space(1)))
#define LAS __attribute__((address_space(3)))
typedef unsigned short bf16;
typedef unsigned v4u __attribute__((ext_vector_type(4)));
typedef float f32x4 __attribute__((ext_vector_type(4)));
typedef short bf16x8 __attribute__((ext_vector_type(8)));
typedef GAS unsigned gu32;
typedef GAS unsigned long long gu64;
#define RLX_AGENT __ATOMIC_RELAXED, __HIP_MEMORY_SCOPE_AGENT
#define LDS_WAIT() asm volatile("s_waitcnt lgkmcnt(0)" ::: "memory")
#define VM_WAIT() asm volatile("s_waitcnt vmcnt(0)" ::: "memory")
__device__ __forceinline__ unsigned long long rt() { return __builtin_amdgcn_s_memrealtime(); }

#define XB_TMO      128
#define XB_XCNT(j)  (256  + 64 * (j))
#define XB_XSUB(j)  (1280 + 64 * (j))
#define XB_XGEN(j)  (2304 + 64 * (j))
#define XB_TOP      3328
#define XB_TOPGEN   3392
#define XCD_BAR_WORDS 3456
#define XB_SPIN_CAP (1u << 18)

__device__ __forceinline__ unsigned xb_ld(unsigned* p)              { return __hip_atomic_load(p, __ATOMIC_RELAXED, __HIP_MEMORY_SCOPE_AGENT); }
__device__ __forceinline__ unsigned xb_add(unsigned* p, unsigned v) { return __hip_atomic_fetch_add(p, v, __ATOMIC_RELAXED, __HIP_MEMORY_SCOPE_AGENT); }
__device__ __forceinline__ unsigned xb_xcc_id() { return (unsigned)__builtin_amdgcn_s_getreg((3 << 11) | 20) & 0xFu; }
#define XB_SPIN(cond, bar) do { unsigned _sp = 0; while (cond) { __builtin_amdgcn_s_sleep(1); \
    if ((++_sp & 255u) == 0u) { if (xb_ld(&(bar)[XB_TMO])) break; if (_sp > XB_SPIN_CAP) { atomicAdd(&(bar)[XB_TMO], 1u); break; } } } } while (0)

struct XcdBarrier {
    unsigned* bar; unsigned x;
    volatile LAS unsigned* st;
};

__device__ __forceinline__ XcdBarrier xcd_barrier_post(unsigned* bar, volatile LAS unsigned* st) {
    XcdBarrier b; b.bar = bar; b.x = xb_xcc_id(); b.st = st;
    if (threadIdx.x == 0) (void)xb_add(&bar[XB_XCNT(b.x)], 1u);
    return b;
}
__device__ __forceinline__ void xcd_barrier_complete(unsigned* bar, unsigned x, unsigned& nloc, unsigned& nx) {
    const unsigned G = gridDim.x * gridDim.y * gridDim.z;
    unsigned sum, cnt, mine, sp = 0u;
    for (;;) {
        sum = 0u; cnt = 0u; mine = 0u;
#pragma unroll
        for (unsigned j = 0; j < 16; ++j) { const unsigned c = xb_ld(&bar[XB_XCNT(j)]); sum += c; cnt += (c > 0u) ? 1u : 0u; mine = (j == x) ? c : mine; }
        if (sum == G) break;
        __builtin_amdgcn_s_sleep(1);
        if ((++sp & 255u) == 0u) { if (xb_ld(&bar[XB_TMO])) break; if (sp > XB_SPIN_CAP) { atomicAdd(&bar[XB_TMO], 1u); break; } }
    }
    nloc = mine > 0u ? mine : 1u; nx = cnt > 0u ? cnt : 1u;
}

__device__ __forceinline__ void xcd_barrier(const XcdBarrier& b) {
    asm volatile("s_waitcnt vmcnt(0)" ::: "memory");
    __syncthreads();
    if (threadIdx.x == 0) {
        unsigned* bar = b.bar;
        __builtin_amdgcn_s_waitcnt(0);
        unsigned nloc = b.st[0], nx = b.st[1];
        if (nloc == 0u) { xcd_barrier_complete(bar, b.x, nloc, nx); b.st[0] = nloc; b.st[1] = nx; }
        const unsigned old = xb_add(&bar[XB_XSUB(b.x)], 1u);
        const unsigned gen = old / nloc;
        if (old + 1u == (gen + 1u) * nloc) {
            __builtin_amdgcn_fence(__ATOMIC_RELEASE, "agent");
            asm volatile("s_waitcnt vmcnt(0)" ::: "memory");
            const unsigned og = xb_add(&bar[XB_TOP], 1u);
            const unsigned tg = og / nx;
            if (og + 1u == (tg + 1u) * nx) xb_add(&bar[XB_TOPGEN], 1u);
            else XB_SPIN(xb_ld(&bar[XB_TOPGEN]) == tg, bar);
            __builtin_amdgcn_fence(__ATOMIC_ACQUIRE, "agent");
            xb_add(&bar[XB_XGEN(b.x)], 1u);
            asm volatile("s_waitcnt vmcnt(0)" ::: "memory");
        } else {
            XB_SPIN(xb_ld(&bar[XB_XGEN(b.x)]) == gen, bar);
            __builtin_amdgcn_fence(__ATOMIC_ACQUIRE, "agent");
            asm volatile("s_waitcnt vmcnt(0)" ::: "memory");
        }
    }
    __syncthreads();
}
constexpr int NWAVES = 8;
constexpr int RING_OFF = 0, RING_BYTES = 131072;
constexpr int LDSCTL_OFF = RING_BYTES, MISC_OFF = LDSCTL_OFF + 320;
constexpr int TB_CNT = LDSCTL_OFF + 1024, TB_HB = LDSCTL_OFF + 2048, TB_T6 = LDSCTL_OFF + 3072, TB_TA = LDSCTL_OFF + 4096, TB_TB = LDSCTL_OFF + 5120, TB_T9 = LDSCTL_OFF + 6144, TB_UT = LDSCTL_OFF + 7168;
constexpr int LDS_BYTES = 147456;
constexpr int CW_TMO = 0, CW_CODE = 1, CW_BAR = 4096;
constexpr int N_IN = 16 * 60, N_G = 16 * 32, N_PA = 4 * 16, N_PB = 8 * 16, N_O = 16 * 16, N_EX = 65 * 128, N_W2 = 65 * 64;
constexpr int N_FILL1 = 0;    constexpr int N_FILL2 = 8320;
constexpr int NITEMS = N_IN + N_G + N_PA + N_PB + N_O + N_EX - N_FILL1 - N_FILL2;
constexpr int NPHASE = 10;
constexpr int NTOT1 = 3840 + 2048;
struct MArgs { const float* in[23]; float* out; unsigned char* ws; int ph_lo, ph_hi, li, pad; };

__device__ __forceinline__ void tr64_load(f32x4 (&v)[16], const float* W, int ldw, int k0, int n0, int lane) {
    const int lq = lane >> 4, n4 = lane & 15;
    const GAS f32x4* src = (const GAS f32x4*)(W + (size_t)(k0 + 2 * lq) * ldw + n0 + 4 * n4);
#pragma unroll
    for (int j = 0; j < 16; ++j) v[j] = src[((size_t)(8 * (j >> 1) + (j & 1)) * ldw) >> 2];
}
__device__ __forceinline__ void tr64_store(const f32x4 (&v)[16], int k0, bf16* WT, int K, int base_row, int hstride, LAS unsigned* T, int lane) {
    const int lq = lane >> 4, n4 = lane & 15;
#pragma unroll
    for (int p = 0; p < 8; ++p)
#pragma unroll
        for (int e = 0; e < 4; ++e) T[(4 * n4 + e) * 33 + 4 * p + lq] = pg8::cvtc(v[2 * p][e], v[2 * p + 1][e]);
    LDS_WAIT(); asm volatile("" ::: "memory");
    const int c = lane & 7;
#pragma unroll
    for (int j = 0; j < 8; ++j) { const int n = (lane >> 3) + 8 * j; const LAS unsigned* s = T + n * 33 + 4 * c;
        v4u o; o.x = s[0]; o.y = s[1]; o.z = s[2]; o.w = s[3];
        *(GAS v4u*)(WT + (size_t)(base_row + hstride * (n >> 5) + (n & 31)) * K + k0 + 8 * c) = o; }
    LDS_WAIT(); asm volatile("" ::: "memory");
}
__device__ __forceinline__ void p0_tr64(const float* W, int ldw, int k0, int n0, bf16* WT, int K, int base_row, int hstride, LAS unsigned* T, int lane) {
    f32x4 v[16];
    tr64_load(v, W, ldw, k0, n0, lane);
    tr64_store(v, k0, WT, K, base_row, hstride, T, lane);
}
__device__ __forceinline__ void rms_row(const float* xrow, const float* g, bf16* orow, const LAS float* wt8, const float* b_forget, float* logf_row, int lane) {
    const GAS f32x4* xr = (const GAS f32x4*)xrow;
    f32x4 v[4]; float ss = 0.f;
#pragma unroll
    for (int j = 0; j < 4; ++j) { v[j] = xr[lane + 64 * j]; ss += v[j].x * v[j].x + v[j].y * v[j].y + v[j].z * v[j].z + v[j].w * v[j].w; }
    ss = wave_sum(ss);
    const float rinv = rsqrtf(ss * (1.f / D) + EPS);
    float f[8];
#pragma unroll
    for (int c = 0; c < 8; ++c) f[c] = 0.f;
#pragma unroll
    for (int j = 0; j < 4; ++j) {
        const f32x4 gg = ((const GAS f32x4*)g)[lane + 64 * j];
        float y[4] = {v[j].x * rinv * gg.x, v[j].y * rinv * gg.y, v[j].z * rinv * gg.z, v[j].w * rinv * gg.w};
        u32x2 o; o.x = pg8::cvtc(y[0], y[1]); o.y = pg8::cvtc(y[2], y[3]);
        *(GAS u32x2*)(orow + 4 * (lane + 64 * j)) = o;
        if (wt8) {
#pragma unroll
            for (int c = 0; c < 8; ++c) { const f32x4 w = *(const LAS f32x4*)(wt8 + c * 1024 + 4 * (lane + 64 * j)); f[c] += (y[0] * w.x + y[1] * w.y) + (y[2] * w.z + y[3] * w.w); }
        }
    }
    if (wt8) {
#pragma unroll
        for (int c = 0; c < 8; ++c) f[c] = wave_sum(f[c]);
        float mine = f[0];
#pragma unroll
        for (int c = 1; c < 8; ++c) mine = (lane == c) ? f[c] : mine;
        if (lane < 8) { const float z = mine + b_forget[lane]; logf_row[lane] = fminf(z, 0.f) - log1pf(expf(-fabsf(z))); }
    }
}
__device__ __forceinline__ void p1_cumsum(int bh, const float* LOGF, float* C, bf16* KAUG, LAS float* sc, int tid, const float* qnb, const float* knb, int* FT0) {
    const int b = bh >> 3, h = bh & 7;
    float loc[16]; float run = 0.f;
#pragma unroll
    for (int e = 0; e < 16; ++e) { run += LOGF[((size_t)b * SEQ + 16 * tid + e) * 8 + h]; loc[e] = run; }
    sc[tid] = run; __syncthreads();
    for (int o = 1; o < 512; o <<= 1) { const float t = (tid >= o) ? sc[tid - o] : 0.f; __syncthreads(); sc[tid] += t; __syncthreads(); }
    const float base = sc[tid] - run;
#pragma unroll
    for (int e = 0; e < 16; ++e) {
        const float c = base + loc[e]; const int t = 16 * tid + e;
        C[(size_t)bh * SEQ + t] = c;
        const float vv = -c * LOG2E;
        const unsigned p0 = f2bf(vv); const float r1 = vv - __uint_as_float(p0 << 16);
        const unsigned p1 = f2bf(r1); const float r2 = r1 - __uint_as_float(p1 << 16);
        const unsigned p2 = f2bf(r2);
        v4u o; o.x = p0 | (p1 << 16); o.y = p2 | (0x3F80u << 16); o.z = 0x3F803F80u; o.w = 0u;
        *(GAS v4u*)(KAUG + (((size_t)b * SEQ + t) * 8 + h) * 8) = o;
        sc[512 + t] = c;
    }
    __syncthreads();
    if (tid < 64) {
        const int lane = tid; const float gq = wave_max(fabsf(qnb[lane])), gk = wave_max(fabsf(knb[lane]));
        const float thr = 2.f * 8.f * gq * gk * 1.03f + 20.f;
        int cost = 0;
        if (lane < 32) { const int q0 = 256 * lane; const float c0 = sc[512 + q0]; int lo = 0, hi = q0;
            while (lo < hi) { const int mid = (lo + hi) >> 1; if (c0 - sc[512 + mid] >= -thr) hi = mid; else lo = mid + 1; }
            int T0 = (lo >> 6) & ~1; if (T0 > 4 * lane) T0 = 4 * lane; FT0[bh * 32 + lane] = T0; cost = 4 * lane + 4 - T0; }
#pragma unroll
        for (int o = 1; o < 64; o <<= 1) cost += __shfl_xor(cost, o);
        if (lane == 0) FT0[512 + bh] = cost;
    }
    __syncthreads();
}

__device__ __forceinline__ unsigned wave_excl_scan(unsigned v, int lane, unsigned& total) {
    unsigned x = v;
#pragma unroll
    for (int o = 1; o < 64; o <<= 1) { const unsigned y = __shfl_up(x, o); if (lane >= o) x += y; }
    total = __shfl(x, 63); return x - v;
}
__device__ __forceinline__ void moe_tables(LAS unsigned char* L, const gu32* CNT, int tid) {
    asm volatile("" : "+v"(tid));
    if (tid < 64) {
        const int lane = tid;
        const unsigned c0 = __hip_atomic_load(CNT + (2 * lane) * CNT_STRIDE, RLX_AGENT), c1 = __hip_atomic_load(CNT + (2 * lane + 1) * CNT_STRIDE, RLX_AGENT);
        const unsigned t0 = (c0 + 255u) >> 8, t1 = (c1 + 255u) >> 8;
        unsigned tc, ta, tbb, t6;
        const unsigned hb = wave_excl_scan(c0 + c1, lane, tc), pa = wave_excl_scan(t0, lane, ta), pb = wave_excl_scan(t1, lane, tbb), p6 = wave_excl_scan((c0 + c1 + 255u) >> 8, lane, t6);
        LAS unsigned* cntL = (LAS unsigned*)(L + TB_CNT); LAS unsigned* hbL = (LAS unsigned*)(L + TB_HB); LAS unsigned* T6 = (LAS unsigned*)(L + TB_T6);
        LAS unsigned* TA = (LAS unsigned*)(L + TB_TA); LAS unsigned* TBt = (LAS unsigned*)(L + TB_TB); LAS unsigned* T9 = (LAS unsigned*)(L + TB_T9);
        cntL[2 * lane] = c0; cntL[2 * lane + 1] = c1; hbL[2 * lane] = hb; hbL[2 * lane + 1] = hb + c0;
        T6[lane] = p6; TA[lane] = pa; TBt[lane] = pb;
        if (lane == 0) { cntL[128] = (unsigned)M; hbL[128] = 0u; T6[64] = t6; T6[65] = t6 + (unsigned)(M / 256); TA[64] = ta; TBt[64] = tbb; T9[0] = 0u; T9[1] = (unsigned)(M / 256); }
    }
    __syncthreads();
}

__device__ __forceinline__ void conv_w1_item(int r, const float* wg_e, const float* wu_e, const float* wg_s, const float* wu_s, bf16* W1, LAS unsigned* scr, int lane) {
    const int e = r >> 7, q = r & 127, up = q >> 6, qq = q & 63, kb = qq >> 2, nb = qq & 3;
    const float* src = (e < NE) ? (up ? wu_e : wg_e) + (size_t)e * D * DE : (up ? wu_s : wg_s);
    p0_tr64(src, DE, 64 * kb, 64 * nb, W1 + (size_t)e * 512 * D, D, 256 * (nb >> 1) + 128 * up + 64 * (nb & 1), 32, scr, lane);
}
__global__ void __launch_bounds__(NWAVES * 64, 2) mega(MArgs args) {
    extern __shared__ __attribute__((aligned(16))) unsigned char lds[];
    LAS unsigned char* L = (LAS unsigned char*)lds;
    volatile LAS unsigned* MISC = (volatile LAS unsigned*)(L + MISC_OFF);
    const int tid = threadIdx.x, lane = tid & 63, wave = __builtin_amdgcn_readfirstlane(tid >> 6);
    const int G = gridDim.x; const int bx = blockIdx.x; const int vcu = (G % 8 == 0) ? (bx % 8) * (G / 8) + bx / 8 : bx;
    unsigned char* ws = args.ws;
    gu32* ctl = (gu32*)(ws + WS_CTL);
#ifdef RERUN_PHASE
#define PROBE_RR (args.li != 0)
#else
#define PROBE_RR false
#endif
    for (int u = tid; u < (LDS_BYTES - LDSCTL_OFF) / 4; u += NWAVES * 64) ((LAS unsigned*)(L + LDSCTL_OFF))[u] = 0u;
    __syncthreads();
    XcdBarrier bar = xcd_barrier_post((unsigned*)(ctl + CW_BAR) + args.li * 28672  , MISC + 8);
#ifdef DIAG_TS
#define GRID_BAR() do { const unsigned long long t0_ = rt(); xcd_barrier(bar); if (bx == DIAG_BLK && tid == 0) ((unsigned long long*)(ws + WS_CTL + 512 * 1024))[20] += rt() - t0_; } while (0)
#else
#define GRID_BAR() xcd_barrier(bar)
#endif
#ifdef RERUN_GMASK
#define DIL_GMASK (PROBE_RR ? RERUN_GMASK : 7)
#else
#define DIL_GMASK 7
#endif
#ifdef RERUN_NOEPI
#define PROBE_NOEPI (PROBE_RR ? 1 : 0)
#else
#define PROBE_NOEPI 0
#endif
#define VCU() ((G % 8 == 0) ? ((int)blockIdx.x % 8) * (G / 8) + (int)blockIdx.x / 8 : (int)blockIdx.x)
#ifndef REPEAT_PHASE
#define REPEAT_PHASE (-1)
#endif
#define NREP(k) (((REPEAT_PHASE) == (k)) ? 2 : 1)
#ifdef REPEAT_BARRIER
#define REP_BAR() do { if (rep_ > 0) GRID_BAR(); } while (0)
#else
#define REP_BAR() do {} while (0)
#endif
#ifndef EXTRA_BARRIERS
#define EXTRA_BARRIERS 0
#endif
#ifdef DIAG_TS
#define TSTAMP(k) do { if (bx == DIAG_BLK && tid == 0) ((unsigned long long*)(ws + WS_CTL + 512 * 1024))[k] = rt(); } while (0)
#else
#define TSTAMP(k) do {} while (0)
#endif
    const int lo = args.ph_lo, hi = args.ph_hi;
#define IN(k) (lo <= (k) && (k) < hi)
#define BOTH(k) (IN(k) && IN((k) + 1))

    TSTAMP(0);
    if (IN(0)) {
        const float* x = args.in[0]; const float* g_mix = args.in[1]; const float* w_in = args.in[2]; const float* rel_bias = args.in[7]; const float* b_forget = args.in[8]; const float* w_gate = args.in[9]; const float* wpa = args.in[11]; const float* wpb = args.in[12]; const float* w_out = args.in[13]; const float* w_router = args.in[15]; const float* wg_e = args.in[17]; const float* wu_e = args.in[18]; const float* wd_e = args.in[19]; const float* wg_s = args.in[20]; const float* wu_s = args.in[21]; const float* wd_s = args.in[22]; bf16* XN = (bf16*)(ws + WS_XN); bf16* WIN_t = (bf16*)(ws + WS_WIN); bf16* WPA_t = (bf16*)(ws + WS_WIN) + (size_t)NTOT1 * D; bf16* WPB_t = (bf16*)(ws + WS_WIN) + (size_t)NTOT1 * D + (size_t)D * OUTA; bf16* WOUT_t = (bf16*)(ws + WS_WIN) + (size_t)NTOT1 * D + (size_t)D * OUTA + (size_t)D * OUTB; bf16* W1 = (bf16*)(ws + WS_W1); bf16* W2 = (bf16*)(ws + WS_W2); float* LOGF = (float*)(ws + WS_LOGF); float* BIAS = (float*)(ws + WS_BIAS);
        _Pragma("unroll") for (int rep_ = 0; rep_ < NREP(0); ++rep_) { REP_BAR();
        LAS unsigned* scr = (LAS unsigned*)(L + RING_OFF + wave * 8704);
        LAS float* wt8 = (LAS float*)(L + RING_OFF + 8 * 8704);
        const int gw = vcu * NWAVES + wave, NGW = G * NWAVES;
        for (int i = tid; i < 8 * D; i += NWAVES * 64) { const int ii = i >> 3, c = i & 7; wt8[c * D + ii] = w_in[(size_t)ii * DIN + (WA + WB) + c]; }
        for (int it = gw; it < NITEMS; it += NGW) {
            int r = it;
            if (r < N_EX - N_FILL1 - N_FILL2) { conv_w1_item(r + N_FILL1 + N_FILL2, wg_e, wu_e, wg_s, wu_s, W1, scr, lane); continue; } r -= N_EX - N_FILL1 - N_FILL2;
            if (r < N_IN) { const int kb = r / 60, nb = r % 60, c = 64 * nb;
                p0_tr64(w_in, DIN, 64 * kb, c, WIN_t, D, 256 * (c / 256) + 32 * ((c % 256) / 64), 128, scr, lane); continue; } r -= N_IN;
            if (r < N_G) { const int kb = r >> 5, nb = r & 31; p0_tr64(w_gate, 2 * D, 64 * kb, 64 * nb, WIN_t, D, 3840 + 64 * nb, 32, scr, lane); continue; } r -= N_G;
            if (r < N_PA) { const int kb = r >> 4, nb = r & 15; p0_tr64(wpa, D, 64 * kb, 64 * nb, WPA_t, OUTA, 64 * nb, 32, scr, lane); continue; } r -= N_PA;
            if (r < N_PB) { const int kb = r >> 4, nb = r & 15; p0_tr64(wpb, D, 64 * kb, 64 * nb, WPB_t, OUTB, 64 * nb, 32, scr, lane); continue; } r -= N_PB;
            { const int kb = r >> 4, nb = r & 15; p0_tr64(w_out, D, 64 * kb, 64 * nb, WOUT_t, D, 64 * nb, 32, scr, lane); }
        }
        __syncthreads();
        for (int m = gw; m < M; m += NGW) rms_row(x + (size_t)m * D, g_mix, XN + (size_t)m * D, wt8, b_forget, LOGF + (size_t)m * 8, lane);
        if (bx == 0) for (int i = tid; i < HA * 129; i += NWAVES * 64) {
            const int head = i / 129, j = i % 129, g = head >> 2; const int d = (g == 0) ? 1 : (g == 1 ? 4 : 16);
            const int dist = d * j; int bucket;
            if (dist < 16) bucket = dist;
            else { const int large = 16 + (int)(__log2f((float)dist * 0.0625f) * (16.f / 7.f)); bucket = large < 31 ? large : 31; }
            BIAS[head * 129 + j] = rel_bias[bucket * HA + head] * LOG2E;
        }
        { unsigned* WRFw = (unsigned*)(ws + WS_WRF);
          for (int i = bx * (NWAVES * 64) + tid; i < 2 * 64 * 64; i += G * NWAVES * 64) {
              const int ln = i & 63, k0 = (i >> 6) & 63, eh = i >> 12; const int e = eh * 32 + (ln & 31), kb = 16 * k0 + 8 * (ln >> 5);
              float wv[8]; unsigned ph[4], pl[4];
#pragma unroll
              for (int j = 0; j < 8; ++j) wv[j] = w_router[(size_t)(kb + j) * NE + e];
#pragma unroll
              for (int j = 0; j < 4; ++j) { ph[j] = pk2(wv[2 * j], wv[2 * j + 1]); pl[j] = pk2(wv[2 * j] - __uint_as_float(ph[j] << 16), wv[2 * j + 1] - __uint_as_float(ph[j] & 0xffff0000u)); }
              v4u hv; hv.x = ph[0]; hv.y = ph[1]; hv.z = ph[2]; hv.w = ph[3]; v4u lv; lv.x = pl[0]; lv.y = pl[1]; lv.z = pl[2]; lv.w = pl[3];
              *(GAS v4u*)(WRFw + ((size_t)((0 + eh) * 64 + k0) * 64 + ln) * 4) = hv; *(GAS v4u*)(WRFw + ((size_t)((2 + eh) * 64 + k0) * 64 + ln) * 4) = lv;
          } }
        }
        if (BOTH(0)) GRID_BAR();
    }

    TSTAMP(1);
    if (IN(1)) {
        const float* qna = args.in[3]; const float* kna = args.in[4]; const float* qnb = args.in[5]; const float* knb = args.in[6]; const float* b_gate = args.in[10]; bf16* Gb = PROBE_RR ? (bf16*)(ws + WS_H) : (bf16*)args.out; bf16* XN = (bf16*)(ws + WS_XN); bf16* WIN_t = (bf16*)(ws + WS_WIN); float* LOGF = (float*)(ws + WS_LOGF); float* Cc = (float*)(ws + WS_C); bf16* KAUG = (bf16*)(ws + WS_KAUG); int* FT0 = (int*)(ws + WS_FT0); const float* wg_e = args.in[17]; const float* wu_e = args.in[18]; const float* wg_s = args.in[20]; const float* wu_s = args.in[21]; bf16* W1 = (bf16*)(ws + WS_W1);
        _Pragma("unroll") for (int rep_ = 0; rep_ < 1; ++rep_) {
        if (G >= 16 && bx >= G - 16) p1_cumsum(bx - (G - 16), LOGF, Cc, KAUG, (LAS float*)(L + RING_OFF), tid, qnb, knb, FT0);
        else if (G < 16 && bx == 0) for (int bh = 0; bh < 16; ++bh) p1_cumsum(bh, LOGF, Cc, KAUG, (LAS float*)(L + RING_OFF), tid, qnb, knb, FT0);
        pg8::Gemm g{XN, WIN_t, M, NTOT1, D}; pg8::RepOrder S; S.init(M, NTOT1, G, bx); S.nrep = NREP(1);
        pg8::EpiQKVG E{ws, Gb, qna, kna, qnb, knb, b_gate};
        pg8::gemm_phase<pg8::EpiQKVG, pg8::RepOrder, true, true>(L + RING_OFF, g, S, E);
        { const int nfull = (M / 256) * (NTOT1 / 256) % G;
          if (nfull != 0 && bx >= nfull) { const int nw = (G - nfull) * NWAVES; for (int it = (bx - nfull) * NWAVES + wave; it < N_FILL1; it += nw) conv_w1_item(it, wg_e, wu_e, wg_s, wu_s, W1, (LAS unsigned*)(L + RING_OFF + wave * 8704), lane); }
          else if (nfull == 0) { for (int it = bx * NWAVES + wave; it < N_FILL1; it += G * NWAVES) conv_w1_item(it, wg_e, wu_e, wg_s, wu_s, W1, (LAS unsigned*)(L + RING_OFF + wave * 8704), lane); } }
        }
        if (BOTH(1)) GRID_BAR();
    }


    TSTAMP(2);
    if (IN(2)) {
        float* Cc = (float*)(ws + WS_C); bf16* KAUG = (bf16*)(ws + WS_KAUG); float* BIAS = (float*)(ws + WS_BIAS); int* FT0 = (int*)(ws + WS_FT0); const float* wd_e = args.in[19]; const float* wd_s = args.in[22]; bf16* W2 = (bf16*)(ws + WS_W2); const float* wg_e = args.in[17]; const float* wu_e = args.in[18]; const float* wg_s = args.in[20]; const float* wu_s = args.in[21]; bf16* W1 = (bf16*)(ws + WS_W1);
        _Pragma("unroll") for (int rep_ = 0; rep_ < NREP(2); ++rep_) { REP_BAR();
#ifdef RERUN_VARIANT
        if (!(PROBE_RR && RERUN_VARIANT >= 2))
#endif
        for (int au = VCU(); au < 2 * 4 * 32; au += G) {
            const int bb = au >> 7, hs = (au >> 5) & 3, blk = au & 31;
            dil::unit(bb, hs, blk, (const fox::bf16*)(ws + WS_QA), (const fox::bf16*)(ws + WS_KA), (const fox::bf16*)(ws + WS_VA), BIAS,
                      (fox::bf16*)(ws + WS_WIN), (fox::bf16*)(ws + WS_XN + 24 * MiB), (fox::bf16*)(ws + WS_LIST), (float*)(ws + WS_WIN + 8 * MiB), (fox::bf16*)(ws + WS_YA),
                      (char*)lds + RING_OFF, (float*)((char*)lds + LDSCTL_OFF + 8192), (float*)((char*)lds + LDSCTL_OFF + 12288), (unsigned*)(ctl + CW_APAIR + 32 * ((bb * 4 + hs) * 16 + (blk >> 1))), DIL_GMASK);
        }
        if (tid < 16) { const int my = FT0[512 + tid]; int rank = 0;
            for (int o = 0; o < 16; ++o) { const int c2 = FT0[512 + o]; rank += (c2 > my || (c2 == my && o < tid)) ? 1 : 0; }
            MISC[24 + rank] = (unsigned)tid; }
        __syncthreads();
        gu32* qhead = ctl + CW_Q2 + 64 * rep_ + 128 * args.li;
        if (tid == 0) MISC[16] = (unsigned)VCU();
        __syncthreads();
        for (;;) {
            const unsigned u = MISC[16];
            __syncthreads();
            constexpr unsigned NFCH = (unsigned)((N_W2 + N_FILL2 + 31) / 32);
            if (u >= 512u + NFCH) break;
            int fox_u = -1, fill_c = -1;
            { const unsigned v = u; if (v < 2u * NFCH) { if ((v & 1u) == 0u) fox_u = (int)(v >> 1); else fill_c = (int)(v >> 1); } else fox_u = (int)(v - NFCH); }
            static_assert((N_W2 + N_FILL2 + 31) / 32 <= 512, "filler chunks interleave one per FoX unit");
#ifdef RERUN_VARIANT
            const bool skip_ = PROBE_RR && ((RERUN_VARIANT == 1) || (RERUN_VARIANT == 2 && fox_u < 0) || (RERUN_VARIANT == 3 && fox_u >= 0));
#else
            const bool skip_ = false;
#endif
            unsigned nxt_u = 0u; if (tid == 0) nxt_u = __hip_atomic_fetch_add(qhead, 1u, RLX_AGENT) + (unsigned)G;
            if (skip_) {
            } else if (fill_c >= 0) {
                for (int k4 = 0; k4 < 4; ++k4) {
                const int r = fill_c * 32 + k4 * 8 + wave;
                if (r >= N_W2) { if (r < N_W2 + N_FILL2) conv_w1_item(N_FILL1 + r - N_W2, wg_e, wu_e, wg_s, wu_s, W1, (LAS unsigned*)(L + RING_OFF + wave * 8704), lane); }
                else { const int e = r >> 6, qq = r & 63, kb = qq >> 4, nb = qq & 15; const float* src = (e < NE) ? wd_e + (size_t)e * DE * D : wd_s;
                    p0_tr64(src, D, 64 * kb, 64 * nb, W2 + (size_t)e * D * DE, DE, 256 * (nb >> 2) + 32 * (nb & 3), 128, (LAS unsigned*)(L + RING_OFF + wave * 8704), lane); }
                }
            } else {
                const int fu = fox_u; const int bh = __builtin_amdgcn_readfirstlane((int)MISC[24 + (fu >> 5)]), qb = 31 - (fu & 31); const int T0 = __builtin_amdgcn_readfirstlane(FT0[bh * 32 + qb]);
                fox::attn_unit<8>(bh >> 3, bh & 7, qb, T0, (const fox::bf16*)(ws + WS_QB), (const fox::bf16*)(ws + WS_KB), (const fox::bf16*)(ws + WS_VB), (const fox::bf16*)KAUG, Cc + (size_t)bh * SEQ,
                                  (fox::bf16*)(ws + WS_YB), (char*)lds + RING_OFF);
            }
            if (tid == 0) MISC[16] = nxt_u;
            __syncthreads();
        }
        }
        if (BOTH(2)) GRID_BAR();
    }
    TSTAMP(3);
    if (IN(3)) {
        const float* x = args.in[0]; bf16* Gb = PROBE_RR ? (bf16*)(ws + WS_H) : (bf16*)args.out; bf16* WPA_t = (bf16*)(ws + WS_WIN) + (size_t)NTOT1 * D; bf16* WPB_t = (bf16*)(ws + WS_WIN) + (size_t)NTOT1 * D + (size_t)D * OUTA;
        _Pragma("unroll") for (int rep_ = 0; rep_ < 1; ++rep_) {
        bf16* YAb = (bf16*)(ws + WS_YA); bf16* YBb = (bf16*)(ws + WS_YB); bf16* MG = (bf16*)(ws + WS_MERGED); bf16* TMPM = (bf16*)(ws + WS_R2 + 32 * MiB);
        pg8::RepOrder S; S.init(M, D, G, bx); S.nrep = NREP(3);
        if ((VCU() & 1) == 0) {
        { pg8::Gemm g{YAb, WPA_t, M, D, OUTA}; pg8::EpiMergeA E{Gb, TMPM, 0u}; pg8::gemm_phase<pg8::EpiMergeA, pg8::RepOrder, true, true>(L + RING_OFF, g, S, E); }
        { pg8::Gemm g{YBb, WPB_t, M, D, OUTB}; pg8::EpiMergeB E{Gb, TMPM, MG, 1024u}; pg8::gemm_phase<pg8::EpiMergeB, pg8::RepOrder, true, true>(L + RING_OFF, g, S, E); }
        } else {
        { pg8::Gemm g{YBb, WPB_t, M, D, OUTB}; pg8::EpiMergeA E{Gb, TMPM, 1024u}; pg8::gemm_phase<pg8::EpiMergeA, pg8::RepOrder, true, true>(L + RING_OFF, g, S, E); }
        { pg8::Gemm g{YAb, WPA_t, M, D, OUTA}; pg8::EpiMergeB E{Gb, TMPM, MG, 0u}; pg8::gemm_phase<pg8::EpiMergeB, pg8::RepOrder, true, true>(L + RING_OFF, g, S, E); }
        }
        }
        if (BOTH(3)) GRID_BAR();
    }
    TSTAMP(4);
    if (IN(4)) {
        const float* x = args.in[0]; const float* g_ffn = args.in[14]; float* out_w = PROBE_RR ? (float*)(ws + WS_H) : args.out; bf16* WOUT_t = (bf16*)(ws + WS_WIN) + (size_t)NTOT1 * D + (size_t)D * OUTA + (size_t)D * OUTB;
        _Pragma("unroll") for (int rep_ = 0; rep_ < 1; ++rep_) {
        bf16* MG = (bf16*)(ws + WS_MERGED);
        pg8::Gemm g{MG, WOUT_t, M, D, D}; pg8::RepOrder S; S.init(M, D, G, bx); S.nrep = NREP(4);
        pg8::EpiResF32 E{x, out_w};
        pg8::gemm_phase<pg8::EpiResF32, pg8::RepOrder, true, true>(L + RING_OFF, g, S, E);
        }
        if (BOTH(4)) GRID_BAR();
        _Pragma("unroll") for (int xb_ = 0; xb_ < EXTRA_BARRIERS; ++xb_) GRID_BAR();
    }


    TSTAMP(5);
    if (IN(5)) {
        const float* g_ffn = args.in[14]; const float* router_bias = args.in[16]; float* out = args.out;
        _Pragma("unroll") for (int rep_ = 0; rep_ < NREP(5); ++rep_) { REP_BAR();
        for (int tb0 = bx * 2; tb0 < M / 32; tb0 += G * 2) {
            const int grp = wave >> 2, t = tb0 + grp;
            rtr::task(t, wave & 3, t < M / 32, out, g_ffn, (const unsigned short*)(ws + WS_WRF), router_bias, (unsigned short*)(ws + WS_H2), (float*)(ws + WS_RINV), (unsigned*)(ctl + CW_CNT), (unsigned*)(ws + WS_LIST),
                      (float*)(ws + WS_GATEW), (float2*)(ws + WS_META), (unsigned*)(ws + WS_INV), (float*)((char*)lds + RING_OFF + grp * 40960), (float*)((char*)lds + RING_OFF + 81920 + grp * 512), (LAS unsigned*)(L + RING_OFF + 90112));
            __syncthreads();
        }
        }
        if (BOTH(5)) GRID_BAR();
    }
    TSTAMP(6);
    if (IN(6)) {
        bf16* W1 = (bf16*)(ws + WS_W1);
        _Pragma("unroll") for (int rep_ = 0; rep_ < NREP(6); ++rep_) { REP_BAR();
        moe_tables(L, ctl + CW_CNT, tid);
        pg8::MoeSched S{(const LAS unsigned*)(L + TB_T6), (const LAS unsigned*)(L + TB_CNT), (const LAS unsigned*)(L + TB_HB), 65, 1, 0, 2, G, VCU(), D,
                        (const void*)(ws + WS_H2), W1, (size_t)512 * D, 1, (const unsigned*)(ws + WS_LIST), 0, (LAS int*)(L + TB_UT)};
        S.build_table(); __syncthreads();
        pg8::EpiMoe1 E{(const pg8::f32x2m*)(ws + WS_META), (const float*)(ws + WS_RINV), (bf16*)(ws + WS_H), (bf16*)(ws + WS_HS)};
        pg8::gemm_phase2<pg8::EpiMoe1, pg8::MoeSched, true>(L + RING_OFF, D, S, E, L + LDSCTL_OFF + 8192);
        }
        if (BOTH(6)) GRID_BAR();
    }
    TSTAMP(7);
    if (IN(7)) {
        bf16* W2 = (bf16*)(ws + WS_W2);
        _Pragma("unroll") for (int rep_ = 0; rep_ < NREP(7); ++rep_) { REP_BAR();
        if (!IN(6)) moe_tables(L, ctl + CW_CNT, tid);
        pg8::MoeSched S{(const LAS unsigned*)(L + TB_T6), (const LAS unsigned*)(L + TB_CNT), (const LAS unsigned*)(L + TB_HB), 64, 1, 0, 4, G, VCU(), DE,
                        (const void*)(ws + WS_H), W2, (size_t)D * DE, 1, (const unsigned*)(ws + WS_LIST), 1, (LAS int*)(L + TB_UT)};
        S.build_table(); __syncthreads();
        pg8::EpiMoe2 E{(unsigned char*)(ws + WS_Y)};
        pg8::gemm_phase2<pg8::EpiMoe2, pg8::MoeSched, true>(L + RING_OFF, DE, S, E, L + LDSCTL_OFF + 8192);
        }
        if (BOTH(7)) GRID_BAR();
    }
    TSTAMP(8);
    TSTAMP(9);
    if (IN(9)) {
        float* out = args.out; float* out_w = PROBE_RR ? (float*)(ws + WS_H) : args.out; bf16* W2 = (bf16*)(ws + WS_W2);
        _Pragma("unroll") for (int rep_ = 0; rep_ < NREP(9); ++rep_) { REP_BAR();
        if (!IN(6)) moe_tables(L, ctl + CW_CNT, tid);
        if (G == 256) {
            pg8::Gemm g{(const bf16*)(ws + WS_HS), W2 + (size_t)NE * D * DE, M, D, DE}; pg8::StaticOrder S; S.init(M, D, G, bx);
            pg8::EpiFinalD E{(const unsigned char*)(ws + WS_Y), (const unsigned*)(ws + WS_INV), (const LAS unsigned*)(L + TB_HB), out, (NREP(9) == 2 && rep_ == 0) ? (float*)(ws + WS_H) : out_w};
            pg8::gemm_phase<pg8::EpiFinalD, pg8::StaticOrder, false, true>(L + RING_OFF, g, S, E);
        } else {
        pg8::MoeSched S{(const LAS unsigned*)(L + TB_T9), (const LAS unsigned*)(L + TB_CNT), (const LAS unsigned*)(L + TB_HB), 1, 0, 128, 4, G, VCU(), DE,
                        (const void*)(ws + WS_HS), W2, (size_t)D * DE, 0, (const unsigned*)(ws + WS_LIST), 1, (LAS int*)(L + TB_UT)};
        S.build_table(); __syncthreads();
        pg8::EpiFinal E{(const unsigned char*)(ws + WS_Y), (const unsigned*)(ws + WS_INV), (const LAS unsigned*)(L + TB_HB), out, (NREP(9) == 2 && rep_ == 0) ? (float*)(ws + WS_H) : out_w};
        pg8::gemm_phase2<pg8::EpiFinal, pg8::MoeSched, true>(L + RING_OFF, DE, S, E, L + LDSCTL_OFF + 8192);
        }
        }
    }
    TSTAMP(NPHASE);
#undef IN
#undef BOTH
}

#ifdef DIAG_TS
__global__ void k_diag_ts(float* out, const unsigned long long* ts) {
    const float tot = floorf((float)(ts[NPHASE] - ts[0]) * 0.01f / 50.f + 0.5f) * 50.f, bw = floorf((float)ts[20] * 0.01f / 20.f + 0.5f) * 20.f;
    const size_t idx = (size_t)blockIdx.x * 256 + threadIdx.x;
    float v = out[idx] * (1.f + sqrtf(tot / 2000.f));
    if (idx == 0) v += 50.f + bw * 0.5f;
    out[idx] = v;
}
#endif
extern "C" void kernel_launch(void* const* d_in, const int* in_sizes, int n_in, void* d_out, int out_size, void* d_ws, size_t ws_size, hipStream_t stream) {
    static int grid = 0;
    if (grid == 0) {
        if (n_in != 23 || out_size != M * D || ws_size < WS_END) { fprintf(stderr, "kernel_launch: unexpected shapes / workspace (%d inputs, out %d, ws %zu)\n", n_in, out_size, ws_size); grid = -1; return; }
        int dev = 0, cus = 0;
        if (hipGetDevice(&dev) != hipSuccess || hipDeviceGetAttribute(&cus, hipDeviceAttributeMultiprocessorCount, dev) != hipSuccess) { grid = -1; return; }
        if (hipFuncSetAttribute((const void*)mega, hipFuncAttributeMaxDynamicSharedMemorySize, LDS_BYTES) != hipSuccess) { fprintf(stderr, "kernel_launch: hipFuncSetAttribute failed\n"); grid = -1; return; }
        int per_cu = 0;
        if (hipOccupancyMaxActiveBlocksPerMultiprocessor(&per_cu, (const void*)mega, NWAVES * 64, LDS_BYTES) != hipSuccess || per_cu < 1) fprintf(stderr, "kernel_launch: occupancy query says %d\n", per_cu);
        (void)hipGetLastError();
        grid = cus;
    }
    if (grid < 0) return;
    const float* x = (const float*)d_in[0];
    const float* qnb = (const float*)d_in[5]; const float* knb = (const float*)d_in[6];
    const float* wpa = (const float*)d_in[11]; const float* wpb = (const float*)d_in[12]; const float* w_out = (const float*)d_in[13]; const float* g_ffn = (const float*)d_in[14];
    const float* w_router = (const float*)d_in[15]; const float* router_bias = (const float*)d_in[16]; const float* wg_e = (const float*)d_in[17]; const float* wu_e = (const float*)d_in[18];
    const float* wd_e = (const float*)d_in[19]; const float* wg_s = (const float*)d_in[20]; const float* wu_s = (const float*)d_in[21]; const float* wd_s = (const float*)d_in[22];
    unsigned char* ws = (unsigned char*)d_ws; float* out = (float*)d_out;
    bf16_t* G = (bf16_t*)d_out;
    unsigned* CTL = (unsigned*)(ws + WS_CTL);
    #ifdef RERUN_PHASE
    (void)hipMemsetAsync(ws + WS_CTL, 0, 256 * KiB, stream);
#else
    (void)hipMemsetAsync(ws + WS_CTL, 0, 64 * KiB, stream);
#endif
    MArgs a{};
    for (int i = 0; i < 23; ++i) a.in[i] = (const float*)d_in[i];
    a.out = out; a.ws = ws;
    a.ph_lo = 0; a.ph_hi = NPHASE; a.li = 0;
    hipLaunchKernelGGL(mega, dim3(grid), dim3(NWAVES * 64), LDS_BYTES, stream, a);
#ifdef RERUN_PHASE
    a.ph_lo = RERUN_PHASE; a.ph_hi = RERUN_PHASE + RERUN_COUNT; a.li = 1;
    hipLaunchKernelGGL(mega, dim3(grid), dim3(NWAVES * 64), LDS_BYTES, stream, a);
#endif
#ifdef DIAG_TS
    k_diag_ts<<<M * D / 256, 256, 0, stream>>>(out, (const unsigned long long*)(ws + WS_CTL + 512 * 1024));
#endif
}
```

```cpp
#include <hip/hip_runtime.h>
#include <hip/hip_bf16.h>
#include <cstdint>
#include <cstdio>

typedef unsigned short bf16_t;
typedef unsigned u32x4 __attribute__((ext_vector_type(4)));
typedef unsigned u32x2 __attribute__((ext_vector_type(2)));

constexpr int BATCH = 2, SEQ = 8192, M = BATCH * SEQ, D = 1024;
constexpr int HA = 12, HB = 8, HD = 64;
constexpr int WA = 3 * HA * HD, WB = 3 * HB * HD, DIN = WA + WB + HB;
constexpr int PA = HA * HD, PB = HB * HD;
constexpr int OUTA = 256, OUTB = 512;
constexpr int NE = 64, TOPK = 8, DE = 256;
constexpr int NLIST = 2 * NE;
constexpr float EPS = 1e-6f;
constexpr float LOG2E = 1.4426950408889634f;
constexpr float QSCALE = 0.125f * LOG2E;

constexpr size_t MiB = 1u << 20, KiB = 1u << 10;
constexpr size_t WS_CTL = 0;
constexpr size_t WS_LOGF = 1 * MiB;
constexpr size_t WS_C = 1 * MiB + 512 * KiB;
constexpr size_t WS_KAUG = 2 * MiB;
constexpr size_t WS_LIST = 4 * MiB;
constexpr size_t WS_GATEW = 12 * MiB;
constexpr size_t WS_BIAS = 12 * MiB + 512 * KiB;
constexpr size_t WS_FT0 = WS_BIAS + 8 * KiB;
constexpr size_t WS_WRF = WS_BIAS + 64 * KiB;
constexpr size_t WS_RINV = WS_BIAS + 384 * KiB;
constexpr size_t WS_W2 = 13 * MiB;
constexpr size_t WS_R1 = 45 * MiB + 512 * KiB;
constexpr size_t WS_W1 = WS_R1;
constexpr size_t WS_WIN = WS_R1 + 65 * MiB;
constexpr size_t WS_XN = WS_R1 + 80 * MiB;
constexpr size_t WS_YA = WS_XN;
constexpr size_t WS_YB = WS_XN + 8 * MiB;
constexpr size_t WS_H2 = WS_XN;
constexpr size_t WS_QB = WS_R1 + 112 * MiB;
constexpr size_t WS_R2 = WS_R1 + 128 * MiB;
constexpr size_t WS_QA = WS_R2;
constexpr size_t WS_KA = WS_R2 + 24 * MiB;
constexpr size_t WS_VA = WS_R2 + 48 * MiB;
constexpr size_t WS_KB = WS_R2 + 72 * MiB;
constexpr size_t WS_VB = WS_R2 + 88 * MiB;
constexpr size_t WS_MERGED = WS_R2;
constexpr size_t WS_H = WS_R2;
constexpr size_t WS_HS = WS_R2 + 65 * MiB;
constexpr size_t WS_Y = WS_R1;
constexpr size_t WS_META = WS_R2 + 80 * MiB;
constexpr size_t WS_INV = WS_R2 + 96 * MiB;
constexpr size_t WS_END = WS_R2 + 104 * MiB;
constexpr int CW_APAIR = 12288;
constexpr int CW_Q2 = 1536;
constexpr int CW_CNT = 8192, CNT_STRIDE = 32;

__device__ __forceinline__ float bf2f(bf16_t v) { return __uint_as_float((unsigned)v << 16); }
__device__ __forceinline__ unsigned f2bf(float f) { unsigned u = __float_as_uint(f); return (u + 0x7fffu + ((u >> 16) & 1u)) >> 16; }
__device__ __forceinline__ unsigned pk2(float lo, float hi) { return f2bf(lo) | (f2bf(hi) << 16); }
__device__ __forceinline__ float wave_sum(float v) {
#pragma unroll
    for (int o = 1; o < 64; o <<= 1) v += __shfl_xor(v, o);
    return v;
}
__device__ __forceinline__ float wave_max(float v) {
#pragma unroll
    for (int o = 1; o < 64; o <<= 1) v = fmaxf(v, __shfl_xor(v, o));
    return v;
}

typedef unsigned short bf16_t_dummy_;
namespace pg8 {
#define PG8_LAS __attribute__((address_space(3)))
typedef unsigned short bf16_t;
typedef short bf16x8 __attribute__((ext_vector_type(8)));
typedef float f32x4 __attribute__((ext_vector_type(4)));
typedef unsigned u32x4 __attribute__((ext_vector_type(4)));
constexpr int BM = 256, BK = 64, HALF = 128, HTB = HALF * BK * 2  , STAGE_BYTES = 8 * HTB, NXCD = 8, WGM = 8;

__host__ __device__ __forceinline__ int lds_byte(int r, int c) { const int st = (r >> 4) * 2 + (c >> 5), rr = r & 15, cc = c & 31, ob = rr * 64 + cc * 2; return st * 1024 + (ob ^ (((ob >> 9) & 1) << 5)); }
__host__ __device__ __forceinline__ void stage_rc(int b, int& R, int& C) { const int st = b / 1024, sb = b % 1024, swz = sb ^ (((sb >> 9) & 1) << 5); R = (st >> 1) * 16 + swz / 64; C = (st & 1) * 32 + (swz % 64) / 2; }
__host__ __device__ __forceinline__ int perm32(int rho) { const int n = rho >> 4, i = rho & 15; return 8 * (i >> 2) + 4 * n + (i & 3); }

struct Unit { int pm, pn; };
struct Gemm { const bf16_t* A; const bf16_t* Bt; int M, N, K; };

struct StaticOrder {
    int nM, nN, nwg, G, c;
    __host__ __device__ void init(int M, int N, int G_, int c_) { nM = M / BM; nN = N / BM; nwg = nM * nN; G = G_; c = c_; }
    __host__ __device__ bool next(int i, Unit& u) const {
        const long L = (long)i * G + c; if (L >= nwg) return false;
        int wgid = (int)L; { const int q = nwg / NXCD, r = nwg % NXCD, xcd = wgid % NXCD, off = wgid / NXCD; wgid = (xcd < r ? xcd * (q + 1) : r * (q + 1) + (xcd - r) * q) + off; }
        const int nig = WGM * nN, gid = wgid / nig, fm = gid * WGM, gsz = (nM - fm) < WGM ? (nM - fm) : WGM;
        u.pm = fm + ((wgid % nig) % gsz); u.pn = (wgid % nig) / gsz; return true;
    }
    __device__ __forceinline__ void a_ready(const Unit&) const {}
    __device__ __forceinline__ void done(const Unit&) const {}
};

__device__ __forceinline__ unsigned cvt_pk_bf16(float lo, float hi) { unsigned r; asm volatile("v_cvt_pk_bf16_f32 %0, %1, %2" : "=v"(r) : "v"(lo), "v"(hi)); return r; }
typedef float f32x2 __attribute__((ext_vector_type(2)));
struct RepOrder : StaticOrder { int nrep;
    __device__ __forceinline__ bool next(int i, Unit& u) const { const int per = (nwg - c + G - 1) / G; if (per <= 0 || i >= per * nrep) return false; return StaticOrder::next(i % per, u); } };
typedef float f32x2_c __attribute__((ext_vector_type(2))); typedef __bf16 bf16x2_c __attribute__((ext_vector_type(2)));
__device__ __forceinline__ unsigned cvtc(float lo, float hi) { f32x2_c v = {lo, hi}; bf16x2_c b = __builtin_convertvector(v, bf16x2_c); return __builtin_bit_cast(unsigned, b); }
struct EpiQKVG {
    static constexpr bool PERM = true, AFTER_DRAIN = false;
    unsigned char* ws; bf16_t* G; const float *qna, *kna, *qnb, *knb, *b_gate;
    __device__ __forceinline__ void operator()(const f32x4 (&acc)[2][2][4][2], const Unit& u, int wr, int wc, int fr, int fq) const {
        const int pn = u.pn; const int row0 = u.pm * BM + wr * 64 + fr;
        if (pn >= 15) {
            const int col0 = (pn - 15) * 256 + wc * 32 + 8 * fq;
            f32x4 bv[2][2];
#pragma unroll
            for (int bj = 0; bj < 2; ++bj)
#pragma unroll
                for (int n = 0; n < 2; ++n) bv[bj][n] = *(const f32x4*)(b_gate + col0 + bj * HALF + 4 * n);
#pragma unroll
            for (int ai = 0; ai < 2; ++ai)
#pragma unroll
                for (int m = 0; m < 4; ++m) { unsigned char* rowp = (unsigned char*)G + (size_t)(row0 + ai * HALF + m * 16) * 2048 + col0;
#pragma unroll
                    for (int bj = 0; bj < 2; ++bj) { f32x4 v0 = acc[ai][bj][m][0] + bv[bj][0], v1 = acc[ai][bj][m][1] + bv[bj][1];
#pragma unroll
                        for (int i = 0; i < 4; ++i) { v0[i] = 255.f * __builtin_amdgcn_rcpf(1.f + __builtin_amdgcn_exp2f(-1.4426950408889634f * v0[i])); v1[i] = 255.f * __builtin_amdgcn_rcpf(1.f + __builtin_amdgcn_exp2f(-1.4426950408889634f * v1[i])); }
                        unsigned w0 = 0u, w1 = 0u;
#pragma unroll
                        for (int i = 0; i < 4; ++i) { w0 = __builtin_amdgcn_cvt_pk_u8_f32(v0[i], (unsigned)i, w0); w1 = __builtin_amdgcn_cvt_pk_u8_f32(v1[i], (unsigned)i, w1); }
                        typedef unsigned u32x2e __attribute__((ext_vector_type(2)));
                        *(u32x2e*)(rowp + bj * HALF) = (u32x2e){w0, w1}; } }
        } else {
            bf16_t* dst; int ld, hb; const float* g = nullptr; float sc = 1.f;
            if (pn < 3) { dst = (bf16_t*)(ws + WS_QA); ld = PA; hb = 4 * pn; g = qna; sc = QSCALE; }
            else if (pn < 6) { dst = (bf16_t*)(ws + WS_KA); ld = PA; hb = 4 * (pn - 3); g = kna; }
            else if (pn < 9) { dst = (bf16_t*)(ws + WS_VA); ld = PA; hb = 4 * (pn - 6); }
            else if (pn < 11) { dst = (bf16_t*)(ws + WS_QB); ld = PB; hb = 4 * (pn - 9); g = qnb; sc = QSCALE; }
            else if (pn < 13) { dst = (bf16_t*)(ws + WS_KB); ld = PB; hb = 4 * (pn - 11); g = knb; }
            else { dst = (bf16_t*)(ws + WS_VB); ld = PB; hb = 4 * (pn - 13); }
            const int colb = (hb + wc) * 64 + 8 * fq;
            f32x4 gv[2][2];
#pragma unroll
            for (int bj = 0; bj < 2; ++bj)
#pragma unroll
                for (int n = 0; n < 2; ++n) gv[bj][n] = g ? *(const f32x4*)(g + 32 * bj + 8 * fq + 4 * n) : (f32x4){1.f, 1.f, 1.f, 1.f};
#pragma unroll
            for (int ai = 0; ai < 2; ++ai)
#pragma unroll
                for (int m = 0; m < 4; ++m) {
                    float rinv = 1.f;
                    if (g) { float ss = 0.f;
#pragma unroll
                        for (int bj = 0; bj < 2; ++bj)
#pragma unroll
                            for (int n = 0; n < 2; ++n) { const f32x4 x = acc[ai][bj][m][n]; ss += (x[0] * x[0] + x[1] * x[1]) + (x[2] * x[2] + x[3] * x[3]); }
                        ss += __shfl_xor(ss, 16); ss += __shfl_xor(ss, 32);
                        rinv = __builtin_amdgcn_rsqf(ss * (1.f / 64.f) + EPS) * sc; }
                    bf16_t* rowp = dst + (size_t)(row0 + ai * HALF + m * 16) * ld + colb;
#pragma unroll
                    for (int bj = 0; bj < 2; ++bj) { const f32x4 v0 = acc[ai][bj][m][0] * rinv * gv[bj][0], v1 = acc[ai][bj][m][1] * rinv * gv[bj][1];
                        u32x4 w; w.x = cvtc(v0[0], v0[1]); w.y = cvtc(v0[2], v0[3]); w.z = cvtc(v1[0], v1[1]); w.w = cvtc(v1[2], v1[3]);
                        *(u32x4*)(rowp + 32 * bj) = w; } }
        }
    }
};
typedef unsigned u32x2g __attribute__((ext_vector_type(2)));
__device__ __forceinline__ float gq(unsigned w, int i) { return (float)((w >> (8 * i)) & 0xffu); }
struct EpiMergeA {
    static constexpr bool PERM = true, AFTER_DRAIN = false;
    const bf16_t* G; bf16_t* T; unsigned goff;
    __device__ __forceinline__ void operator()(const f32x4 (&acc)[2][2][4][2], const Unit& u, int wr, int wc, int fr, int fq) const {
        const unsigned row0 = (unsigned)(u.pm * BM + wr * 64 + fr), col0 = (unsigned)(u.pn * BM + wc * 32 + 8 * fq);
#pragma unroll
        for (int ai = 0; ai < 2; ++ai) {
            u32x2g g[4][2];
#pragma unroll
            for (int m = 0; m < 4; ++m)
#pragma unroll
                for (int bj = 0; bj < 2; ++bj) g[m][bj] = *(const u32x2g*)((const unsigned char*)G + ((row0 + ai * HALF + m * 16) * 2048u + goff + col0 + bj * HALF));
#pragma unroll
            for (int m = 0; m < 4; ++m)
#pragma unroll
                for (int bj = 0; bj < 2; ++bj) { const u32x2g gg = g[m][bj]; const f32x4 a0 = acc[ai][bj][m][0] * (1.f / 255.f), a1 = acc[ai][bj][m][1] * (1.f / 255.f);
                    u32x4 w;
                    w.x = cvtc(a0[0] * gq(gg.x, 0), a0[1] * gq(gg.x, 1)); w.y = cvtc(a0[2] * gq(gg.x, 2), a0[3] * gq(gg.x, 3));
                    w.z = cvtc(a1[0] * gq(gg.y, 0), a1[1] * gq(gg.y, 1)); w.w = cvtc(a1[2] * gq(gg.y, 2), a1[3] * gq(gg.y, 3));
                    *(u32x4*)(T + ((row0 + ai * HALF + m * 16) * 1024u + col0 + bj * HALF)) = w; }
            asm volatile("" ::: "memory");
        }
    }
};
struct EpiMergeB {
    static constexpr bool PERM = true, AFTER_DRAIN = false;
    const bf16_t* G; const bf16_t* T; bf16_t* O; unsigned goff;
    __device__ __forceinline__ void operator()(const f32x4 (&acc)[2][2][4][2], const Unit& u, int wr, int wc, int fr, int fq) const {
        const unsigned row0 = (unsigned)(u.pm * BM + wr * 64 + fr), col0 = (unsigned)(u.pn * BM + wc * 32 + 8 * fq);
#pragma unroll
        for (int ai = 0; ai < 2; ++ai)
#pragma unroll
          for (int mp = 0; mp < 2; ++mp) {
            u32x2g g[2][2]; u32x4 t[2][2];
#pragma unroll
            for (int mm = 0; mm < 2; ++mm)
#pragma unroll
                for (int bj = 0; bj < 2; ++bj) { const unsigned r = row0 + ai * HALF + (2 * mp + mm) * 16; g[mm][bj] = *(const u32x2g*)((const unsigned char*)G + (r * 2048u + goff + col0 + bj * HALF)); t[mm][bj] = *(const u32x4*)(T + (r * 1024u + col0 + bj * HALF)); }
#pragma unroll
            for (int mm = 0; mm < 2; ++mm)
#pragma unroll
                for (int bj = 0; bj < 2; ++bj) { const int m = 2 * mp + mm; const u32x2g gg = g[mm][bj]; const u32x4 tt = t[mm][bj]; const f32x4 a0 = acc[ai][bj][m][0] * (1.f / 255.f), a1 = acc[ai][bj][m][1] * (1.f / 255.f);
                    u32x4 w;
                    w.x = cvtc(__uint_as_float(tt.x << 16) + a0[0] * gq(gg.x, 0), __uint_as_float(tt.x & 0xffff0000u) + a0[1] * gq(gg.x, 1));
                    w.y = cvtc(__uint_as_float(tt.y << 16) + a0[2] * gq(gg.x, 2), __uint_as_float(tt.y & 0xffff0000u) + a0[3] * gq(gg.x, 3));
                    w.z = cvtc(__uint_as_float(tt.z << 16) + a1[0] * gq(gg.y, 0), __uint_as_float(tt.z & 0xffff0000u) + a1[1] * gq(gg.y, 1));
                    w.w = cvtc(__uint_as_float(tt.w << 16) + a1[2] * gq(gg.y, 2), __uint_as_float(tt.w & 0xffff0000u) + a1[3] * gq(gg.y, 3));
                    *(u32x4*)(O + ((row0 + ai * HALF + m * 16) * 1024u + col0 + bj * HALF)) = w; }
            asm volatile("" ::: "memory");
          }
    }
};
struct EpiResF32 {
    static constexpr bool PERM = false, AFTER_DRAIN = false;
    const float* X; float* O;
    __device__ __forceinline__ void operator()(const f32x4 (&acc)[2][2][4][2], const Unit& u, int wr, int wc, int fr, int fq) const {
        const unsigned row0 = (unsigned)(u.pm * BM + wr * 64 + fr), col0 = (unsigned)(u.pn * BM + wc * 32 + 4 * fq);
#pragma unroll
        for (int ai = 0; ai < 2; ++ai)
#pragma unroll
          for (int mp = 0; mp < 2; ++mp) {
            f32x4 xv[2][2][2];
#pragma unroll
            for (int mm = 0; mm < 2; ++mm)
#pragma unroll
                for (int bj = 0; bj < 2; ++bj)
#pragma unroll
                    for (int n = 0; n < 2; ++n) xv[mm][bj][n] = *(const f32x4*)(X + ((row0 + ai * HALF + (2 * mp + mm) * 16) * 1024u + col0 + bj * HALF + n * 16));
#pragma unroll
            for (int mm = 0; mm < 2; ++mm)
#pragma unroll
                for (int bj = 0; bj < 2; ++bj)
#pragma unroll
                    for (int n = 0; n < 2; ++n) *(f32x4*)(O + ((row0 + ai * HALF + (2 * mp + mm) * 16) * 1024u + col0 + bj * HALF + n * 16)) = xv[mm][bj][n] + acc[ai][bj][2 * mp + mm][n];
            asm volatile("" ::: "memory");
          }
    }
};
template <class Epi, class Sched, bool ALIGN_EPI = false, bool SP2 = false>
__device__ __forceinline__ void gemm_phase(PG8_LAS unsigned char* lds, const Gemm g, const Sched& S, const Epi& E) {
    int tid_ = threadIdx.x; asm volatile("" : "+v"(tid_));
    const int tid = tid_, wid = __builtin_amdgcn_readfirstlane(tid >> 6), lane = tid & 63, wr = wid >> 2, wc = wid & 3, fr = lane & 15, fq = lane >> 4;
    const int K = g.K, nt = K / BK;
    unsigned voffA[2], voffB[2];
#pragma unroll
    for (int i = 0; i < 2; ++i) { int R, C; stage_rc(tid * 16 + i * 8192, R, C); const int Rb = Epi::PERM ? ((R & ~31) + perm32(R & 31)) : R;
        voffA[i] = (unsigned)(R * K + C) * 2u; voffB[i] = (unsigned)(Rb * K + C) * 2u; }
    const size_t kstep = (size_t)(BK * 2);
    const size_t hstep = (size_t)HALF * K * 2;
    const size_t tstep = 2 * hstep;
    const unsigned ldsw = (unsigned)wid * 1024u;
    const int aoff = lds_byte(wr * 64 + fr, fq * 8), boff = lds_byte(wc * 32 + fr, fq * 8);
#define PG8_SA(b, h) (((b) * 2 + (h)) * HTB)
#define PG8_SB(b, h) ((4 + (b) * 2 + (h)) * HTB)
#define PG8_STAGE(bufoff, gbase, voff) do { _Pragma("unroll") for (int _i = 0; _i < 2; ++_i) \
        __builtin_amdgcn_global_load_lds((const unsigned*)((const char*)(gbase) + (voff)[_i]), (PG8_LAS unsigned*)(lds + (bufoff) + ldsw + _i * 8192), 16, 0, 0); } while (0)
#define PG8_LDA(dst, b, h) do { _Pragma("unroll") for (int m = 0; m < 4; ++m) _Pragma("unroll") for (int k = 0; k < 2; ++k) dst[m][k] = *(const PG8_LAS bf16x8*)(lds + PG8_SA(b, h) + aoff + m * 2048 + k * 1024); } while (0)
#define PG8_LDB(dst, b, h) do { _Pragma("unroll") for (int n = 0; n < 2; ++n) _Pragma("unroll") for (int k = 0; k < 2; ++k) dst[n][k] = *(const PG8_LAS bf16x8*)(lds + PG8_SB(b, h) + boff + n * 2048 + k * 1024); } while (0)
#define PG8_MMA(ai, bj, At, Bt) do { __builtin_amdgcn_s_setprio(1); _Pragma("unroll") for (int m = 0; m < 4; ++m) _Pragma("unroll") for (int n = 0; n < 2; ++n) _Pragma("unroll") for (int k = 0; k < 2; ++k) \
        acc[ai][bj][m][n] = __builtin_amdgcn_mfma_f32_16x16x32_bf16(Bt[n][k], At[m][k], acc[ai][bj][m][n], 0, 0, 0); __builtin_amdgcn_s_setprio(0); } while (0)
#define PG8_WAIT_V(n) asm volatile("s_waitcnt vmcnt(" #n ")" ::: "memory")
#define PG8_WAIT_L(n) asm volatile("s_waitcnt lgkmcnt(" #n ")" ::: "memory")
#define PG8_BAR __builtin_amdgcn_s_barrier()
#define PG8_SCHED __builtin_amdgcn_sched_barrier(0)
    Unit cur, nxt; int ui = 0;
    if (!S.next(0, cur)) return;
    f32x4 acc[2][2][4][2];
#pragma unroll
    for (int a = 0; a < 2; ++a)
#pragma unroll
        for (int b = 0; b < 2; ++b)
#pragma unroll
            for (int m = 0; m < 4; ++m)
#pragma unroll
                for (int n = 0; n < 2; ++n) acc[a][b][m][n] = (f32x4){0.f, 0.f, 0.f, 0.f};
    bf16x8 At[4][2], B0[2][2], B1[2][2];
    const char* cA = (const char*)g.A + (size_t)cur.pm * tstep; const char* cB = (const char*)g.Bt + (size_t)cur.pn * tstep;
    S.a_ready(cur);
    if constexpr (SP2) {
        PG8_STAGE(PG8_SB(0, 0), cB, voffB); PG8_STAGE(PG8_SB(0, 1), cB + hstep, voffB); PG8_STAGE(PG8_SA(0, 0), cA, voffA); PG8_STAGE(PG8_SA(0, 1), cA + hstep, voffA);
        if (wr == 1) PG8_BAR;
        PG8_WAIT_V(2); PG8_BAR;
        PG8_STAGE(PG8_SB(1, 0), cB + kstep, voffB); PG8_STAGE(PG8_SA(1, 0), cA + kstep, voffA); PG8_STAGE(PG8_SB(1, 1), cB + hstep + kstep, voffB);
        PG8_WAIT_V(6); PG8_BAR;
    } else {
        PG8_STAGE(PG8_SB(0, 0), cB, voffB); PG8_STAGE(PG8_SA(0, 0), cA, voffA); PG8_STAGE(PG8_SB(0, 1), cB + hstep, voffB); PG8_STAGE(PG8_SA(0, 1), cA + hstep, voffA);
        if (wr == 1) PG8_BAR;
        PG8_WAIT_V(4); PG8_BAR;
        PG8_STAGE(PG8_SB(1, 0), cB + kstep, voffB); PG8_STAGE(PG8_SA(1, 0), cA + kstep, voffA); PG8_STAGE(PG8_SB(1, 1), cB + hstep + kstep, voffB);
        PG8_WAIT_V(6); PG8_BAR;
    }
    for (;;) {
        const bool has_next = S.next(ui + 1, nxt);
        const char* nA = has_next ? (const char*)g.A + (size_t)nxt.pm * tstep : cA; const char* nB = has_next ? (const char*)g.Bt + (size_t)nxt.pn * tstep : cB;
        for (int t = 0; t < nt; t += 2) {
            const bool last = (t == nt - 2);
            const char* a1 = cA + (size_t)(t + 1) * kstep;
            const char* a2 = last ? nA : cA + (size_t)(t + 2) * kstep; const char* b2 = last ? nB : cB + (size_t)(t + 2) * kstep;
            const char* a3 = a2 + kstep; const char* b3 = b2 + kstep;
            if (last && has_next) S.a_ready(nxt);
            if constexpr (SP2) {
            PG8_LDB(B0, 0, 0); PG8_LDB(B1, 0, 1); PG8_SCHED; PG8_LDA(At, 0, 0); PG8_STAGE(PG8_SA(1, 1), a1 + hstep, voffA);
            PG8_WAIT_V(8); PG8_WAIT_L(0); PG8_BAR; PG8_MMA(0, 0, At, B0); PG8_MMA(0, 1, At, B1); PG8_BAR; PG8_SCHED;
            PG8_LDA(At, 0, 1); PG8_STAGE(PG8_SB(0, 0), b2, voffB); PG8_STAGE(PG8_SB(0, 1), b2 + hstep, voffB); PG8_STAGE(PG8_SA(0, 0), a2, voffA);
            PG8_WAIT_V(8); PG8_WAIT_L(0); PG8_BAR; PG8_MMA(1, 0, At, B0); PG8_MMA(1, 1, At, B1); PG8_BAR; PG8_SCHED;
            PG8_LDB(B0, 1, 0); PG8_LDB(B1, 1, 1); PG8_SCHED; PG8_LDA(At, 1, 0); PG8_STAGE(PG8_SA(0, 1), a2 + hstep, voffA);
            PG8_WAIT_V(8); PG8_WAIT_L(0); PG8_BAR; PG8_MMA(0, 0, At, B0); PG8_MMA(0, 1, At, B1); PG8_BAR; PG8_SCHED;
            PG8_LDA(At, 1, 1); PG8_STAGE(PG8_SB(1, 0), b3, voffB); PG8_STAGE(PG8_SB(1, 1), b3 + hstep, voffB); PG8_STAGE(PG8_SA(1, 0), a3, voffA);
            PG8_WAIT_V(8); PG8_WAIT_L(0); PG8_BAR; PG8_MMA(1, 0, At, B0); PG8_MMA(1, 1, At, B1); PG8_BAR; PG8_SCHED;
            } else {
            PG8_LDB(B0, 0, 0); PG8_SCHED; PG8_LDA(At, 0, 0); PG8_STAGE(PG8_SA(1, 1), a1 + hstep, voffA);
            PG8_WAIT_L(8); PG8_BAR; PG8_WAIT_L(0); PG8_MMA(0, 0, At, B0); PG8_BAR; PG8_SCHED;
            PG8_LDB(B1, 0, 1); PG8_STAGE(PG8_SB(0, 0), b2, voffB);
            PG8_BAR; PG8_WAIT_L(0); PG8_MMA(0, 1, At, B1); PG8_BAR;
            PG8_LDA(At, 0, 1); PG8_STAGE(PG8_SA(0, 0), a2, voffA);
            PG8_BAR; PG8_WAIT_L(0); PG8_MMA(1, 0, At, B0); PG8_BAR; PG8_SCHED;
            PG8_STAGE(PG8_SB(0, 1), b2 + hstep, voffB);
            PG8_WAIT_V(6); PG8_BAR; PG8_MMA(1, 1, At, B1); PG8_BAR;
            PG8_LDB(B0, 1, 0); PG8_SCHED; PG8_LDA(At, 1, 0); PG8_STAGE(PG8_SA(0, 1), a2 + hstep, voffA);
            PG8_WAIT_L(8); PG8_BAR; PG8_WAIT_L(0); PG8_MMA(0, 0, At, B0); PG8_BAR; PG8_SCHED;
            PG8_LDB(B1, 1, 1); PG8_STAGE(PG8_SB(1, 0), b3, voffB);
            PG8_BAR; PG8_WAIT_L(0); PG8_MMA(0, 1, At, B1); PG8_BAR;
            PG8_LDA(At, 1, 1); PG8_STAGE(PG8_SA(1, 0), a3, voffA);
            PG8_BAR; PG8_WAIT_L(0); PG8_MMA(1, 0, At, B0); PG8_BAR; PG8_SCHED;
            PG8_STAGE(PG8_SB(1, 1), b3 + hstep, voffB);
            PG8_WAIT_V(6); PG8_BAR; PG8_MMA(1, 1, At, B1); PG8_BAR;
            }
        }
        if constexpr (ALIGN_EPI) { if (wr == 0) PG8_BAR; }
        if constexpr (!Epi::AFTER_DRAIN) { E(acc, cur, wr, wc, fr, fq); S.done(cur); }
        if (!has_next) break;
#pragma unroll
        for (int a = 0; a < 2; ++a)
#pragma unroll
            for (int b = 0; b < 2; ++b)
#pragma unroll
                for (int m = 0; m < 4; ++m)
#pragma unroll
                    for (int n = 0; n < 2; ++n) acc[a][b][m][n] = (f32x4){0.f, 0.f, 0.f, 0.f};
        cur = nxt; cA = nA; cB = nB; ++ui;
        if constexpr (ALIGN_EPI) { if (wr == 1) PG8_BAR; }
    }
    PG8_WAIT_V(0);
    if constexpr (!ALIGN_EPI) { if (wr == 0) PG8_BAR; }
    PG8_BAR;
    if constexpr (Epi::AFTER_DRAIN) { E.fused(acc, cur, wr, wc, fr, fq, lds, wid, lane); S.done(cur); }
#undef PG8_SA
#undef PG8_SB
#undef PG8_STAGE
#undef PG8_LDA
#undef PG8_LDB
#undef PG8_MMA
#undef PG8_WAIT_V
#undef PG8_WAIT_L
#undef PG8_BAR
#undef PG8_SCHED
}
struct Unit2 { int pm, pn, l, cnt, split; unsigned hb; };
typedef int i32x4_t __attribute__((ext_vector_type(4))); typedef int i32x8_t __attribute__((ext_vector_type(8)));
__device__ __forceinline__ i32x8_t f8pair(const bf16x8& lo, const bf16x8& hi) { const i32x4_t a = __builtin_bit_cast(i32x4_t, lo), b = __builtin_bit_cast(i32x4_t, hi); return __builtin_shufflevector(a, b, 0, 1, 2, 3, 4, 5, 6, 7); }
template <class Epi, class Sched, bool ALIGN_EPI, bool F8 = false>
__device__ __forceinline__ void gemm_phase2(PG8_LAS unsigned char* lds, const int K, const Sched& S, const Epi& E, PG8_LAS unsigned char* aux  ) {
    int tid_ = threadIdx.x; asm volatile("" : "+v"(tid_));
    const int tid = tid_, wid = __builtin_amdgcn_readfirstlane(tid >> 6), lane = tid & 63, wr = wid >> 2, wc = wid & 3, fr = lane & 15, fq = lane >> 4;
    int nt_ = K / BK; asm volatile("" : "+s"(nt_)); const int nt = nt_;
    int Rr[2], Cc[2]; unsigned voffB[2];
#pragma unroll
    for (int i = 0; i < 2; ++i) { int R, C; stage_rc(tid * 16 + i * 8192, R, C); const int Rb = Epi::PERM ? ((R & ~31) + perm32(R & 31)) : R; Rr[i] = R; Cc[i] = C; voffB[i] = (unsigned)(Rb * K + C) * 2u; }
    const size_t kstep = (size_t)(BK * 2);
    const size_t hstep = (size_t)HALF * K * 2;
    const unsigned ldsw = (unsigned)wid * 1024u;
    const int aoff = lds_byte(wr * 64 + fr, fq * 8), boff = lds_byte(wc * 32 + fr, fq * 8);
#define PG8_SA(b, h) (((b) * 2 + (h)) * HTB)
#define PG8_SB(b, h) ((4 + (b) * 2 + (h)) * HTB)
#define PG8_STAGE(bufoff, gbase, voff) do { _Pragma("unroll") for (int _i = 0; _i < 2; ++_i) \
        __builtin_amdgcn_global_load_lds((const unsigned*)((const char*)(gbase) + (voff)[_i]), (PG8_LAS unsigned*)(lds + (bufoff) + ldsw + _i * 8192), 16, 0, 0); } while (0)
#define PG8_STAGEA(bufoff, o0, o1, kb) do { \
        __builtin_amdgcn_global_load_lds((const unsigned*)(Abase + (size_t)(o0) + (kb)), (PG8_LAS unsigned*)(lds + (bufoff) + ldsw), 16, 0, 0); \
        __builtin_amdgcn_global_load_lds((const unsigned*)(Abase + (size_t)(o1) + (kb)), (PG8_LAS unsigned*)(lds + (bufoff) + ldsw + 8192), 16, 0, 0); } while (0)
#define PG8_LDA(dst, b, h) do { _Pragma("unroll") for (int m = 0; m < 4; ++m) { if constexpr (F8) { dst##8[m].lo = *(const PG8_LAS i32x4_t*)(lds + PG8_SA(b, h) + aoff + m * 2048); dst##8[m].hi = *(const PG8_LAS i32x4_t*)(lds + PG8_SA(b, h) + aoff + m * 2048 + 1024); } \
        else { _Pragma("unroll") for (int k = 0; k < 2; ++k) dst[m][k] = *(const PG8_LAS bf16x8*)(lds + PG8_SA(b, h) + aoff + m * 2048 + k * 1024); } } } while (0)
#define PG8_LDB(dst, b, h) do { _Pragma("unroll") for (int n = 0; n < 2; ++n) { if constexpr (F8) { dst##8[n].lo = *(const PG8_LAS i32x4_t*)(lds + PG8_SB(b, h) + boff + n * 2048); dst##8[n].hi = *(const PG8_LAS i32x4_t*)(lds + PG8_SB(b, h) + boff + n * 2048 + 1024); } \
        else { _Pragma("unroll") for (int k = 0; k < 2; ++k) dst[n][k] = *(const PG8_LAS bf16x8*)(lds + PG8_SB(b, h) + boff + n * 2048 + k * 1024); } } } while (0)
#define PG8_MMA(ai, bj, At, Bt) do { __builtin_amdgcn_s_setprio(1); _Pragma("unroll") for (int m = 0; m < 4; ++m) _Pragma("unroll") for (int n = 0; n < 2; ++n) { \
        if constexpr (F8) asm volatile("v_mfma_scale_f32_16x16x128_f8f6f4 %0, %1, %2, %0, %3, %3 op_sel_hi:[0,0,0]" : "+v"(acc[ai][bj][m][n]) : "v"(Bt##8[n]), "v"(At##8[m]), "v"(f8scale));     \
        else { _Pragma("unroll") for (int k = 0; k < 2; ++k) acc[ai][bj][m][n] = __builtin_amdgcn_mfma_f32_16x16x32_bf16(Bt[n][k], At[m][k], acc[ai][bj][m][n], 0, 0, 0); } } __builtin_amdgcn_s_setprio(0); } while (0)
#define PG8_WAIT_V(n) asm volatile("s_waitcnt vmcnt(" #n ")" ::: "memory")
#define PG8_WAIT_L(n) asm volatile("s_waitcnt lgkmcnt(" #n ")" ::: "memory")
#define PG8_BAR __builtin_amdgcn_s_barrier()
#define PG8_SCHED __builtin_amdgcn_sched_barrier(0)
    Unit2 cur, nxt; int ui = 0;
    if (!S.next(0, cur)) return;
    f32x4 acc[2][2][4][2];
#pragma unroll
    for (int a = 0; a < 2; ++a)
#pragma unroll
        for (int b = 0; b < 2; ++b)
#pragma unroll
            for (int m = 0; m < 4; ++m)
#pragma unroll
                for (int n = 0; n < 2; ++n) acc[a][b][m][n] = (f32x4){0.f, 0.f, 0.f, 0.f};
    bf16x8 At[4][2], B0[2][2], B1[2][2]; i32x8_t At8[4], B08[2], B18[2]; const int f8scale = 0x7f7f7f7f;
    const char* Abase = (const char*)S.abase();
    unsigned cAo[4], nAo[4];
    S.aoffs(cur, Rr, Cc, cAo);
    const char* cB = (const char*)S.bptr(cur);
    typename Epi::Pre pre = E.pre(cur, wr, lane);
    PG8_STAGE(PG8_SB(0, 0), cB, voffB); PG8_STAGE(PG8_SB(0, 1), cB + hstep, voffB); PG8_STAGEA(PG8_SA(0, 0), cAo[0], cAo[1], 0); PG8_STAGEA(PG8_SA(0, 1), cAo[2], cAo[3], 0);
    if (wr == 1) PG8_BAR;
    PG8_WAIT_V(2); PG8_BAR;
    PG8_STAGE(PG8_SB(1, 0), cB + kstep, voffB); PG8_STAGEA(PG8_SA(1, 0), cAo[0], cAo[1], kstep); PG8_STAGE(PG8_SB(1, 1), cB + hstep + kstep, voffB);
    PG8_WAIT_V(6); PG8_BAR;
    for (;;) {
        const bool has_next = S.next(ui + 1, nxt);
        if (has_next) S.aoffs(nxt, Rr, Cc, nAo); else { nAo[0] = cAo[0]; nAo[1] = cAo[1]; nAo[2] = cAo[2]; nAo[3] = cAo[3]; }
        const char* nB = has_next ? (const char*)S.bptr(nxt) : cB;
        for (int t = 0; t < nt; t += 2) {
            const bool last = (t == nt - 2);
            const size_t k1 = (size_t)(t + 1) * kstep;
            const size_t k2 = last ? 0 : (size_t)(t + 2) * kstep, k3 = k2 + kstep;
            const char* b2 = last ? nB : cB + (size_t)(t + 2) * kstep; const char* b3 = b2 + kstep;
            const unsigned a20 = last ? nAo[0] : cAo[0], a21 = last ? nAo[1] : cAo[1], a22 = last ? nAo[2] : cAo[2], a23 = last ? nAo[3] : cAo[3];
            PG8_LDB(B0, 0, 0); PG8_LDB(B1, 0, 1); PG8_SCHED; PG8_LDA(At, 0, 0); PG8_STAGEA(PG8_SA(1, 1), cAo[2], cAo[3], k1);
            PG8_WAIT_V(8); PG8_WAIT_L(0); PG8_BAR; PG8_MMA(0, 0, At, B0); PG8_MMA(0, 1, At, B1); PG8_BAR; PG8_SCHED;
            PG8_LDA(At, 0, 1); PG8_STAGE(PG8_SB(0, 0), b2, voffB); PG8_STAGE(PG8_SB(0, 1), b2 + hstep, voffB); PG8_STAGEA(PG8_SA(0, 0), a20, a21, k2);
            PG8_WAIT_V(8); PG8_WAIT_L(0); PG8_BAR; PG8_MMA(1, 0, At, B0); PG8_MMA(1, 1, At, B1); PG8_BAR; PG8_SCHED;
            PG8_LDB(B0, 1, 0); PG8_LDB(B1, 1, 1); PG8_SCHED; PG8_LDA(At, 1, 0); PG8_STAGEA(PG8_SA(0, 1), a22, a23, k2);
            PG8_WAIT_V(8); PG8_WAIT_L(0); PG8_BAR; PG8_MMA(0, 0, At, B0); PG8_MMA(0, 1, At, B1); PG8_BAR; PG8_SCHED;
            PG8_LDA(At, 1, 1); PG8_STAGE(PG8_SB(1, 0), b3, voffB); PG8_STAGE(PG8_SB(1, 1), b3 + hstep, voffB); PG8_STAGEA(PG8_SA(1, 0), a20, a21, k3);
            PG8_WAIT_V(8); PG8_WAIT_L(0); PG8_BAR; PG8_MMA(1, 0, At, B0); PG8_MMA(1, 1, At, B1); PG8_BAR; PG8_SCHED;
        }
        if constexpr (ALIGN_EPI) { if (wr == 0) PG8_BAR; }
        if constexpr (F8) asm volatile("s_nop 15\n\ts_nop 3" ::: "memory");
        E(acc, cur, wr, wc, fr, fq, pre, aux + wid * 1024, lane);
        if (!has_next) break;
#pragma unroll
        for (int a = 0; a < 2; ++a)
#pragma unroll
            for (int b = 0; b < 2; ++b)
#pragma unroll
                for (int m = 0; m < 4; ++m)
#pragma unroll
                    for (int n = 0; n < 2; ++n) acc[a][b][m][n] = (f32x4){0.f, 0.f, 0.f, 0.f};
        cur = nxt; pre = E.pre(cur, wr, lane); cB = nB; cAo[0] = nAo[0]; cAo[1] = nAo[1]; cAo[2] = nAo[2]; cAo[3] = nAo[3]; ++ui;
        if constexpr (ALIGN_EPI) { if (wr == 1) PG8_BAR; }
    }
    PG8_WAIT_V(0);
    if constexpr (!ALIGN_EPI) { if (wr == 0) PG8_BAR; }
    PG8_BAR;
#undef PG8_SA
#undef PG8_SB
#undef PG8_STAGE
#undef PG8_STAGEA
#undef PG8_LDA
#undef PG8_LDB
#undef PG8_MMA
#undef PG8_WAIT_V
#undef PG8_WAIT_L
#undef PG8_BAR
#undef PG8_SCHED
}
struct MoeSched {
    const PG8_LAS unsigned* tb;
    const PG8_LAS unsigned* cntL;
    const PG8_LAS unsigned* hbL;
    int nl, lmul, ladd;
    int nN, G, c, K;
    const void* Abase_; const bf16_t* Bbase; size_t bstride;
    int merged;
    const unsigned* LIST; int mode;
    PG8_LAS int* ut;
    __device__ __forceinline__ void build_table() const {
        if (threadIdx.x < 32) { Unit2 u; const bool ok = search((int)threadIdx.x, u); PG8_LAS int* p = ut + 8 * threadIdx.x;
            p[0] = ok ? 1 : 0; p[1] = u.pm; p[2] = u.pn; p[3] = u.l; p[4] = u.cnt; p[5] = u.split; p[6] = (int)u.hb; }
    }
    __device__ __forceinline__ bool next(int i, Unit2& u) const {
        if (i < 32) { const PG8_LAS int* p = ut + 8 * i; if (__builtin_amdgcn_readfirstlane(p[0]) == 0) return false;
            u.pm = __builtin_amdgcn_readfirstlane(p[1]); u.pn = __builtin_amdgcn_readfirstlane(p[2]); u.l = __builtin_amdgcn_readfirstlane(p[3]); u.cnt = __builtin_amdgcn_readfirstlane(p[4]); u.split = __builtin_amdgcn_readfirstlane(p[5]); u.hb = (unsigned)__builtin_amdgcn_readfirstlane(p[6]); return true; }
        return search(i, u);
    }
    __device__ __forceinline__ bool search(int i, Unit2& u) const {
        u.pm = 0; u.pn = 0; u.l = 0; u.cnt = 0; u.split = 0; u.hb = 0u;
        const unsigned total = tb[nl] * (unsigned)nN; const unsigned Lx = (unsigned)i * (unsigned)G + (unsigned)c; if (Lx >= total) return false;
        const unsigned rt = Lx / (unsigned)nN; u.pn = (int)(Lx % (unsigned)nN);
        int lo = 0, hi = nl;
        while (hi - lo > 1) { const int mid = (lo + hi) >> 1; if (tb[mid] <= rt) lo = mid; else hi = mid; }
        u.pm = (int)(rt - tb[lo]);
        if (merged) { if (lo < 64) { u.l = 2 * lo; const int c0 = (int)cntL[2 * lo]; u.split = c0; u.cnt = c0 + (int)cntL[2 * lo + 1]; u.hb = hbL[2 * lo]; } else { u.l = 128; u.cnt = (int)cntL[128]; u.split = u.cnt; u.hb = 0u; } }
        else { u.l = lo * lmul + ladd; u.cnt = (int)cntL[u.l]; u.split = u.cnt; u.hb = hbL[u.l]; }
        return true;
    }
    __device__ __forceinline__ const void* abase() const { return Abase_; }
    __device__ __forceinline__ const bf16_t* bptr(const Unit2& u) const { const int e = (u.l < 128) ? (u.l >> 1) : 64; return Bbase + (size_t)e * bstride + (size_t)u.pn * 256 * K; }
    __device__ __forceinline__ void aoffs(const Unit2& u, const int (&Rr)[2], const int (&Cc)[2], unsigned (&o)[4]) const {
#pragma unroll
        for (int h = 0; h < 2; ++h)
#pragma unroll
            for (int i = 0; i < 2; ++i) {
                const int p = u.pm * 256 + h * 128 + Rr[i]; unsigned row;
                if (mode == 0) { if (u.l == 128) row = (unsigned)p; else { const int pp = p < u.cnt ? p : 0; row = LIST[pp < u.split ? (size_t)u.l * 16384 + pp : (size_t)(u.l + 1) * 16384 + (pp - u.split)] >> 3; } }
                else row = u.hb + (unsigned)p;
                o[h * 2 + i] = row * (unsigned)(K * 2) + (unsigned)(Cc[i] * 2);
            }
    }
};
typedef float f32x2m __attribute__((ext_vector_type(2)));
struct EpiMoe1 {
    static constexpr bool PERM = true, AFTER_DRAIN = false;
    const f32x2m* META; const float* RINV; bf16_t* H; bf16_t* HS; float asc;
    struct Pre { f32x2m r0, r1; };
    __device__ __forceinline__ Pre pre(const Unit2& u, int wr, int lane) const {
        Pre p; const int p0 = u.pm * 256 + wr * 64 + lane, p1 = p0 + HALF;
        if (u.l == 128) { p.r0 = (f32x2m){RINV[p0], 1.f}; p.r1 = (f32x2m){RINV[p1], 1.f}; }
        else { const int q0 = p0 < u.cnt ? p0 : 0, q1 = p1 < u.cnt ? p1 : 0;
            p.r0 = META[q0 < u.split ? (size_t)u.l * 16384 + q0 : (size_t)(u.l + 1) * 16384 + (q0 - u.split)]; p.r1 = META[q1 < u.split ? (size_t)u.l * 16384 + q1 : (size_t)(u.l + 1) * 16384 + (q1 - u.split)]; }
        return p;
    }
    __device__ __forceinline__ void operator()(const f32x4 (&acc)[2][2][4][2], const Unit2& u, int wr, int wc, int fr, int fq, const Pre& pr, PG8_LAS unsigned char* aux, int lane) const {
        PG8_LAS f32x2m* slot = (PG8_LAS f32x2m*)aux;
        slot[lane] = pr.r0; slot[64 + lane] = pr.r1;
        asm volatile("s_waitcnt lgkmcnt(0)" ::: "memory");
        const int col = u.pn * 128 + wc * 32 + 8 * fq;
#pragma unroll
        for (int ai = 0; ai < 2; ++ai)
#pragma unroll
            for (int m = 0; m < 4; ++m) {
                const int p = u.pm * 256 + ai * HALF + wr * 64 + m * 16 + fr;
                if (p < u.cnt) {
                    const f32x2m mr = slot[ai * 64 + m * 16 + fr]; const float ri = mr.x * asc, gw = mr.y;
                    float hv[8];
#pragma unroll
                    for (int n = 0; n < 2; ++n)
#pragma unroll
                        for (int i = 0; i < 4; ++i) { const float g = acc[ai][0][m][n][i] * ri, uu = acc[ai][1][m][n][i] * ri;
                            hv[n * 4 + i] = g * __builtin_amdgcn_rcpf(1.f + __builtin_amdgcn_exp2f(-1.4426950408889634f * g)) * uu * gw; }
                    if (u.l == 128) { u32x4 w; w.x = cvtc(hv[0], hv[1]); w.y = cvtc(hv[2], hv[3]); w.z = cvtc(hv[4], hv[5]); w.w = cvtc(hv[6], hv[7]);
                        *(u32x4*)(HS + (size_t)p * 256 + col) = w; }
                    else {
#pragma unroll
                        for (int i = 0; i < 8; ++i) hv[i] = __builtin_amdgcn_fmed3f(hv[i] * 16.f, -440.f, 440.f);
                        int w0 = __builtin_amdgcn_cvt_pk_fp8_f32(hv[0], hv[1], 0, false); w0 = __builtin_amdgcn_cvt_pk_fp8_f32(hv[2], hv[3], w0, true);
                        int w1 = __builtin_amdgcn_cvt_pk_fp8_f32(hv[4], hv[5], 0, false); w1 = __builtin_amdgcn_cvt_pk_fp8_f32(hv[6], hv[7], w1, true);
                        typedef unsigned u32x2h __attribute__((ext_vector_type(2)));
                        *(u32x2h*)((unsigned char*)H + ((size_t)u.hb + p) * 256 + col) = (u32x2h){(unsigned)w0, (unsigned)w1}; }
                }
                asm volatile("" ::: "memory");
            }
        asm volatile("s_waitcnt lgkmcnt(0)" ::: "memory");
    }
};
struct EpiMoe2 {
    static constexpr bool PERM = true, AFTER_DRAIN = false;
    unsigned char* Y8; float sc;
    struct Pre { int dummy; };
    __device__ __forceinline__ Pre pre(const Unit2&, int, int) const { return Pre{0}; }
    __device__ __forceinline__ void operator()(const f32x4 (&acc)[2][2][4][2], const Unit2& u, int wr, int wc, int fr, int fq, const Pre&, PG8_LAS unsigned char*, int) const {
        const unsigned cofs = (unsigned)(u.pn * 256 + (wc * 4 + fq) * 16);
#pragma unroll
        for (int ai = 0; ai < 2; ++ai)
#pragma unroll
            for (int m = 0; m < 4; ++m) {
                const int p = u.pm * 256 + ai * HALF + wr * 64 + m * 16 + fr;
                if (p < u.cnt) {
                    int w[4];
#pragma unroll
                    for (int bj = 0; bj < 2; ++bj) { f32x4 a0 = acc[ai][bj][m][0] * sc, a1 = acc[ai][bj][m][1] * sc;
#pragma unroll
                        for (int i = 0; i < 4; ++i) { a0[i] = __builtin_amdgcn_fmed3f(a0[i], -440.f, 440.f); a1[i] = __builtin_amdgcn_fmed3f(a1[i], -440.f, 440.f); }
                        int w0 = __builtin_amdgcn_cvt_pk_fp8_f32(a0[0], a0[1], 0, false); w0 = __builtin_amdgcn_cvt_pk_fp8_f32(a0[2], a0[3], w0, true);
                        int w1 = __builtin_amdgcn_cvt_pk_fp8_f32(a1[0], a1[1], 0, false); w1 = __builtin_amdgcn_cvt_pk_fp8_f32(a1[2], a1[3], w1, true);
                        w[2 * bj] = w0; w[2 * bj + 1] = w1; }
                    *(u32x4*)(Y8 + ((u.hb + (unsigned)p) * 1024u + cofs)) = (u32x4){(unsigned)w[0], (unsigned)w[1], (unsigned)w[2], (unsigned)w[3]};
                }
            }
    }
};
struct EpiFinal {
    static constexpr bool PERM = true, AFTER_DRAIN = false;
    const unsigned char* Y8; const unsigned* INV; const PG8_LAS unsigned* hbL; const float* Oin; float* O;
    struct Pre { int dummy; };
    __device__ __forceinline__ Pre pre(const Unit2&, int, int) const { return Pre{0}; }
    __device__ __forceinline__ void operator()(const f32x4 (&acc)[2][2][4][2], const Unit2& u, int wr, int wc, int fr, int fq, const Pre&, PG8_LAS unsigned char*, int) const {
        typedef float f32x2v __attribute__((ext_vector_type(2)));
        const unsigned col = (unsigned)(u.pn * 256 + wc * 64 + 8 * fq), cofs = (unsigned)(u.pn * 256 + (wc * 4 + fq) * 16);
#pragma unroll
        for (int ai = 0; ai < 2; ++ai)
#pragma unroll
            for (int m = 0; m < 4; ++m) {
                const unsigned row = (unsigned)(u.pm * 256 + ai * HALF + wr * 64 + m * 16 + fr);
                const u32x4 iv0 = *(const u32x4*)(INV + row * 8u), iv1 = *(const u32x4*)(INV + row * 8u + 4u);
                const unsigned iv[8] = {iv0.x, iv0.y, iv0.z, iv0.w, iv1.x, iv1.y, iv1.z, iv1.w};
                unsigned yo[8];
#pragma unroll
                for (int j = 0; j < 8; ++j) yo[j] = (hbL[iv[j] >> 16] + (iv[j] & 0xffffu)) * 1024u + cofs;
#pragma unroll
                for (int bj = 0; bj < 2; ++bj) {
                    typedef unsigned u32x2g __attribute__((ext_vector_type(2)));
                    u32x2g t[8];
#pragma unroll
                    for (int j = 0; j < 8; ++j) t[j] = *(const u32x2g*)(Y8 + (yo[j] + bj * 8u));
                    const f32x4 x0 = *(const f32x4*)(Oin + (row * 1024u + col + bj * 32)), x1 = *(const f32x4*)(Oin + (row * 1024u + col + bj * 32 + 4));
                    f32x4 s0 = (f32x4){0.f, 0.f, 0.f, 0.f}, s1 = (f32x4){0.f, 0.f, 0.f, 0.f};
#pragma unroll
                    for (int j = 0; j < 8; ++j) { const f32x2v p0 = __builtin_amdgcn_cvt_pk_f32_fp8((int)t[j].x, false), p1 = __builtin_amdgcn_cvt_pk_f32_fp8((int)t[j].x, true),
                                                               p2 = __builtin_amdgcn_cvt_pk_f32_fp8((int)t[j].y, false), p3 = __builtin_amdgcn_cvt_pk_f32_fp8((int)t[j].y, true);
                        s0[0] += p0.x; s0[1] += p0.y; s0[2] += p1.x; s0[3] += p1.y; s1[0] += p2.x; s1[1] += p2.y; s1[2] += p3.x; s1[3] += p3.y; }
                    float* op = O + (row * 1024u + col + bj * 32);
                    *(f32x4*)op = x0 + acc[ai][bj][m][0] + s0 * 0.0625f; *(f32x4*)(op + 4) = x1 + acc[ai][bj][m][1] + s1 * 0.0625f;
                    asm volatile("" ::: "memory");
                }
                asm volatile("" ::: "memory");
            }
    }
};
struct EpiFinalD {
    static constexpr bool PERM = true, AFTER_DRAIN = true;
    const unsigned char* Y8; const unsigned* INV; const PG8_LAS unsigned* hbL; const float* Oin; float* O;
    __device__ __forceinline__ void fused(const f32x4 (&acc)[2][2][4][2], const Unit& u, int wr, int wc, int fr, int fq, PG8_LAS unsigned char*, int, int) const {
        typedef float f32x2v __attribute__((ext_vector_type(2)));
        const unsigned col = (unsigned)(u.pn * 256 + wc * 64 + 8 * fq), cofs = (unsigned)(u.pn * 256 + (wc * 4 + fq) * 16);
#pragma unroll
        for (int ai = 0; ai < 2; ++ai)
#pragma unroll
            for (int m = 0; m < 4; ++m) {
                const unsigned row = (unsigned)(u.pm * 256 + ai * HALF + wr * 64 + m * 16 + fr);
                const u32x4 iv0 = *(const u32x4*)(INV + row * 8u), iv1 = *(const u32x4*)(INV + row * 8u + 4u);
                const unsigned iv[8] = {iv0.x, iv0.y, iv0.z, iv0.w, iv1.x, iv1.y, iv1.z, iv1.w};
                f32x4 xr[2][2];
#pragma unroll
                for (int bj = 0; bj < 2; ++bj) { xr[bj][0] = *(const f32x4*)(Oin + (row * 1024u + col + bj * 32)); xr[bj][1] = *(const f32x4*)(Oin + (row * 1024u + col + bj * 32 + 4)); }
                f32x4 s[2][2];
#pragma unroll
                for (int bj = 0; bj < 2; ++bj) { s[bj][0] = (f32x4){0.f, 0.f, 0.f, 0.f}; s[bj][1] = (f32x4){0.f, 0.f, 0.f, 0.f}; }
#pragma unroll
                for (int jh = 0; jh < 2; ++jh) {
                    u32x4 t[4];
#pragma unroll
                    for (int j = 0; j < 4; ++j) { const unsigned ivv = iv[jh * 4 + j]; t[j] = *(const u32x4*)(Y8 + ((hbL[ivv >> 16] + (ivv & 0xffffu)) * 1024u + cofs)); }
#pragma unroll
                    for (int j = 0; j < 4; ++j) { const unsigned tw[4] = {t[j].x, t[j].y, t[j].z, t[j].w};
#pragma unroll
                        for (int bj = 0; bj < 2; ++bj) { const f32x2v p0 = __builtin_amdgcn_cvt_pk_f32_fp8((int)tw[2 * bj], false), p1 = __builtin_amdgcn_cvt_pk_f32_fp8((int)tw[2 * bj], true),
                                                                     p2 = __builtin_amdgcn_cvt_pk_f32_fp8((int)tw[2 * bj + 1], false), p3 = __builtin_amdgcn_cvt_pk_f32_fp8((int)tw[2 * bj + 1], true);
                            s[bj][0][0] += p0.x; s[bj][0][1] += p0.y; s[bj][0][2] += p1.x; s[bj][0][3] += p1.y; s[bj][1][0] += p2.x; s[bj][1][1] += p2.y; s[bj][1][2] += p3.x; s[bj][1][3] += p3.y; } }
                    asm volatile("" ::: "memory");
                }
#pragma unroll
                for (int bj = 0; bj < 2; ++bj) { float* op = O + (row * 1024u + col + bj * 32);
                    *(f32x4*)op = xr[bj][0] + acc[ai][bj][m][0] + s[bj][0] * 0.0625f; *(f32x4*)(op + 4) = xr[bj][1] + acc[ai][bj][m][1] + s[bj][1] * 0.0625f; }
                asm volatile("" ::: "memory");
            }
    }
};
}
#ifndef PG8_SP2
#define PG8_SP2 true
#endif
namespace fox {
using bf16=__hip_bfloat16;
using bf16x8=__attribute__((ext_vector_type(8)))short;
using s16x4=__attribute__((ext_vector_type(4)))short;
using f32x16=__attribute__((ext_vector_type(16)))float;
using u32x4=__attribute__((ext_vector_type(4)))unsigned;
constexpr int BATCH=2,NHEAD=8,SEQ=8192,D=64,DM=NHEAD*D;
constexpr int NW=8,QBLK=32,QB=QBLK*NW,KVBLK=64,NQB=SEQ/QB;
constexpr int ATTN_PITCH=DM, ATTN_UNIT_ROWS=QB;
__device__ __forceinline__ int crow(int r,int hi){return (r&3)+8*(r>>2)+4*hi;}
#define SBAR() __builtin_amdgcn_sched_barrier(0)
__device__ __forceinline__ void cmask(f32x16&p0,f32x16&p1,int jb,int qrel,int hi){
  const float NEG=-INFINITY; int kb=64*jb+4*hi;
  #pragma unroll
  for(int r=0;r<16;++r){int kv=kb+(r&3)+8*(r>>2); if(kv>qrel)p0[r]=NEG; if(kv+32>qrel)p1[r]=NEG;}
}

constexpr int NSLOT=3, SLOTB=9216, KAOFF=8192;
constexpr int LDS_K=0, LDS_V=NSLOT*SLOTB, LDS_WS=2*NSLOT*SLOTB, LDS_OST=LDS_WS+NW*64*4, LDS_BYTES=LDS_OST+NW*4096;
constexpr float C2=0.125f*1.4426950408889634f;
__device__ __forceinline__ void glds16(const void*gsrc,unsigned lds_dst){unsigned keep;
  asm volatile("s_mov_b32 %0, m0\n\ts_mov_b32 m0, %2\n\ts_nop 0\n\tglobal_load_lds_dwordx4 %1, off\n\ts_mov_b32 m0, %0":"=&s"(keep):"v"(gsrc),"s"(lds_dst):"memory");}
__device__ __forceinline__ float max3f(float a,float b,float c){float r;asm("v_max3_f32 %0, %1, %2, %3":"=v"(r):"v"(a),"v"(b),"v"(c));return r;}
__device__ __forceinline__ float max2f(float a,float b){float r;asm("v_max_f32_e32 %0, %1, %2":"=v"(r):"v"(a),"v"(b));return r;}
__device__ __forceinline__ float fadd_s(float a,float b){float r;asm("v_add_f32_e32 %0, %1, %2":"=v"(r):"v"(a),"v"(b));return r;}
__device__ __forceinline__ float fsub_s(float a,float b){float r;asm("v_sub_f32_e32 %0, %1, %2":"=v"(r):"v"(a),"v"(b));return r;}
typedef float f32x2_t __attribute__((ext_vector_type(2))); typedef __bf16 bf16x2_t __attribute__((ext_vector_type(2)));
__device__ __forceinline__ unsigned cvtpk_s(float lo,float hi){f32x2_t v={lo,hi};bf16x2_t b=__builtin_convertvector(v,bf16x2_t);return __builtin_bit_cast(unsigned,b);}
#define WAIT_BAR(N) asm volatile("s_waitcnt vmcnt(" #N ") lgkmcnt(0)\n\ts_barrier":::"memory")

__device__ __forceinline__ void qkt(f32x16&p0,f32x16&p1,const char*Kslot,const bf16x8*qr,const bf16x8 qa,int r32,int hi){
  const f32x16 z16=f32x16{};
  const char*kb=Kslot+hi*1024+r32*16;
  #pragma unroll
  for(int d0=0;d0<4;++d0){
    const bf16x8 b0=*reinterpret_cast<const bf16x8*>(kb+d0*2048);
    const bf16x8 b1=*reinterpret_cast<const bf16x8*>(kb+d0*2048+512);
    if(d0==0){p0=__builtin_amdgcn_mfma_f32_32x32x16_bf16(b0,qr[0],z16,0,0,0);p1=__builtin_amdgcn_mfma_f32_32x32x16_bf16(b1,qr[0],z16,0,0,0);}
    else{p0=__builtin_amdgcn_mfma_f32_32x32x16_bf16(b0,qr[d0],p0,0,0,0);p1=__builtin_amdgcn_mfma_f32_32x32x16_bf16(b1,qr[d0],p1,0,0,0);}}
  { const bf16x8 a0=*reinterpret_cast<const bf16x8*>(Kslot+KAOFF+r32*16); const bf16x8 a1=*reinterpret_cast<const bf16x8*>(Kslot+KAOFF+r32*16+512);
    p0=__builtin_amdgcn_mfma_f32_32x32x16_bf16(a0,qa,p0,0,0,0);p1=__builtin_amdgcn_mfma_f32_32x32x16_bf16(a1,qa,p1,0,0,0); }
}
typedef __attribute__((address_space(3))) const char* lds_cptr;
typedef short v4i16_t __attribute__((ext_vector_type(4)));
__device__ __forceinline__ void kload8(bf16x8*kf,lds_cptr kp){
  kf[0]=*(const __attribute__((address_space(3))) bf16x8*)(kp);      kf[1]=*(const __attribute__((address_space(3))) bf16x8*)(kp+512);
  kf[2]=*(const __attribute__((address_space(3))) bf16x8*)(kp+2048); kf[3]=*(const __attribute__((address_space(3))) bf16x8*)(kp+2560);
  kf[4]=*(const __attribute__((address_space(3))) bf16x8*)(kp+4096); kf[5]=*(const __attribute__((address_space(3))) bf16x8*)(kp+4608);
  kf[6]=*(const __attribute__((address_space(3))) bf16x8*)(kp+6144); kf[7]=*(const __attribute__((address_space(3))) bf16x8*)(kp+6656);
}
__device__ __forceinline__ void kload2(bf16x8*kf,lds_cptr kp,int j){ kf[2*j]=*(const __attribute__((address_space(3))) bf16x8*)(kp+j*2048); kf[2*j+1]=*(const __attribute__((address_space(3))) bf16x8*)(kp+j*2048+512); }
__device__ __forceinline__ s16x4 vtr(lds_cptr p){ return __builtin_bit_cast(s16x4,__builtin_amdgcn_ds_read_tr16_b64_v4i16((__attribute__((address_space(3))) v4i16_t*)p)); }
__device__ __forceinline__ float rowmax(const f32x16&p0,const f32x16&p1){
  float a=max3f(p0[0],p0[1],p1[0]),b=max3f(p0[2],p0[3],p1[1]);a=max3f(a,p1[2],p1[3]);
  #pragma unroll
  for(int r=4;r<16;r+=4){a=max3f(a,p0[r],p0[r+1]);b=max3f(b,p0[r+2],p0[r+3]);a=max3f(a,p1[r],p1[r+1]);b=max3f(b,p1[r+2],p1[r+3]);}
  const float m=max2f(a,b);
  auto rr=__builtin_amdgcn_permlane32_swap(__float_as_uint(m),__float_as_uint(m),false,false);
  return max2f(__uint_as_float(rr[0]),__uint_as_float(rr[1]));
}
__device__ __forceinline__ void pv(f32x16*o,int vb,bf16x8 pa0,bf16x8 pa1,bf16x8 pa2,bf16x8 pa3){
  #pragma unroll
  for(int d0=0;d0<2;++d0){s16x4 lo[4],hi[4];
    #pragma unroll
    for(int ks=0;ks<4;++ks){
      asm volatile("ds_read_b64_tr_b16 %0,%1 offset:%c2":"=&v"(lo[ks]):"v"(vb),"i"(d0*4096+ks*1024):"memory");
      asm volatile("ds_read_b64_tr_b16 %0,%1 offset:%c2":"=&v"(hi[ks]):"v"(vb),"i"(d0*4096+ks*1024+512):"memory");}
    asm volatile("s_waitcnt lgkmcnt(0)":::"memory");SBAR();
    #define PK(k) (bf16x8){lo[k][0],lo[k][1],lo[k][2],lo[k][3],hi[k][0],hi[k][1],hi[k][2],hi[k][3]}
    o[d0]=__builtin_amdgcn_mfma_f32_32x32x16_bf16(pa0,PK(0),o[d0],0,0,0);
    o[d0]=__builtin_amdgcn_mfma_f32_32x32x16_bf16(pa1,PK(1),o[d0],0,0,0);
    o[d0]=__builtin_amdgcn_mfma_f32_32x32x16_bf16(pa2,PK(2),o[d0],0,0,0);
    o[d0]=__builtin_amdgcn_mfma_f32_32x32x16_bf16(pa3,PK(3),o[d0],0,0,0);
    #undef PK
  }
}

#ifndef ATTN_STORE16
#define ATTN_STORE16(p,v) (*(u32x4*)(p)=(v))
#endif
template<int THRL> __device__ __forceinline__ void attn_unit(int b,int h,int qb,int T0,const bf16*Q,const bf16*__restrict__ K,const bf16*__restrict__ V,const bf16*__restrict__ KA,const float*__restrict__ Cbh,bf16*O,char*shm){
  int tid_=threadIdx.x; asm volatile("":"+v"(tid_));
  const int tid=tid_,lane=tid&63,r32=lane&31,hi=lane>>5; const int wid=__builtin_amdgcn_readfirstlane(tid>>6);
  const long rowbase=(long)b*SEQ; const int q0=qb*QB;
  const bf16*Qw=Q+(rowbase+q0+wid*QBLK)*DM+h*D;
  const bf16*Kh=K+(rowbase+(long)T0*KVBLK)*DM+h*D,*Vh=V+(rowbase+(long)T0*KVBLK)*DM+h*D;
  const bf16*kasrc=KA+((rowbase+(long)T0*KVBLK+lane)*NHEAD+h)*8;
  const unsigned lds0=(unsigned)(uintptr_t)shm;
  float*wsf=(float*)(shm+LDS_WS)+wid*64;
  const bf16*ksrc=Kh+(long)lane*DM+wid*8;
  const bf16*vsrc=Vh+(long)(16*(wid&3)+(lane>>2))*DM+(wid>>2)*32+(lane&3)*8;
  const unsigned kdst=lds0+LDS_K+wid*1024, vdst=lds0+LDS_V+wid*1024;
  #define DMA_K(t,slot) glds16(ksrc+(long)(t)*KVBLK*DM,(unsigned)__builtin_amdgcn_readfirstlane(kdst+(slot)))
  #define DMA_V(t,slot) glds16(vsrc+(long)(t)*KVBLK*DM,(unsigned)__builtin_amdgcn_readfirstlane(vdst+(slot)))
  #define DMA_KA(t,slot) do{ if(wid==0) glds16(kasrc+(long)(t)*KVBLK*NHEAD*8,(unsigned)__builtin_amdgcn_readfirstlane(lds0+LDS_K+KAOFF+(slot))); }while(0)
  const int vb0=(int)(lds0+LDS_V)+((lane>>4)&1)*32+(lane&3)*8+(4*hi+((lane&15)>>2))*64;
  const char*Kbase=shm+LDS_K; bf16x8 kf[8],kfa[2];
  const lds_cptr shm3=(lds_cptr)shm; const lds_cptr kpa=shm3+LDS_K+KAOFF+r32*16; const lds_cptr kp0=shm3+LDS_K+hi*1024+r32*16;
  #define KALOAD(sl) do{ kfa[0]=*(const __attribute__((address_space(3))) bf16x8*)(kpa+(sl)); kfa[1]=*(const __attribute__((address_space(3))) bf16x8*)(kpa+(sl)+512); }while(0)
  const lds_cptr vp0=shm3+LDS_V+((lane>>4)&1)*32+(lane&3)*8+(4*hi+((lane&15)>>2))*64;
  const int NT=(q0+QB)/KVBLK-T0;
  DMA_KA(0,0);DMA_KA(1,SLOTB);DMA_KA(2,2*SLOTB);
  DMA_K(0,0);DMA_V(0,0);DMA_K(1,SLOTB);
  bf16x8 qr[4];
  #pragma unroll
  for(int d0=0;d0<4;++d0)qr[d0]=*reinterpret_cast<const bf16x8*>(&Qw[(long)r32*DM+d0*16+hi*8]);
  const float ct2=Cbh[q0+wid*QBLK+r32]*1.4426950408889634f;
  float mhat=0.f,l_reg=0.f;f32x16 o[2];o[0]=f32x16{};o[1]=f32x16{};u32x4 qaw;
  #define QA_REBUILD() do{ const float a_=ct2-mhat; const unsigned p0_=cvtpk_s(a_,0.f)&0xffffu; const float r1_=a_-__uint_as_float(p0_<<16); const unsigned p1_=cvtpk_s(r1_,0.f)&0xffffu; \
      const float r2_=r1_-__uint_as_float(p1_<<16); const unsigned p2_=cvtpk_s(r2_,0.f)&0xffffu; \
      qaw=hi?(u32x4){0u,0u,0u,0u}:(u32x4){0x3F803F80u,0x3F80u|(p0_<<16),p1_|(p2_<<16),0u}; asm volatile("":"+v"(qaw)); }while(0)
  #define QAF __builtin_bit_cast(bf16x8,qaw)
  QA_REBUILD();
  const int qrel=wid*QBLK+r32;
  #define CMASK(P0,P1,t) do{int jb_=(t)-(NT-4); if(jb_>=0)cmask(P0,P1,jb_,qrel,hi);}while(0)
  bool resc=false;
  #define START(P0,P1) do{ const float rm=rowmax(P0,P1); resc=false; \
    { const float dl=rm; mhat=fadd_s(mhat,dl); \
      _Pragma("unroll") for(int r=0;r<16;++r){P0[r]=fsub_s(P0[r],dl);P1[r]=fsub_s(P1[r],dl);} \
      QA_REBUILD(); } \
    _Pragma("unroll") for(int r=0;r<16;++r)P0[r]=__builtin_amdgcn_exp2f(P0[r]); }while(0)
  #define RESC() do{ if(resc){ asm volatile("s_waitcnt lgkmcnt(0)":::"memory"); \
      _Pragma("unroll") for(int d_=0;d_<2;++d_) _Pragma("unroll") for(int r=0;r<16;++r)o[d_][r]*=wsf[crow(r,hi)]; } }while(0)
  f32x16 pA0,pA1,pB0,pB1;
  int sl_prev=0,sl_cur=0,sl_next=SLOTB;
  #define ROT() do{sl_prev=sl_cur;sl_cur=sl_next;sl_next=(sl_next==(NSLOT-1)*SLOTB)?0:sl_next+SLOTB;}while(0)
  DMA_K(2,2*SLOTB);
  WAIT_BAR(3);
  qkt(pA0,pA1,Kbase,qr,QAF,r32,hi);asm volatile("s_nop 15\n\ts_nop 7":"+v"(pA0),"+v"(pA1));CMASK(pA0,pA1,0);
  START(pA0,pA1);
  _Pragma("unroll") for(int r=0;r<16;++r)pA1[r]=__builtin_amdgcn_exp2f(pA1[r]);
  WAIT_BAR(0);
  DMA_KA(3,0);DMA_K(3,0);DMA_V(1,SLOTB);
  ROT();
  kload8(kf,kp0+sl_cur); KALOAD(sl_cur);
  WAIT_BAR(2);
  s16x4 vlo[8],vhi[8]; u32x4 pw0,pw1,pw2,pw3;
  #define PKW(P,B) cvtpk_s(P[B],P[B+1])
  #define PAF(k) __builtin_bit_cast(bf16x8,pw##k)
  #define VFR(i) (bf16x8){vlo[i][0],vlo[i][1],vlo[i][2],vlo[i][3],vhi[i][0],vhi[i][1],vhi[i][2],vhi[i][3]}
  #define PIN(x) asm volatile("":"+v"(x))
  #define MX3(a,b,c) __builtin_fmaxf(__builtin_fmaxf((a),(b)),(c))
  #define GAPA(MF,A0,A1,A2,A3,W0,W1,PW) do{ MF; sacc+=A0; sacc+=A1; sacc+=A2; sacc+=A3; PIN(sacc); W0; W1; PIN(PW); SBAR(); }while(0)
  #define EX(v) __builtin_amdgcn_exp2f(v)
  #define GAPB(MF,X,B) do{ MF; X[B]=EX(X[B]); X[B+1]=EX(X[B+1]); X[B+2]=EX(X[B+2]); X[B+3]=EX(X[B+3]); PIN(X); SBAR(); }while(0)
  #define VRD(i) do{ vlo[i]=vtr(vp_+(((i)>>2)*4096+((i)&3)*1024)); vhi[i]=vtr(vp_+(((i)>>2)*4096+((i)&3)*1024+512)); }while(0)
  #define KRD(G,j) do{ if(G){ kload2(kf,kp0+sl_next,j); SBAR(); } }while(0)
  const f32x16 z16=f32x16{};
  #define STEP(C0,C1,P0,P1,t,GK,GV,GL) do{ SBAR(); \
    const lds_cptr vp_=vp0+sl_prev; \
    VRD(0); SBAR(); float sacc=(P0[0]+P0[1]); \
    GAPA(C0=__builtin_amdgcn_mfma_f32_32x32x16_bf16(kf[0],qr[0],z16,0,0,0), P0[2],P0[3],P0[4],P0[5],     pw0[0]=PKW(P0,0), pw0[1]=PKW(P0,2), pw0); \
    VRD(4); SBAR(); GAPA(C1=__builtin_amdgcn_mfma_f32_32x32x16_bf16(kf[1],qr[0],z16,0,0,0), P0[6],P0[7],P0[8],P0[9],     pw0[2]=PKW(P0,4), pw0[3]=PKW(P0,6), pw0); \
    VRD(1); SBAR(); GAPA(C0=__builtin_amdgcn_mfma_f32_32x32x16_bf16(kf[2],qr[1],C0,0,0,0),   P0[10],P0[11],P0[12],P0[13], pw1[0]=PKW(P0,8), pw1[1]=PKW(P0,10), pw1); \
    VRD(5); SBAR(); GAPA(C1=__builtin_amdgcn_mfma_f32_32x32x16_bf16(kf[3],qr[1],C1,0,0,0),   P0[14],P0[15],P1[0],P1[1],   pw1[2]=PKW(P0,12),pw1[3]=PKW(P0,14), pw1); \
    VRD(2); SBAR(); GAPA(C0=__builtin_amdgcn_mfma_f32_32x32x16_bf16(kf[4],qr[2],C0,0,0,0),   P1[2],P1[3],P1[4],P1[5],     pw2[0]=PKW(P1,0), pw2[1]=PKW(P1,2), pw2); \
    VRD(6); SBAR(); GAPA(C1=__builtin_amdgcn_mfma_f32_32x32x16_bf16(kf[5],qr[2],C1,0,0,0),   P1[6],P1[7],P1[8],P1[9],     pw2[2]=PKW(P1,4), pw2[3]=PKW(P1,6), pw2); \
    VRD(3); SBAR(); GAPA(C0=__builtin_amdgcn_mfma_f32_32x32x16_bf16(kf[6],qr[3],C0,0,0,0),   P1[10],P1[11],P1[12],P1[13], pw3[0]=PKW(P1,8), pw3[1]=PKW(P1,10), pw3); \
    VRD(7); SBAR(); GAPA(C1=__builtin_amdgcn_mfma_f32_32x32x16_bf16(kf[7],qr[3],C1,0,0,0),   P1[14],P1[15],0.f,0.f,       pw3[2]=PKW(P1,12),pw3[3]=PKW(P1,14), pw3); \
    C0=__builtin_amdgcn_mfma_f32_32x32x16_bf16(kfa[0],QAF,C0,0,0,0); C1=__builtin_amdgcn_mfma_f32_32x32x16_bf16(kfa[1],QAF,C1,0,0,0); SBAR(); \
    l_reg+=sacc; \
    if(GK){DMA_KA((t)+3,sl_cur);DMA_K((t)+3,sl_cur);} if(GV){DMA_V((t)+1,sl_next);} \
    CMASK(C0,C1,t); \
    { float a=MX3(C0[0],C0[1],C1[0]),b=MX3(C0[2],C0[3],C1[1]); a=MX3(a,C1[2],C1[3]); \
      _Pragma("unroll") for(int r=4;r<16;r+=4){a=MX3(a,C0[r],C0[r+1]);b=MX3(b,C0[r+2],C0[r+3]);a=MX3(a,C1[r],C1[r+1]);b=MX3(b,C1[r+2],C1[r+3]);} \
      float rm=__builtin_fmaxf(a,b); { auto rr=__builtin_amdgcn_permlane32_swap(__float_as_uint(rm),__float_as_uint(rm),false,false); rm=__builtin_fmaxf(__uint_as_float(rr[0]),__uint_as_float(rr[1])); } \
      resc=false; \
      if(__builtin_expect(__any(rm>(float)THRL),0)){ const float dl=__builtin_fmaxf(rm,0.f); mhat+=dl; \
        _Pragma("unroll") for(int r=0;r<16;++r){C0[r]-=dl;C1[r]-=dl;} \
        QA_REBUILD(); \
        const float f=__builtin_amdgcn_exp2f(-dl); l_reg*=f; if(hi==0)wsf[r32]=f; resc=true; } } \
    SBAR(); \
    GAPB(o[0]=__builtin_amdgcn_mfma_f32_32x32x16_bf16(PAF(0),VFR(0),o[0],0,0,0), C0,0); \
    GAPB(o[1]=__builtin_amdgcn_mfma_f32_32x32x16_bf16(PAF(0),VFR(4),o[1],0,0,0), C0,4); \
    KRD(GL,0); GAPB(o[0]=__builtin_amdgcn_mfma_f32_32x32x16_bf16(PAF(1),VFR(1),o[0],0,0,0), C0,8); \
    KRD(GL,1); GAPB(o[1]=__builtin_amdgcn_mfma_f32_32x32x16_bf16(PAF(1),VFR(5),o[1],0,0,0), C0,12); \
    KRD(GL,2); GAPB(o[0]=__builtin_amdgcn_mfma_f32_32x32x16_bf16(PAF(2),VFR(2),o[0],0,0,0), C1,0); \
    KRD(GL,3); GAPB(o[1]=__builtin_amdgcn_mfma_f32_32x32x16_bf16(PAF(2),VFR(6),o[1],0,0,0), C1,4); \
    if(GL){ KALOAD(sl_next); SBAR(); } \
    GAPB(o[0]=__builtin_amdgcn_mfma_f32_32x32x16_bf16(PAF(3),VFR(3),o[0],0,0,0), C1,8); \
    GAPB(o[1]=__builtin_amdgcn_mfma_f32_32x32x16_bf16(PAF(3),VFR(7),o[1],0,0,0), C1,12); \
    }while(0)
  int t=1;
  #undef CMASK
  #define CMASK(P0,P1,t) do{}while(0)
  for(;t+5<NT;t+=2){
    STEP(pB0,pB1,pA0,pA1,t,true,true,true);     WAIT_BAR(2); RESC(); ROT();
    STEP(pA0,pA1,pB0,pB1,t+1,true,true,true);   WAIT_BAR(2); RESC(); ROT();
  }
  #undef CMASK
  #define CMASK(P0,P1,t) do{int jb_=(t)-(NT-4); if(jb_>=0)cmask(P0,P1,jb_,qrel,hi);}while(0)
  #define ENDW(tt) do{ if((tt)+3<NT){WAIT_BAR(2);} else if((tt)+2<NT){WAIT_BAR(1);} else {WAIT_BAR(0);} }while(0)
  for(;t+1<NT;t+=2){
    STEP(pB0,pB1,pA0,pA1,t,(t+3<NT),(t+1<NT),(t+1<NT));       ENDW(t);   RESC(); ROT();
    STEP(pA0,pA1,pB0,pB1,t+1,(t+4<NT),(t+2<NT),(t+2<NT));     ENDW(t+1); RESC(); ROT();
  }
  STEP(pB0,pB1,pA0,pA1,NT-1,false,false,false); RESC();
  { float sacc=pB0[0]+pB0[1]; _Pragma("unroll") for(int r=2;r<16;++r)sacc+=pB0[r]; _Pragma("unroll") for(int r=0;r<16;++r)sacc+=pB1[r]; l_reg+=sacc;
    pw0=(u32x4){PKW(pB0,0),PKW(pB0,2),PKW(pB0,4),PKW(pB0,6)};pw1=(u32x4){PKW(pB0,8),PKW(pB0,10),PKW(pB0,12),PKW(pB0,14)};pw2=(u32x4){PKW(pB1,0),PKW(pB1,2),PKW(pB1,4),PKW(pB1,6)};pw3=(u32x4){PKW(pB1,8),PKW(pB1,10),PKW(pB1,12),PKW(pB1,14)};
    SBAR(); pv(o,vb0+sl_cur,PAF(0),PAF(1),PAF(2),PAF(3)); }
  #undef PKW
  #undef PAF
  #undef VFR
  #undef PIN
  #undef MX3
  #undef GAPA
  #undef GAPB
  #undef EX
  #undef VRD
  #undef KRD
  #undef STEP
  #undef ENDW
  {auto rr=__builtin_amdgcn_permlane32_swap(__float_as_uint(l_reg),__float_as_uint(l_reg),false,false);l_reg=__uint_as_float(rr[0])+__uint_as_float(rr[1]);}
  if(hi==0)wsf[32+r32]=l_reg;asm volatile("s_waitcnt lgkmcnt(0)":::"memory");
  float rli[16];
  #pragma unroll
  for(int r=0;r<16;++r)rli[r]=__builtin_amdgcn_rcpf(wsf[32+crow(r,hi)]);
  bf16*Ow=O+(rowbase+q0+wid*QBLK)*DM+h*D;
  { bf16*stg=(bf16*)(shm+LDS_OST)+wid*2048;
    #pragma unroll
    for(int r=0;r<16;++r){const int orow=crow(r,hi);
      #pragma unroll
      for(int d0=0;d0<2;++d0)stg[orow*64+d0*32+r32]=__float2bfloat16(o[d0][r]*rli[r]);}
    asm volatile("s_waitcnt lgkmcnt(0)":::"memory");
    #pragma unroll
    for(int i=0;i<4;++i){const int row=i*8+(lane>>3),ch=lane&7; const u32x4 v=*(const u32x4*)(stg+row*64+ch*8); ATTN_STORE16(Ow+(long)row*DM+ch*8,v);} }
  asm volatile("s_waitcnt lgkmcnt(0)\n\ts_barrier":::"memory");
  #undef DMA_K
  #undef DMA_KA
  #undef KALOAD
  #undef QA_REBUILD
  #undef QAF
  #undef DMA_V
  #undef CMASK
  #undef START
  #undef RESC
  #undef ROT
}
constexpr int ATTN_LDS_BYTES=LDS_BYTES;
#undef SBAR
#undef WAIT_BAR
}
namespace dil {
using fox::bf16; using fox::bf16x8; using fox::f32x16; using fox::u32x4; using fox::s16x4;
constexpr int PITCH = 768;
constexpr int BT_N = 224;
__device__ __forceinline__ float hswap_max(float v) { auto rr = __builtin_amdgcn_permlane32_swap(__float_as_uint(v), __float_as_uint(v), false, false); return fmaxf(__uint_as_float(rr[0]), __uint_as_float(rr[1])); }
__device__ __forceinline__ float hswap_sum(float v) { auto rr = __builtin_amdgcn_permlane32_swap(__float_as_uint(v), __float_as_uint(v), false, false); return __uint_as_float(rr[0]) + __uint_as_float(rr[1]); }
__device__ __forceinline__ void pv_hi(f32x16* o, int vb, bf16x8 pa2, bf16x8 pa3) {
#pragma unroll
    for (int d0 = 0; d0 < 2; ++d0) { s16x4 lo[2], hi[2];
#pragma unroll
        for (int ks = 0; ks < 2; ++ks) {
            asm volatile("ds_read_b64_tr_b16 %0,%1 offset:%c2" : "=&v"(lo[ks]) : "v"(vb), "i"(d0 * 4096 + (ks + 2) * 1024) : "memory");
            asm volatile("ds_read_b64_tr_b16 %0,%1 offset:%c2" : "=&v"(hi[ks]) : "v"(vb), "i"(d0 * 4096 + (ks + 2) * 1024 + 512) : "memory"); }
        asm volatile("s_waitcnt lgkmcnt(0)" ::: "memory"); __builtin_amdgcn_sched_barrier(0);
#define DIL_PKV(k) (bf16x8){lo[k][0], lo[k][1], lo[k][2], lo[k][3], hi[k][0], hi[k][1], hi[k][2], hi[k][3]}
        o[d0] = __builtin_amdgcn_mfma_f32_32x32x16_bf16(pa2, DIL_PKV(0), o[d0], 0, 0, 0);
        o[d0] = __builtin_amdgcn_mfma_f32_32x32x16_bf16(pa3, DIL_PKV(1), o[d0], 0, 0, 0);
#undef DIL_PKV
    }
}
struct TP { int d, h12, tb, c, ubase; };
__device__ __forceinline__ TP mk_tp(int hs, int g, int t0, int r, int c) { TP p; p.d = (g == 0) ? 1 : (g == 1 ? 4 : 16); p.h12 = 4 * g + hs; p.tb = t0 + r; p.c = c; p.ubase = 32 * c - 160; return p; }
__device__ __forceinline__ void glds16s(const void* sbase, unsigned voff, unsigned lds_dst) { unsigned keep;
    asm volatile("s_mov_b32 %0, m0\n\ts_mov_b32 m0, %3\n\ts_nop 0\n\tglobal_load_lds_dwordx4 %1, %2\n\ts_mov_b32 m0, %0" : "=&s"(keep) : "v"(voff), "s"(sbase), "s"(lds_dst) : "memory"); }
__device__ __forceinline__ void dma_v(const TP& p, const unsigned rowbase, const bf16* __restrict__ VA, const unsigned lds_slot, const int tt, const int lane) {
#pragma unroll
    for (int w = 0; w < 8; ++w) {
        if (tt == 0 && (w & 3) < 2) continue;
        int pos = p.tb + p.d * (p.ubase + 64 * tt + 16 * (w & 3) + (lane >> 2)); pos = pos < 0 ? 0 : (pos > SEQ - 1 ? SEQ - 1 : pos);
        const unsigned off = ((rowbase + (unsigned)pos) * (unsigned)PITCH + (unsigned)(p.h12 * 64 + (w >> 2) * 32 + (lane & 3) * 8)) * 2u;
        glds16s(VA, off, (unsigned)__builtin_amdgcn_readfirstlane(lds_slot + w * 1024));
    }
}
__device__ __forceinline__ void issue_qk(const TP& p, const unsigned rowbase, const bf16* __restrict__ QA, const bf16* __restrict__ KA, bf16x8 (&qr)[4], bf16x8 (&kf)[5][4], const int lane) {
    const int r32 = lane & 31, hi = lane >> 5;
    { int tq = p.tb + p.d * (32 * p.c + r32); tq = tq > SEQ - 1 ? SEQ - 1 : tq;
      const unsigned qo = ((rowbase + (unsigned)tq) * (unsigned)PITCH + (unsigned)(p.h12 * 64 + hi * 8)) * 2u;
#pragma unroll
      for (int d0 = 0; d0 < 4; ++d0) qr[d0] = *reinterpret_cast<const bf16x8*>((const char*)QA + qo + d0 * 32); }
#pragma unroll
    for (int ch = 1; ch < 6; ++ch) {
        int pos = p.tb + p.d * (p.ubase + 32 * ch + r32); pos = pos < 0 ? 0 : (pos > SEQ - 1 ? SEQ - 1 : pos);
        const unsigned ko = ((rowbase + (unsigned)pos) * (unsigned)PITCH + (unsigned)(p.h12 * 64 + hi * 8)) * 2u;
#pragma unroll
        for (int d0 = 0; d0 < 4; ++d0) kf[ch - 1][d0] = *reinterpret_cast<const bf16x8*>((const char*)KA + ko + d0 * 32);
    }
    __builtin_amdgcn_sched_barrier(0);
}
template <bool HAS_NEXT>
__device__ __forceinline__ void task(const TP& p, const TP& nx, const int hs, const unsigned rowbase, const bf16* __restrict__ QA, const bf16* __restrict__ KA, const bf16* __restrict__ VA,
                                     bf16* __restrict__ PO, float* __restrict__ LSE, char* shm, const int vslot, const float* bt, float* wsf, bf16x8 (&qr)[4], bf16x8 (&kf)[5][4], const int lane_in) {
    int lane = lane_in; asm volatile("" : "+v"(lane));
    const int r32 = lane & 31, hi = lane >> 5;
    const unsigned lds0 = (unsigned)(uintptr_t)shm;
    f32x16 sc[6];
#pragma unroll
    for (int ch = 1; ch < 6; ++ch) {
        f32x16 a = f32x16{};
#pragma unroll
        for (int d0 = 0; d0 < 4; ++d0) a = __builtin_amdgcn_mfma_f32_32x32x16_bf16(kf[ch - 1][d0], qr[d0], a, 0, 0, 0);
        sc[ch] = a;
    }
    const int kmin = -p.ubase - p.tb / p.d;
    const int kth = kmin - 4 * hi;
    const float* btl = bt + (r32 - 4 * hi + 192);
    float mx = -INFINITY;
#pragma unroll
    for (int ch = 1; ch < 6; ++ch) {
#pragma unroll
        for (int rr = 0; rr < 16; ++rr) {
            const int kc = 32 * ch + (rr & 3) + 8 * (rr >> 2);
            float v = sc[ch][rr] + btl[-kc];
            if (kmin > 0) { if (kc < kth) v = -INFINITY; }
            sc[ch][rr] = v; mx = fmaxf(mx, v);
        }
        asm volatile("" ::: "memory");
    }
    mx = hswap_max(mx);
    float l = 0.f;
#define DIL_PK(P, B) fox::cvtpk_s(P[B], P[B + 1])
#define DIL_PA(P, B) __builtin_bit_cast(bf16x8, (u32x4){DIL_PK(P, B), DIL_PK(P, B + 2), DIL_PK(P, B + 4), DIL_PK(P, B + 6)})
    bf16x8 pk[6][2];
#pragma unroll
    for (int ch = 1; ch < 6; ++ch) {
#pragma unroll
        for (int rr = 0; rr < 16; ++rr) { const float pe = __builtin_amdgcn_exp2f(sc[ch][rr] - mx); sc[ch][rr] = pe; l += pe; }
        pk[ch][0] = DIL_PA(sc[ch], 0); pk[ch][1] = DIL_PA(sc[ch], 8);
    }
#undef DIL_PK
#undef DIL_PA
    l = hswap_sum(l);
    f32x16 o[2]; o[0] = f32x16{}; o[1] = f32x16{};
    const int vb = (int)(lds0 + vslot) + ((lane >> 4) & 1) * 32 + (lane & 3) * 8 + (4 * hi + ((lane & 15) >> 2)) * 64;
    asm volatile("s_waitcnt vmcnt(0)" ::: "memory");
    pv_hi(o, vb, pk[1][0], pk[1][1]);
    dma_v(p, rowbase, VA, lds0 + vslot, 2, lane);
    fox::pv(o, vb + 8192, pk[2][0], pk[2][1], pk[3][0], pk[3][1]);
    if constexpr (HAS_NEXT) {
        issue_qk(nx, rowbase, QA, KA, qr, kf, lane);
        dma_v(nx, rowbase, VA, lds0 + vslot + 8192, 1, lane);
        asm volatile("s_waitcnt vmcnt(32)" ::: "memory");
    } else {
        asm volatile("s_waitcnt vmcnt(0)" ::: "memory");
    }
    fox::pv(o, vb, pk[4][0], pk[4][1], pk[5][0], pk[5][1]);
    if (hi == 0) wsf[r32] = __builtin_amdgcn_rcpf(l);
    if (hi == 0) __hip_atomic_store(LSE + ((size_t)rowbase + p.tb + p.d * (32 * p.c + r32)) * 4 + hs, mx + __builtin_amdgcn_logf(l), __ATOMIC_RELAXED, __HIP_MEMORY_SCOPE_AGENT);
    asm volatile("s_waitcnt lgkmcnt(0)" ::: "memory");
    typedef __attribute__((address_space(3))) unsigned short* lds_u16p; typedef __attribute__((address_space(3))) const u32x4* lds_v4p;
    { const lds_u16p stg = (lds_u16p)(uintptr_t)(lds0 + vslot) + (4 * hi * 64 + r32);
#pragma unroll
      for (int rr = 0; rr < 16; ++rr) {
          const int q0 = (rr & 3) + 8 * (rr >> 2); const float rl = wsf[q0 + 4 * hi];
          stg[q0 * 64] = (unsigned short)(fox::cvtpk_s(o[0][rr] * rl, 0.f) & 0xffffu); stg[q0 * 64 + 32] = (unsigned short)(fox::cvtpk_s(o[1][rr] * rl, 0.f) & 0xffffu);
      } }
    asm volatile("s_waitcnt lgkmcnt(0)" ::: "memory");
    u32x4 ov[4];
    { const lds_v4p rb = (lds_v4p)(uintptr_t)(lds0 + vslot) + lane;
#pragma unroll
      for (int i = 0; i < 4; ++i) ov[i] = rb[i * 64]; }
    asm volatile("s_waitcnt lgkmcnt(0)" ::: "memory");
    if constexpr (HAS_NEXT) dma_v(nx, rowbase, VA, lds0 + vslot, 0, lane);
#pragma unroll
    for (int i = 0; i < 4; ++i) { const int idx = i * 64 + lane; const int qi = idx >> 3, c8 = idx & 7;
        asm volatile("global_store_dwordx4 %0, %1, off sc1\n\ts_nop 1" :: "v"(PO + ((size_t)rowbase + p.tb + p.d * (32 * p.c + qi)) * 256 + hs * 64 + c8 * 8), "v"(ov[i]) : "memory"); }
}
__device__ __forceinline__ void unit(const int b, const int hs, const int blk, const bf16* QA, const bf16* KA, const bf16* VA, const float* __restrict__ BIAS, bf16* PO0, bf16* PO1, bf16* PO2, float* LSE, bf16* YA,
                                     char* shm, float* bt_all, float* wsf_all, unsigned* pairctr, const int gmask = 7  ) {
    int tid_ = threadIdx.x; asm volatile("" : "+v"(tid_));
    const int tid = tid_, wave = __builtin_amdgcn_readfirstlane(tid >> 6);
    const int t0 = blk * 256, t512 = (blk >> 1) * 512, half = blk & 1;
    const int lane = tid & 63; const unsigned rowbase = (unsigned)b * SEQ; const int vslot = wave * 16384;
    const TP p0 = mk_tp(hs, 0, t0, 0, wave), p1 = mk_tp(hs, 1, t0, wave & 3, wave >> 2), p2 = mk_tp(hs, 2, t512, 8 * half + wave, 0);
    bf16x8 qr[4], kf[5][4];
    const unsigned lds0 = (unsigned)(uintptr_t)shm;
    if (gmask == 7) { dma_v(p0, rowbase, VA, lds0 + vslot, 0, lane); dma_v(p0, rowbase, VA, lds0 + vslot + 8192, 1, lane); issue_qk(p0, rowbase, QA, KA, qr, kf, lane); }
    for (int i = tid; i < 3 * BT_N; i += 512) { const int g = i / BT_N, x = i % BT_N, j = x - 32; bt_all[i] = (j >= 0 && j <= 128) ? BIAS[(4 * g + hs) * 129 + j] : -INFINITY; }
    __syncthreads();
    if (gmask == 7) {
        task<true>(p0, p1, hs, rowbase, QA, KA, VA, PO0, LSE, shm, vslot, bt_all, wsf_all + wave * 64, qr, kf, lane);
        task<true>(p1, p2, hs, rowbase, QA, KA, VA, PO1, LSE + (size_t)M * 4, shm, vslot, bt_all + BT_N, wsf_all + wave * 64, qr, kf, lane);
        task<false>(p2, p2, hs, rowbase, QA, KA, VA, PO2, LSE + (size_t)2 * M * 4, shm, vslot, bt_all + 2 * BT_N, wsf_all + wave * 64, qr, kf, lane);
    }
    asm volatile("s_waitcnt vmcnt(0)" ::: "memory");
    __syncthreads();
    unsigned* tick = (unsigned*)(wsf_all + 512);
    if (tid == 0) *tick = __hip_atomic_fetch_add(pairctr, 1u, __ATOMIC_RELAXED, __HIP_MEMORY_SCOPE_AGENT);
    __syncthreads();
    const bool last = (*tick & 1u) == 1u;
    if (last) {
        if (tid < 64) { __builtin_amdgcn_fence(__ATOMIC_ACQUIRE, "agent"); asm volatile("s_waitcnt vmcnt(0)" ::: "memory"); }
        __syncthreads();
        const size_t row0 = (size_t)b * SEQ + t512;
        for (int it = tid; it < 512 * 8; it += 512) {
            const int tok = it >> 3, c8 = it & 7; const size_t row = row0 + tok;
            float ls[3]; u32x4 pv3[3];
#pragma unroll
            for (int g = 0; g < 3; ++g) { const bf16* POg = g == 0 ? PO0 : (g == 1 ? PO1 : PO2); ls[g] = LSE[((size_t)g * M + row) * 4 + hs]; pv3[g] = *(const u32x4*)(POg + row * 256 + hs * 64 + c8 * 8); }
            const float mm = fmaxf(ls[0], fmaxf(ls[1], ls[2]));
            float w[3]; float ws_ = 0.f;
#pragma unroll
            for (int g = 0; g < 3; ++g) { w[g] = __builtin_amdgcn_exp2f(ls[g] - mm); ws_ += w[g]; }
            const float iw = 1.f / ws_;
            float y[8];
#pragma unroll
            for (int e = 0; e < 8; ++e) y[e] = 0.f;
#pragma unroll
            for (int g = 0; g < 3; ++g) { const float wg = w[g] * iw; const unsigned q[4] = {pv3[g].x, pv3[g].y, pv3[g].z, pv3[g].w};
#pragma unroll
                for (int e = 0; e < 4; ++e) { y[2 * e] += wg * __uint_as_float(q[e] << 16); y[2 * e + 1] += wg * __uint_as_float(q[e] & 0xffff0000u); } }
            u32x4 ov; ov.x = fox::cvtpk_s(y[0], y[1]); ov.y = fox::cvtpk_s(y[2], y[3]); ov.z = fox::cvtpk_s(y[4], y[5]); ov.w = fox::cvtpk_s(y[6], y[7]);
            *(u32x4*)(YA + row * 256 + hs * 64 + c8 * 8) = ov;
        }
    }
    __syncthreads();
}
}
namespace rtr {
using fox::bf16x8; using fox::f32x16; using fox::u32x4;
__device__ __forceinline__ void task(const int t, const int kq, const bool valid, const float* __restrict__ X1, const float* __restrict__ gf, const unsigned short* __restrict__ WRF, const float* __restrict__ router_bias,
                                     unsigned short* __restrict__ H2, float* __restrict__ RINV, unsigned* __restrict__ CNT, unsigned* __restrict__ LIST, float* __restrict__ GATEW, float2* __restrict__ META, unsigned* __restrict__ INV, float* tiles, float* sst, PG8_LAS unsigned* LC  ) {
    int tid_ = threadIdx.x; asm volatile("" : "+v"(tid_));
    if (tid_ < 128) LC[tid_] = 0u;
    const int lane = tid_ & 63, r32 = lane & 31, hi = lane >> 5;
    const size_t row = (size_t)t * 32 + r32;
    const float* xp = X1 + row * D + hi * 8; const float* gp = gf + hi * 8; unsigned short* hp = H2 + row * D + hi * 8;
    const u32x4* wf = (const u32x4*)WRF + lane;
    f32x16 acc[2]; acc[0] = f32x16{}; acc[1] = f32x16{};
    float ss = 0.f;
    if (valid) {
#pragma unroll 4
    for (int k0 = 16 * kq; k0 < 16 * kq + 16; ++k0) {
        const float4 xa = *(const float4*)(xp + k0 * 16), xb = *(const float4*)(xp + k0 * 16 + 4);
        const float4 ga = *(const float4*)(gp + k0 * 16), gb = *(const float4*)(gp + k0 * 16 + 4);
        const u32x4 bh0 = wf[(0 * 64 + k0) * 64], bh1 = wf[(1 * 64 + k0) * 64], bl0 = wf[(2 * 64 + k0) * 64], bl1 = wf[(3 * 64 + k0) * 64];
        const float x[8] = {xa.x, xa.y, xa.z, xa.w, xb.x, xb.y, xb.z, xb.w}; const float gg[8] = {ga.x, ga.y, ga.z, ga.w, gb.x, gb.y, gb.z, gb.w};
        float y[8]; unsigned ph[4], pl[4];
#pragma unroll
        for (int e = 0; e < 8; ++e) { ss += x[e] * x[e]; y[e] = x[e] * gg[e]; }
#pragma unroll
        for (int e = 0; e < 4; ++e) { ph[e] = fox::cvtpk_s(y[2 * e], y[2 * e + 1]);
            pl[e] = fox::cvtpk_s(y[2 * e] - __uint_as_float(ph[e] << 16), y[2 * e + 1] - __uint_as_float(ph[e] & 0xffff0000u)); }
        const u32x4 hv = {ph[0], ph[1], ph[2], ph[3]}, lv = {pl[0], pl[1], pl[2], pl[3]};
        *(u32x4*)(hp + k0 * 16) = hv;
        const bf16x8 ah = __builtin_bit_cast(bf16x8, hv), al = __builtin_bit_cast(bf16x8, lv);
        acc[0] = __builtin_amdgcn_mfma_f32_32x32x16_bf16(ah, __builtin_bit_cast(bf16x8, bh0), acc[0], 0, 0, 0);
        acc[1] = __builtin_amdgcn_mfma_f32_32x32x16_bf16(ah, __builtin_bit_cast(bf16x8, bh1), acc[1], 0, 0, 0);
        acc[0] = __builtin_amdgcn_mfma_f32_32x32x16_bf16(ah, __builtin_bit_cast(bf16x8, bl0), acc[0], 0, 0, 0);
        acc[1] = __builtin_amdgcn_mfma_f32_32x32x16_bf16(ah, __builtin_bit_cast(bf16x8, bl1), acc[1], 0, 0, 0);
        acc[0] = __builtin_amdgcn_mfma_f32_32x32x16_bf16(al, __builtin_bit_cast(bf16x8, bh0), acc[0], 0, 0, 0);
        acc[1] = __builtin_amdgcn_mfma_f32_32x32x16_bf16(al, __builtin_bit_cast(bf16x8, bh1), acc[1], 0, 0, 0);
    }
    { auto rr = __builtin_amdgcn_permlane32_swap(__float_as_uint(ss), __float_as_uint(ss), false, false); ss = __uint_as_float(rr[0]) + __uint_as_float(rr[1]); }
    float* tile = tiles + kq * (32 * 65);
#pragma unroll
    for (int eh = 0; eh < 2; ++eh)
#pragma unroll
        for (int r = 0; r < 16; ++r) tile[((r & 3) + 8 * (r >> 2) + 4 * hi) * 65 + eh * 32 + r32] = acc[eh][r];
    if (hi == 0) sst[kq * 32 + r32] = ss;
    }
    asm volatile("s_waitcnt lgkmcnt(0)" ::: "memory");
    __syncthreads();
    const bool fin = valid && kq == 0;
    int ls[4] = {0, 0, 0, 0}; unsigned lp[4] = {0u, 0u, 0u, 0u}; float gwv[4] = {0.f, 0.f, 0.f, 0.f}; float rinv = 0.f;
#define RT_LOGIT(e_) ((trow[e_] + trow[(e_) + 32 * 65]) + (trow[(e_) + 2 * 32 * 65] + trow[(e_) + 3 * 32 * 65]))
    if (fin) {
    rinv = rsqrtf((sst[r32] + sst[32 + r32] + sst[64 + r32] + sst[96 + r32]) * (1.f / D) + EPS);
    if (hi == 0) RINV[row] = rinv;
    float tv[8]; int ti[8];
#pragma unroll
    for (int p = 0; p < 8; ++p) { tv[p] = -INFINITY; ti[p] = 0; }
    const float* trow = tiles + r32 * 65;
#pragma unroll 4
    for (int e0 = 0; e0 < 32; ++e0) {
        const int e = hi * 32 + e0;
        float v = 1.f / (1.f + __expf(-RT_LOGIT(e) * rinv)) + router_bias[e]; int id = e;
#pragma unroll
        for (int p = 0; p < 8; ++p) { const bool gt = v > tv[p]; const float tvv = tv[p]; const int tii = ti[p]; tv[p] = gt ? v : tvv; ti[p] = gt ? id : tii; v = gt ? tvv : v; id = gt ? tii : id; }
    }
    float ov[8]; int oi[8];
#pragma unroll
    for (int p = 0; p < 8; ++p) { auto a = __builtin_amdgcn_permlane32_swap(__float_as_uint(tv[p]), __float_as_uint(tv[p]), false, false); ov[p] = hi ? __uint_as_float(a[0]) : __uint_as_float(a[1]);
        auto bq = __builtin_amdgcn_permlane32_swap((unsigned)ti[p], (unsigned)ti[p], false, false); oi[p] = hi ? (int)bq[0] : (int)bq[1]; }
#pragma unroll
    for (int q = 0; q < 8; ++q) { float v = ov[q]; int id = oi[q];
#pragma unroll
        for (int p = 0; p < 8; ++p) { const bool gt = (v > tv[p]) || (v == tv[p] && id < ti[p]); const float tvv = tv[p]; const int tii = ti[p]; tv[p] = gt ? v : tvv; ti[p] = gt ? id : tii; v = gt ? tvv : v; id = gt ? tii : id; } }
    float sv[8]; float ssum = 0.f;
#pragma unroll
    for (int p = 0; p < 8; ++p) { sv[p] = 1.f / (1.f + __expf(-RT_LOGIT(ti[p]) * rinv)); ssum += sv[p]; }
    const float sc = 2.5f / ssum;
#pragma unroll
    for (int j = 0; j < 4; ++j) { const int e = hi ? ti[4 + j] : ti[j]; ls[j] = e * 2 + hi; gwv[j] = (hi ? sv[4 + j] : sv[j]) * sc;
        lp[j] = __hip_atomic_fetch_add(LC + ls[j], 1u, __ATOMIC_RELAXED, __HIP_MEMORY_SCOPE_WORKGROUP); }
    }
    asm volatile("s_waitcnt lgkmcnt(0)" ::: "memory");
    __syncthreads();
    if (tid_ < 128) { const unsigned c = LC[tid_]; unsigned base = 0u; if (c != 0u) base = atomicAdd(&CNT[tid_ * CNT_STRIDE], c); LC[128 + tid_] = base; }
    asm volatile("s_waitcnt lgkmcnt(0)" ::: "memory");
    __syncthreads();
    if (fin) {
#pragma unroll
    for (int j = 0; j < 4; ++j) {
        const int l = ls[j], p = 4 * hi + j;
        const unsigned pos = LC[128 + l] + lp[j];
        LIST[(size_t)l * M + pos] = (unsigned)row * 8u + (unsigned)p;
        GATEW[row * 8 + p] = gwv[j];
        META[(size_t)l * M + pos] = make_float2(rinv, gwv[j]);
        INV[row * 8 + p] = ((unsigned)l << 16) | pos;
    }
    }
    asm volatile("s_waitcnt lgkmcnt(0)" ::: "memory");
#undef RT_LOGIT
}
}
#define GAS __attribute__((address_space(1)))
#define LAS __attribute__((address_space(3)))
typedef unsigned short bf16;
typedef unsigned v4u __attribute__((ext_vector_type(4)));
typedef float f32x4 __attribute__((ext_vector_type(4)));
typedef short bf16x8 __attribute__((ext_vector_type(8)));
typedef GAS unsigned gu32;
typedef GAS unsigned long long gu64;
#define RLX_AGENT __ATOMIC_RELAXED, __HIP_MEMORY_SCOPE_AGENT
#define LDS_WAIT() asm volatile("s_waitcnt lgkmcnt(0)" ::: "memory")
#define VM_WAIT() asm volatile("s_waitcnt vmcnt(0)" ::: "memory")
__device__ __forceinline__ unsigned long long rt() { return __builtin_amdgcn_s_memrealtime(); }

#define XB_TMO      128
#define XB_XCNT(j)  (256  + 64 * (j))
#define XB_XSUB(j)  (1280 + 64 * (j))
#define XB_XGEN(j)  (2304 + 64 * (j))
#define XB_TOP      3328
#define XB_TOPGEN   3392
#define XCD_BAR_WORDS 3456
#define XB_SPIN_CAP (1u << 18)

__device__ __forceinline__ unsigned xb_ld(unsigned* p)              { return __hip_atomic_load(p, __ATOMIC_RELAXED, __HIP_MEMORY_SCOPE_AGENT); }
__device__ __forceinline__ unsigned xb_add(unsigned* p, unsigned v) { return __hip_atomic_fetch_add(p, v, __ATOMIC_RELAXED, __HIP_MEMORY_SCOPE_AGENT); }
__device__ __forceinline__ unsigned xb_xcc_id() { return (unsigned)__builtin_amdgcn_s_getreg((3 << 11) | 20) & 0xFu; }
#define XB_SPIN(cond, bar) do { unsigned _sp = 0; while (cond) { __builtin_amdgcn_s_sleep(1); \
    if ((++_sp & 255u) == 0u) { if (xb_ld(&(bar)[XB_TMO])) break; if (_sp > XB_SPIN_CAP) { atomicAdd(&(bar)[XB_TMO], 1u); break; } } } } while (0)

struct XcdBarrier {
    unsigned* bar; unsigned x;
    volatile LAS unsigned* st;
};

__device__ __forceinline__ XcdBarrier xcd_barrier_post(unsigned* bar, volatile LAS unsigned* st) {
    XcdBarrier b; b.bar = bar; b.x = xb_xcc_id(); b.st = st;
    if (threadIdx.x == 0) (void)xb_add(&bar[XB_XCNT(b.x)], 1u);
    return b;
}
__device__ __forceinline__ void xcd_barrier_complete(unsigned* bar, unsigned x, unsigned& nloc, unsigned& nx) {
    const unsigned G = gridDim.x * gridDim.y * gridDim.z;
    unsigned sum, cnt, mine, sp = 0u;
    for (;;) {
        sum = 0u; cnt = 0u; mine = 0u;
#pragma unroll
        for (unsigned j = 0; j < 16; ++j) { const unsigned c = xb_ld(&bar[XB_XCNT(j)]); sum += c; cnt += (c > 0u) ? 1u : 0u; mine = (j == x) ? c : mine; }
        if (sum == G) break;
        __builtin_amdgcn_s_sleep(1);
        if ((++sp & 255u) == 0u) { if (xb_ld(&bar[XB_TMO])) break; if (sp > XB_SPIN_CAP) { atomicAdd(&bar[XB_TMO], 1u); break; } }
    }
    nloc = mine > 0u ? mine : 1u; nx = cnt > 0u ? cnt : 1u;
}

__device__ __forceinline__ void xcd_barrier(const XcdBarrier& b) {
    asm volatile("s_waitcnt vmcnt(0)" ::: "memory");
    __syncthreads();
    if (threadIdx.x == 0) {
        unsigned* bar = b.bar;
        __builtin_amdgcn_s_waitcnt(0);
        unsigned nloc = b.st[0], nx = b.st[1];
        if (nloc == 0u) { xcd_barrier_complete(bar, b.x, nloc, nx); b.st[0] = nloc; b.st[1] = nx; }
        const unsigned old = xb_add(&bar[XB_XSUB(b.x)], 1u);
        const unsigned gen = old / nloc;
        if (old + 1u == (gen + 1u) * nloc) {
            __builtin_amdgcn_fence(__ATOMIC_RELEASE, "agent");
            asm volatile("s_waitcnt vmcnt(0)" ::: "memory");
            const unsigned og = xb_add(&bar[XB_TOP], 1u);
            const unsigned tg = og / nx;
            if (og + 1u == (tg + 1u) * nx) xb_add(&bar[XB_TOPGEN], 1u);
            else XB_SPIN(xb_ld(&bar[XB_TOPGEN]) == tg, bar);
            __builtin_amdgcn_fence(__ATOMIC_ACQUIRE, "agent");
            xb_add(&bar[XB_XGEN(b.x)], 1u);
            asm volatile("s_waitcnt vmcnt(0)" ::: "memory");
        } else {
            XB_SPIN(xb_ld(&bar[XB_XGEN(b.x)]) == gen, bar);
            __builtin_amdgcn_fence(__ATOMIC_ACQUIRE, "agent");
            asm volatile("s_waitcnt vmcnt(0)" ::: "memory");
        }
    }
    __syncthreads();
}
constexpr int NWAVES = 8;
constexpr int RING_OFF = 0, RING_BYTES = 131072;
constexpr int LDSCTL_OFF = RING_BYTES, MISC_OFF = LDSCTL_OFF + 320;
constexpr int TB_CNT = LDSCTL_OFF + 1024, TB_HB = LDSCTL_OFF + 2048, TB_T6 = LDSCTL_OFF + 3072, TB_TA = LDSCTL_OFF + 4096, TB_TB = LDSCTL_OFF + 5120, TB_T9 = LDSCTL_OFF + 6144, TB_UT = LDSCTL_OFF + 7168;
constexpr int LDS_BYTES = 147456;
constexpr int CW_TMO = 0, CW_CODE = 1, CW_BAR = 4096;
constexpr int N_IN = 16 * 60, N_G = 16 * 32, N_PA = 4 * 16, N_PB = 8 * 16, N_O = 16 * 16, N_EX = 65 * 128, N_W2 = 65 * 64;
constexpr int N_FILL1 = 0;    constexpr int N_FILL2 = 8320;
constexpr int NITEMS = N_IN + N_G + N_PA + N_PB + N_O + N_EX - N_FILL1 - N_FILL2;
constexpr int NPHASE = 10;
constexpr int NTOT1 = 3840 + 2048;
struct MArgs { const float* in[23]; float* out; unsigned char* ws; int ph_lo, ph_hi, li, pad; };

__device__ __forceinline__ void tr64_load(f32x4 (&v)[16], const float* W, int ldw, int k0, int n0, int lane) {
    const int lq = lane >> 4, n4 = lane & 15;
    const GAS f32x4* src = (const GAS f32x4*)(W + (size_t)(k0 + 2 * lq) * ldw + n0 + 4 * n4);
#pragma unroll
    for (int j = 0; j < 16; ++j) v[j] = src[((size_t)(8 * (j >> 1) + (j & 1)) * ldw) >> 2];
}
__device__ __forceinline__ void tr64_store(const f32x4 (&v)[16], int k0, bf16* WT, int K, int base_row, int hstride, LAS unsigned* T, int lane) {
    const int lq = lane >> 4, n4 = lane & 15;
#pragma unroll
    for (int p = 0; p < 8; ++p)
#pragma unroll
        for (int e = 0; e < 4; ++e) T[(4 * n4 + e) * 33 + 4 * p + lq] = pg8::cvtc(v[2 * p][e], v[2 * p + 1][e]);
    LDS_WAIT(); asm volatile("" ::: "memory");
    const int c = lane & 7;
#pragma unroll
    for (int j = 0; j < 8; ++j) { const int n = (lane >> 3) + 8 * j; const LAS unsigned* s = T + n * 33 + 4 * c;
        v4u o; o.x = s[0]; o.y = s[1]; o.z = s[2]; o.w = s[3];
        *(GAS v4u*)(WT + (size_t)(base_row + hstride * (n >> 5) + (n & 31)) * K + k0 + 8 * c) = o; }
    LDS_WAIT(); asm volatile("" ::: "memory");
}
__device__ __forceinline__ void p0_tr64(const float* W, int ldw, int k0, int n0, bf16* WT, int K, int base_row, int hstride, LAS unsigned* T, int lane) {
    f32x4 v[16];
    tr64_load(v, W, ldw, k0, n0, lane);
    tr64_store(v, k0, WT, K, base_row, hstride, T, lane);
}
__device__ __forceinline__ void p0_tr64_f8(const float* W, int ldw, int k0, int n0, unsigned char* WT, int K, int base_row, int hstride, float sc, LAS unsigned* T, int lane) {
    const int lq = lane >> 4, n4 = lane & 15;
    const GAS f32x4* src = (const GAS f32x4*)(W + (size_t)(k0 + 4 * lq) * ldw + n0 + 4 * n4);
    f32x4 v[16];
#pragma unroll
    for (int j = 0; j < 16; ++j) v[j] = src[((size_t)(16 * (j >> 2) + (j & 3)) * ldw) >> 2];
#pragma unroll
    for (int p = 0; p < 4; ++p)
#pragma unroll
        for (int e = 0; e < 4; ++e) { int w = __builtin_amdgcn_cvt_pk_fp8_f32(v[4 * p][e] * sc, v[4 * p + 1][e] * sc, 0, false); w = __builtin_amdgcn_cvt_pk_fp8_f32(v[4 * p + 2][e] * sc, v[4 * p + 3][e] * sc, w, true);
            T[(4 * n4 + e) * 17 + 4 * p + lq] = (unsigned)w; }
    LDS_WAIT(); asm volatile("" ::: "memory");
    const int c = lane & 3;
#pragma unroll
    for (int j = 0; j < 4; ++j) { const int n = (lane >> 2) + 16 * j; const LAS unsigned* s = T + n * 17 + 4 * c;
        v4u o; o.x = s[0]; o.y = s[1]; o.z = s[2]; o.w = s[3];
        *(GAS v4u*)(WT + (size_t)(base_row + hstride * (n >> 5) + (n & 31)) * K + k0 + 16 * c) = o; }
    LDS_WAIT(); asm volatile("" ::: "memory");
}
__device__ __forceinline__ void rms_row(const float* xrow, const float* g, bf16* orow, const LAS float* wt8, const float* b_forget, float* logf_row, int lane) {
    const GAS f32x4* xr = (const GAS f32x4*)xrow;
    f32x4 v[4]; float ss = 0.f;
#pragma unroll
    for (int j = 0; j < 4; ++j) { v[j] = xr[lane + 64 * j]; ss += v[j].x * v[j].x + v[j].y * v[j].y + v[j].z * v[j].z + v[j].w * v[j].w; }
    ss = wave_sum(ss);
    const float rinv = rsqrtf(ss * (1.f / D) + EPS);
    float f[8];
#pragma unroll
    for (int c = 0; c < 8; ++c) f[c] = 0.f;
#pragma unroll
    for (int j = 0; j < 4; ++j) {
        const f32x4 gg = ((const GAS f32x4*)g)[lane + 64 * j];
        float y[4] = {v[j].x * rinv * gg.x, v[j].y * rinv * gg.y, v[j].z * rinv * gg.z, v[j].w * rinv * gg.w};
        u32x2 o; o.x = pg8::cvtc(y[0], y[1]); o.y = pg8::cvtc(y[2], y[3]);
        *(GAS u32x2*)(orow + 4 * (lane + 64 * j)) = o;
        if (wt8) {
#pragma unroll
            for (int c = 0; c < 8; ++c) { const f32x4 w = *(const LAS f32x4*)(wt8 + c * 1024 + 4 * (lane + 64 * j)); f[c] += (y[0] * w.x + y[1] * w.y) + (y[2] * w.z + y[3] * w.w); }
        }
    }
    if (wt8) {
#pragma unroll
        for (int c = 0; c < 8; ++c) f[c] = wave_sum(f[c]);
        float mine = f[0];
#pragma unroll
        for (int c = 1; c < 8; ++c) mine = (lane == c) ? f[c] : mine;
        if (lane < 8) { const float z = mine + b_forget[lane]; logf_row[lane] = fminf(z, 0.f) - log1pf(expf(-fabsf(z))); }
    }
}
__device__ __forceinline__ void p1_cumsum(int bh, const float* LOGF, float* C, bf16* KAUG, LAS float* sc, int tid, const float* qnb, const float* knb, int* FT0) {
    const int b = bh >> 3, h = bh & 7;
    float loc[16]; float run = 0.f;
#pragma unroll
    for (int e = 0; e < 16; ++e) { run += LOGF[((size_t)b * SEQ + 16 * tid + e) * 8 + h]; loc[e] = run; }
    sc[tid] = run; __syncthreads();
    for (int o = 1; o < 512; o <<= 1) { const float t = (tid >= o) ? sc[tid - o] : 0.f; __syncthreads(); sc[tid] += t; __syncthreads(); }
    const float base = sc[tid] - run;
#pragma unroll
    for (int e = 0; e < 16; ++e) {
        const float c = base + loc[e]; const int t = 16 * tid + e;
        C[(size_t)bh * SEQ + t] = c;
        const float vv = -c * LOG2E;
        const unsigned p0 = f2bf(vv); const float r1 = vv - __uint_as_float(p0 << 16);
        const unsigned p1 = f2bf(r1); const float r2 = r1 - __uint_as_float(p1 << 16);
        const unsigned p2 = f2bf(r2);
        v4u o; o.x = p0 | (p1 << 16); o.y = p2 | (0x3F80u << 16); o.z = 0x3F803F80u; o.w = 0u;
        *(GAS v4u*)(KAUG + (((size_t)b * SEQ + t) * 8 + h) * 8) = o;
        sc[512 + t] = c;
    }
    __syncthreads();
    if (tid < 64) {
        const int lane = tid; const float gq = wave_max(fabsf(qnb[lane])), gk = wave_max(fabsf(knb[lane]));
        const float thr = 2.f * 8.f * gq * gk * 1.03f + 20.f;
        int cost = 0;
        if (lane < 32) { const int q0 = 256 * lane; const float c0 = sc[512 + q0]; int lo = 0, hi = q0;
            while (lo < hi) { const int mid = (lo + hi) >> 1; if (c0 - sc[512 + mid] >= -thr) hi = mid; else lo = mid + 1; }
            int T0 = (lo >> 6) & ~1; if (T0 > 4 * lane) T0 = 4 * lane; FT0[bh * 32 + lane] = T0; cost = 4 * lane + 4 - T0; }
#pragma unroll
        for (int o = 1; o < 64; o <<= 1) cost += __shfl_xor(cost, o);
        if (lane == 0) FT0[512 + bh] = cost;
    }
    __syncthreads();
}

__device__ __forceinline__ unsigned wave_excl_scan(unsigned v, int lane, unsigned& total) {
    unsigned x = v;
#pragma unroll
    for (int o = 1; o < 64; o <<= 1) { const unsigned y = __shfl_up(x, o); if (lane >= o) x += y; }
    total = __shfl(x, 63); return x - v;
}
__device__ __forceinline__ void moe_tables(LAS unsigned char* L, const gu32* CNT, int tid) {
    asm volatile("" : "+v"(tid));
    if (tid < 64) {
        const int lane = tid;
        const unsigned c0 = __hip_atomic_load(CNT + (2 * lane) * CNT_STRIDE, RLX_AGENT), c1 = __hip_atomic_load(CNT + (2 * lane + 1) * CNT_STRIDE, RLX_AGENT);
        const unsigned t0 = (c0 + 255u) >> 8, t1 = (c1 + 255u) >> 8;
        unsigned tc, ta, tbb, t6;
        const unsigned hb = wave_excl_scan(c0 + c1, lane, tc), pa = wave_excl_scan(t0, lane, ta), pb = wave_excl_scan(t1, lane, tbb), p6 = wave_excl_scan((c0 + c1 + 255u) >> 8, lane, t6);
        LAS unsigned* cntL = (LAS unsigned*)(L + TB_CNT); LAS unsigned* hbL = (LAS unsigned*)(L + TB_HB); LAS unsigned* T6 = (LAS unsigned*)(L + TB_T6);
        LAS unsigned* TA = (LAS unsigned*)(L + TB_TA); LAS unsigned* TBt = (LAS unsigned*)(L + TB_TB); LAS unsigned* T9 = (LAS unsigned*)(L + TB_T9);
        cntL[2 * lane] = c0; cntL[2 * lane + 1] = c1; hbL[2 * lane] = hb; hbL[2 * lane + 1] = hb + c0;
        T6[lane] = p6; TA[lane] = pa; TBt[lane] = pb;
        if (lane == 0) { cntL[128] = (unsigned)M; hbL[128] = 0u; T6[64] = t6; T6[65] = t6 + (unsigned)(M / 256); TA[64] = ta; TBt[64] = tbb; T9[0] = 0u; T9[1] = (unsigned)(M / 256); }
    }
    __syncthreads();
}

__device__ __forceinline__ void conv_w1_item(int r, const float* wg_e, const float* wu_e, const float* wg_s, const float* wu_s, bf16* W1, LAS unsigned* scr, int lane) {
    const int e = r >> 7, q = r & 127, up = q >> 6, qq = q & 63, kb = qq >> 2, nb = qq & 3;
    const float* src = (e < NE) ? (up ? wu_e : wg_e) + (size_t)e * D * DE : (up ? wu_s : wg_s);
    p0_tr64(src, DE, 64 * kb, 64 * nb, W1 + (size_t)e * 512 * D, D, 256 * (nb >> 1) + 128 * up + 64 * (nb & 1), 32, scr, lane);
}
__global__ void __launch_bounds__(NWAVES * 64, 2) mega(MArgs args) {
    extern __shared__ __attribute__((aligned(16))) unsigned char lds[];
    LAS unsigned char* L = (LAS unsigned char*)lds;
    volatile LAS unsigned* MISC = (volatile LAS unsigned*)(L + MISC_OFF);
    const int tid = threadIdx.x, lane = tid & 63, wave = __builtin_amdgcn_readfirstlane(tid >> 6);
    const int G = gridDim.x; const int bx = blockIdx.x; const int vcu = (G % 8 == 0) ? (bx % 8) * (G / 8) + bx / 8 : bx;
    unsigned char* ws = args.ws;
    gu32* ctl = (gu32*)(ws + WS_CTL);
#ifdef RERUN_PHASE
#define PROBE_RR (args.li != 0)
#else
#define PROBE_RR false
#endif
    for (int u = tid; u < (LDS_BYTES - LDSCTL_OFF) / 4; u += NWAVES * 64) ((LAS unsigned*)(L + LDSCTL_OFF))[u] = 0u;
    __syncthreads();
    XcdBarrier bar = xcd_barrier_post((unsigned*)(ctl + CW_BAR) + args.li * 28672  , MISC + 8);
#ifdef DIAG_TS
#define GRID_BAR() do { const unsigned long long t0_ = rt(); xcd_barrier(bar); if (bx == DIAG_BLK && tid == 0) ((unsigned long long*)(ws + WS_CTL + 512 * 1024))[20] += rt() - t0_; } while (0)
#else
#define GRID_BAR() xcd_barrier(bar)
#endif
#ifdef RERUN_GMASK
#define DIL_GMASK (PROBE_RR ? RERUN_GMASK : 7)
#else
#define DIL_GMASK 7
#endif
#ifdef RERUN_NOEPI
#define PROBE_NOEPI (PROBE_RR ? 1 : 0)
#else
#define PROBE_NOEPI 0
#endif
#define VCU() ((G % 8 == 0) ? ((int)blockIdx.x % 8) * (G / 8) + (int)blockIdx.x / 8 : (int)blockIdx.x)
#ifndef REPEAT_PHASE
#define REPEAT_PHASE (-1)
#endif
#define NREP(k) (((REPEAT_PHASE) == (k)) ? 2 : 1)
#ifdef REPEAT_BARRIER
#define REP_BAR() do { if (rep_ > 0) GRID_BAR(); } while (0)
#else
#define REP_BAR() do {} while (0)
#endif
#ifndef EXTRA_BARRIERS
#define EXTRA_BARRIERS 0
#endif
#ifdef DIAG_TS
#define TSTAMP(k) do { if (bx == DIAG_BLK && tid == 0) ((unsigned long long*)(ws + WS_CTL + 512 * 1024))[k] = rt(); } while (0)
#else
#define TSTAMP(k) do {} while (0)
#endif
    const int lo = args.ph_lo, hi = args.ph_hi;
#define IN(k) (lo <= (k) && (k) < hi)
#define BOTH(k) (IN(k) && IN((k) + 1))

    TSTAMP(0);
    if (IN(0)) {
        const float* x = args.in[0]; const float* g_mix = args.in[1]; const float* w_in = args.in[2]; const float* rel_bias = args.in[7]; const float* b_forget = args.in[8]; const float* w_gate = args.in[9]; const float* wpa = args.in[11]; const float* wpb = args.in[12]; const float* w_out = args.in[13]; const float* w_router = args.in[15]; const float* wg_e = args.in[17]; const float* wu_e = args.in[18]; const float* wd_e = args.in[19]; const float* wg_s = args.in[20]; const float* wu_s = args.in[21]; const float* wd_s = args.in[22]; bf16* XN = (bf16*)(ws + WS_XN); bf16* WIN_t = (bf16*)(ws + WS_WIN); bf16* WPA_t = (bf16*)(ws + WS_WIN) + (size_t)NTOT1 * D; bf16* WPB_t = (bf16*)(ws + WS_WIN) + (size_t)NTOT1 * D + (size_t)D * OUTA; bf16* WOUT_t = (bf16*)(ws + WS_WIN) + (size_t)NTOT1 * D + (size_t)D * OUTA + (size_t)D * OUTB; bf16* W1 = (bf16*)(ws + WS_W1); bf16* W2 = (bf16*)(ws + WS_W2); float* LOGF = (float*)(ws + WS_LOGF); float* BIAS = (float*)(ws + WS_BIAS);
        _Pragma("unroll") for (int rep_ = 0; rep_ < NREP(0); ++rep_) { REP_BAR();
        LAS unsigned* scr = (LAS unsigned*)(L + RING_OFF + wave * 8704);
        LAS float* wt8 = (LAS float*)(L + RING_OFF + 8 * 8704);
        const int gw = vcu * NWAVES + wave, NGW = G * NWAVES;
        for (int i = tid; i < 8 * D; i += NWAVES * 64) { const int ii = i >> 3, c = i & 7; wt8[c * D + ii] = w_in[(size_t)ii * DIN + (WA + WB) + c]; }
        for (int it = gw; it < NITEMS; it += NGW) {
            int r = it;
            if (r < N_EX - N_FILL1 - N_FILL2) { conv_w1_item(r + N_FILL1 + N_FILL2, wg_e, wu_e, wg_s, wu_s, W1, scr, lane); continue; } r -= N_EX - N_FILL1 - N_FILL2;
            if (r < N_IN) { const int kb = r / 60, nb = r % 60, c = 64 * nb;
                p0_tr64(w_in, DIN, 64 * kb, c, WIN_t, D, 256 * (c / 256) + 32 * ((c % 256) / 64), 128, scr, lane); continue; } r -= N_IN;
            if (r < N_G) { const int kb = r >> 5, nb = r & 31; p0_tr64(w_gate, 2 * D, 64 * kb, 64 * nb, WIN_t, D, 3840 + 64 * nb, 32, scr, lane); continue; } r -= N_G;
            if (r < N_PA) { const int kb = r >> 4, nb = r & 15; p0_tr64(wpa, D, 64 * kb, 64 * nb, WPA_t, OUTA, 64 * nb, 32, scr, lane); continue; } r -= N_PA;
            if (r < N_PB) { const int kb = r >> 4, nb = r & 15; p0_tr64(wpb, D, 64 * kb, 64 * nb, WPB_t, OUTB, 64 * nb, 32, scr, lane); continue; } r -= N_PB;
            { const int kb = r >> 4, nb = r & 15; p0_tr64(w_out, D, 64 * kb, 64 * nb, WOUT_t, D, 64 * nb, 32, scr, lane); }
        }
        __syncthreads();
        for (int m = gw; m < M; m += NGW) rms_row(x + (size_t)m * D, g_mix, XN + (size_t)m * D, wt8, b_forget, LOGF + (size_t)m * 8, lane);
        if (bx == 0) for (int i = tid; i < HA * 129; i += NWAVES * 64) {
            const int head = i / 129, j = i % 129, g = head >> 2; const int d = (g == 0) ? 1 : (g == 1 ? 4 : 16);
            const int dist = d * j; int bucket;
            if (dist < 16) bucket = dist;
            else { const int large = 16 + (int)(__log2f((float)dist * 0.0625f) * (16.f / 7.f)); bucket = large < 31 ? large : 31; }
            BIAS[head * 129 + j] = rel_bias[bucket * HA + head] * LOG2E;
        }
        { unsigned* WRFw = (unsigned*)(ws + WS_WRF);
          for (int i = bx * (NWAVES * 64) + tid; i < 2 * 64 * 64; i += G * NWAVES * 64) {
              const int ln = i & 63, k0 = (i >> 6) & 63, eh = i >> 12; const int e = eh * 32 + (ln & 31), kb = 16 * k0 + 8 * (ln >> 5);
              float wv[8]; unsigned ph[4], pl[4];
#pragma unroll
              for (int j = 0; j < 8; ++j) wv[j] = w_router[(size_t)(kb + j) * NE + e];
#pragma unroll
              for (int j = 0; j < 4; ++j) { ph[j] = pk2(wv[2 * j], wv[2 * j + 1]); pl[j] = pk2(wv[2 * j] - __uint_as_float(ph[j] << 16), wv[2 * j + 1] - __uint_as_float(ph[j] & 0xffff0000u)); }
              v4u hv; hv.x = ph[0]; hv.y = ph[1]; hv.z = ph[2]; hv.w = ph[3]; v4u lv; lv.x = pl[0]; lv.y = pl[1]; lv.z = pl[2]; lv.w = pl[3];
              *(GAS v4u*)(WRFw + ((size_t)((0 + eh) * 64 + k0) * 64 + ln) * 4) = hv; *(GAS v4u*)(WRFw + ((size_t)((2 + eh) * 64 + k0) * 64 + ln) * 4) = lv;
          } }
        }
        if (BOTH(0)) GRID_BAR();
    }

    TSTAMP(1);
    if (IN(1)) {
        const float* qna = args.in[3]; const float* kna = args.in[4]; const float* qnb = args.in[5]; const float* knb = args.in[6]; const float* b_gate = args.in[10]; bf16* Gb = PROBE_RR ? (bf16*)(ws + WS_H) : (bf16*)args.out; bf16* XN = (bf16*)(ws + WS_XN); bf16* WIN_t = (bf16*)(ws + WS_WIN); float* LOGF = (float*)(ws + WS_LOGF); float* Cc = (float*)(ws + WS_C); bf16* KAUG = (bf16*)(ws + WS_KAUG); int* FT0 = (int*)(ws + WS_FT0); const float* wg_e = args.in[17]; const float* wu_e = args.in[18]; const float* wg_s = args.in[20]; const float* wu_s = args.in[21]; bf16* W1 = (bf16*)(ws + WS_W1);
        _Pragma("unroll") for (int rep_ = 0; rep_ < 1; ++rep_) {
        if (G >= 16 && bx >= G - 16) p1_cumsum(bx - (G - 16), LOGF, Cc, KAUG, (LAS float*)(L + RING_OFF), tid, qnb, knb, FT0);
        else if (G < 16 && bx == 0) for (int bh = 0; bh < 16; ++bh) p1_cumsum(bh, LOGF, Cc, KAUG, (LAS float*)(L + RING_OFF), tid, qnb, knb, FT0);
        pg8::Gemm g{XN, WIN_t, M, NTOT1, D}; pg8::RepOrder S; S.init(M, NTOT1, G, bx); S.nrep = NREP(1);
        pg8::EpiQKVG E{ws, Gb, qna, kna, qnb, knb, b_gate};
        pg8::gemm_phase<pg8::EpiQKVG, pg8::RepOrder, true, true>(L + RING_OFF, g, S, E);
        { const int nfull = (M / 256) * (NTOT1 / 256) % G;
          if (nfull != 0 && bx >= nfull) { const int nw = (G - nfull) * NWAVES; for (int it = (bx - nfull) * NWAVES + wave; it < N_FILL1; it += nw) conv_w1_item(it, wg_e, wu_e, wg_s, wu_s, W1, (LAS unsigned*)(L + RING_OFF + wave * 8704), lane); }
          else if (nfull == 0) { for (int it = bx * NWAVES + wave; it < N_FILL1; it += G * NWAVES) conv_w1_item(it, wg_e, wu_e, wg_s, wu_s, W1, (LAS unsigned*)(L + RING_OFF + wave * 8704), lane); } }
        }
        if (BOTH(1)) GRID_BAR();
    }


    TSTAMP(2);
    if (IN(2)) {
        float* Cc = (float*)(ws + WS_C); bf16* KAUG = (bf16*)(ws + WS_KAUG); float* BIAS = (float*)(ws + WS_BIAS); int* FT0 = (int*)(ws + WS_FT0); const float* wd_e = args.in[19]; const float* wd_s = args.in[22]; bf16* W2 = (bf16*)(ws + WS_W2); const float* wg_e = args.in[17]; const float* wu_e = args.in[18]; const float* wg_s = args.in[20]; const float* wu_s = args.in[21]; bf16* W1 = (bf16*)(ws + WS_W1);
        _Pragma("unroll") for (int rep_ = 0; rep_ < NREP(2); ++rep_) { REP_BAR();
#ifdef RERUN_VARIANT
        if (!(PROBE_RR && RERUN_VARIANT >= 2))
#endif
        for (int au = VCU(); au < 2 * 4 * 32; au += G) {
            const int bb = au >> 7, hs = (au >> 5) & 3, blk = au & 31;
            dil::unit(bb, hs, blk, (const fox::bf16*)(ws + WS_QA), (const fox::bf16*)(ws + WS_KA), (const fox::bf16*)(ws + WS_VA), BIAS,
                      (fox::bf16*)(ws + WS_WIN), (fox::bf16*)(ws + WS_XN + 24 * MiB), (fox::bf16*)(ws + WS_LIST), (float*)(ws + WS_WIN + 8 * MiB), (fox::bf16*)(ws + WS_YA),
                      (char*)lds + RING_OFF, (float*)((char*)lds + LDSCTL_OFF + 8192), (float*)((char*)lds + LDSCTL_OFF + 12288), (unsigned*)(ctl + CW_APAIR + 32 * ((bb * 4 + hs) * 16 + (blk >> 1))), DIL_GMASK);
        }
        if (tid < 16) { const int my = FT0[512 + tid]; int rank = 0;
            for (int o = 0; o < 16; ++o) { const int c2 = FT0[512 + o]; rank += (c2 > my || (c2 == my && o < tid)) ? 1 : 0; }
            MISC[24 + rank] = (unsigned)tid; }
        __syncthreads();
        gu32* qhead = ctl + CW_Q2 + 64 * rep_ + 128 * args.li;
        if (tid == 0) MISC[16] = (unsigned)VCU();
        __syncthreads();
        for (;;) {
            const unsigned u = MISC[16];
            __syncthreads();
            constexpr unsigned NFCH = (unsigned)((N_W2 + N_FILL2 + 31) / 32);
            if (u >= 512u + NFCH) break;
            int fox_u = -1, fill_c = -1;
            { const unsigned v = u; if (v < 2u * NFCH) { if ((v & 1u) == 0u) fox_u = (int)(v >> 1); else fill_c = (int)(v >> 1); } else fox_u = (int)(v - NFCH); }
            static_assert((N_W2 + N_FILL2 + 31) / 32 <= 512, "filler chunks interleave one per FoX unit");
#ifdef RERUN_VARIANT
            const bool skip_ = PROBE_RR && ((RERUN_VARIANT == 1) || (RERUN_VARIANT == 2 && fox_u < 0) || (RERUN_VARIANT == 3 && fox_u >= 0));
#else
            const bool skip_ = false;
#endif
            unsigned nxt_u = 0u; if (tid == 0) nxt_u = __hip_atomic_fetch_add(qhead, 1u, RLX_AGENT) + (unsigned)G;
            if (skip_) {
            } else if (fill_c >= 0) {
                for (int k4 = 0; k4 < 4; ++k4) {
                const int r = fill_c * 32 + k4 * 8 + wave;
                if (r >= N_W2) { if (r < N_W2 + N_FILL2) conv_w1_item(N_FILL1 + r - N_W2, wg_e, wu_e, wg_s, wu_s, W1, (LAS unsigned*)(L + RING_OFF + wave * 8704), lane); }
                else { const int e = r >> 6, qq = r & 63, kb = qq >> 4, nb = qq & 15;
                    if (e < NE) p0_tr64_f8(wd_e + (size_t)e * DE * D, D, 64 * kb, 64 * nb, (unsigned char*)W2 + (size_t)e * D * DE, DE, 256 * (nb >> 2) + 32 * (nb & 3), 128, 16.f, (LAS unsigned*)(L + RING_OFF + wave * 8704), lane);
                    else p0_tr64(wd_s, D, 64 * kb, 64 * nb, W2 + (size_t)e * D * DE, DE, 256 * (nb >> 2) + 32 * (nb & 3), 128, (LAS unsigned*)(L + RING_OFF + wave * 8704), lane); }
                }
            } else {
                const int fu = fox_u; const int bh = __builtin_amdgcn_readfirstlane((int)MISC[24 + (fu >> 5)]), qb = 31 - (fu & 31); const int T0 = __builtin_amdgcn_readfirstlane(FT0[bh * 32 + qb]);
                fox::attn_unit<8>(bh >> 3, bh & 7, qb, T0, (const fox::bf16*)(ws + WS_QB), (const fox::bf16*)(ws + WS_KB), (const fox::bf16*)(ws + WS_VB), (const fox::bf16*)KAUG, Cc + (size_t)bh * SEQ,
                                  (fox::bf16*)(ws + WS_YB), (char*)lds + RING_OFF);
            }
            if (tid == 0) MISC[16] = nxt_u;
            __syncthreads();
        }
        }
        if (BOTH(2)) GRID_BAR();
    }
    TSTAMP(3);
    if (IN(3)) {
        const float* x = args.in[0]; bf16* Gb = PROBE_RR ? (bf16*)(ws + WS_H) : (bf16*)args.out; bf16* WPA_t = (bf16*)(ws + WS_WIN) + (size_t)NTOT1 * D; bf16* WPB_t = (bf16*)(ws + WS_WIN) + (size_t)NTOT1 * D + (size_t)D * OUTA;
        _Pragma("unroll") for (int rep_ = 0; rep_ < 1; ++rep_) {
        bf16* YAb = (bf16*)(ws + WS_YA); bf16* YBb = (bf16*)(ws + WS_YB); bf16* MG = (bf16*)(ws + WS_MERGED); bf16* TMPM = (bf16*)(ws + WS_R2 + 32 * MiB);
        pg8::RepOrder S; S.init(M, D, G, bx); S.nrep = NREP(3);
        if ((VCU() & 1) == 0) {
        { pg8::Gemm g{YAb, WPA_t, M, D, OUTA}; pg8::EpiMergeA E{Gb, TMPM, 0u}; pg8::gemm_phase<pg8::EpiMergeA, pg8::RepOrder, true, true>(L + RING_OFF, g, S, E); }
        { pg8::Gemm g{YBb, WPB_t, M, D, OUTB}; pg8::EpiMergeB E{Gb, TMPM, MG, 1024u}; pg8::gemm_phase<pg8::EpiMergeB, pg8::RepOrder, true, true>(L + RING_OFF, g, S, E); }
        } else {
        { pg8::Gemm g{YBb, WPB_t, M, D, OUTB}; pg8::EpiMergeA E{Gb, TMPM, 1024u}; pg8::gemm_phase<pg8::EpiMergeA, pg8::RepOrder, true, true>(L + RING_OFF, g, S, E); }
        { pg8::Gemm g{YAb, WPA_t, M, D, OUTA}; pg8::EpiMergeB E{Gb, TMPM, MG, 0u}; pg8::gemm_phase<pg8::EpiMergeB, pg8::RepOrder, true, true>(L + RING_OFF, g, S, E); }
        }
        }
        if (BOTH(3)) GRID_BAR();
    }
    TSTAMP(4);
    if (IN(4)) {
        const float* x = args.in[0]; const float* g_ffn = args.in[14]; float* out_w = PROBE_RR ? (float*)(ws + WS_H) : args.out; bf16* WOUT_t = (bf16*)(ws + WS_WIN) + (size_t)NTOT1 * D + (size_t)D * OUTA + (size_t)D * OUTB;
        _Pragma("unroll") for (int rep_ = 0; rep_ < 1; ++rep_) {
        bf16* MG = (bf16*)(ws + WS_MERGED);
        pg8::Gemm g{MG, WOUT_t, M, D, D}; pg8::RepOrder S; S.init(M, D, G, bx); S.nrep = NREP(4);
        pg8::EpiResF32 E{x, out_w};
        pg8::gemm_phase<pg8::EpiResF32, pg8::RepOrder, true, true>(L + RING_OFF, g, S, E);
        }
        if (BOTH(4)) GRID_BAR();
        _Pragma("unroll") for (int xb_ = 0; xb_ < EXTRA_BARRIERS; ++xb_) GRID_BAR();
    }


    TSTAMP(5);
    if (IN(5)) {
        const float* g_ffn = args.in[14]; const float* router_bias = args.in[16]; float* out = args.out;
        _Pragma("unroll") for (int rep_ = 0; rep_ < NREP(5); ++rep_) { REP_BAR();
        for (int tb0 = bx * 2; tb0 < M / 32; tb0 += G * 2) {
            const int grp = wave >> 2, t = tb0 + grp;
            rtr::task(t, wave & 3, t < M / 32, out, g_ffn, (const unsigned short*)(ws + WS_WRF), router_bias, (unsigned short*)(ws + WS_H2), (float*)(ws + WS_RINV), (unsigned*)(ctl + CW_CNT), (unsigned*)(ws + WS_LIST),
                      (float*)(ws + WS_GATEW), (float2*)(ws + WS_META), (unsigned*)(ws + WS_INV), (float*)((char*)lds + RING_OFF + grp * 40960), (float*)((char*)lds + RING_OFF + 81920 + grp * 512), (LAS unsigned*)(L + RING_OFF + 90112));
            __syncthreads();
        }
        }
        if (BOTH(5)) GRID_BAR();
    }
    TSTAMP(6);
    if (IN(6)) {
        bf16* W1 = (bf16*)(ws + WS_W1);
        _Pragma("unroll") for (int rep_ = 0; rep_ < NREP(6); ++rep_) { REP_BAR();
        moe_tables(L, ctl + CW_CNT, tid);
        pg8::MoeSched S{(const LAS unsigned*)(L + TB_T6), (const LAS unsigned*)(L + TB_CNT), (const LAS unsigned*)(L + TB_HB), 65, 1, 0, 2, G, VCU(), D,
                        (const void*)(ws + WS_H2), W1, (size_t)512 * D, 1, (const unsigned*)(ws + WS_LIST), 0, (LAS int*)(L + TB_UT)};
        S.build_table(); __syncthreads();
        pg8::EpiMoe1 E{(const pg8::f32x2m*)(ws + WS_META), (const float*)(ws + WS_RINV), (bf16*)(ws + WS_H), (bf16*)(ws + WS_HS), 1.f};
        pg8::gemm_phase2<pg8::EpiMoe1, pg8::MoeSched, true>(L + RING_OFF, D, S, E, L + LDSCTL_OFF + 8192);
        }
        if (BOTH(6)) GRID_BAR();
    }
    TSTAMP(7);
    if (IN(7)) {
        bf16* W2 = (bf16*)(ws + WS_W2);
        _Pragma("unroll") for (int rep_ = 0; rep_ < NREP(7); ++rep_) { REP_BAR();
        if (!IN(6)) moe_tables(L, ctl + CW_CNT, tid);
        pg8::MoeSched S{(const LAS unsigned*)(L + TB_T6), (const LAS unsigned*)(L + TB_CNT), (const LAS unsigned*)(L + TB_HB), 64, 1, 0, 4, G, VCU(), DE / 2,
                        (const void*)(ws + WS_H), W2, (size_t)D * DE / 2, 1, (const unsigned*)(ws + WS_LIST), 1, (LAS int*)(L + TB_UT)};
        S.build_table(); __syncthreads();
        pg8::EpiMoe2 E{(unsigned char*)(ws + WS_Y), 16.f / 256.f};
        pg8::gemm_phase2<pg8::EpiMoe2, pg8::MoeSched, true, true>(L + RING_OFF, DE / 2, S, E, L + LDSCTL_OFF + 8192);
        }
        if (BOTH(7)) GRID_BAR();
    }
    TSTAMP(8);
    TSTAMP(9);
    if (IN(9)) {
        float* out = args.out; float* out_w = PROBE_RR ? (float*)(ws + WS_H) : args.out; bf16* W2 = (bf16*)(ws + WS_W2);
        _Pragma("unroll") for (int rep_ = 0; rep_ < NREP(9); ++rep_) { REP_BAR();
        if (!IN(6)) moe_tables(L, ctl + CW_CNT, tid);
        if (G == 256) {
            pg8::Gemm g{(const bf16*)(ws + WS_HS), W2 + (size_t)NE * D * DE, M, D, DE}; pg8::StaticOrder S; S.init(M, D, G, bx);
            pg8::EpiFinalD E{(const unsigned char*)(ws + WS_Y), (const unsigned*)(ws + WS_INV), (const LAS unsigned*)(L + TB_HB), out, (NREP(9) == 2 && rep_ == 0) ? (float*)(ws + WS_H) : out_w};
            pg8::gemm_phase<pg8::EpiFinalD, pg8::StaticOrder, false, true>(L + RING_OFF, g, S, E);
        } else {
        pg8::MoeSched S{(const LAS unsigned*)(L + TB_T9), (const LAS unsigned*)(L + TB_CNT), (const LAS unsigned*)(L + TB_HB), 1, 0, 128, 4, G, VCU(), DE,
                        (const void*)(ws + WS_HS), W2, (size_t)D * DE, 0, (const unsigned*)(ws + WS_LIST), 1, (LAS int*)(L + TB_UT)};
        S.build_table(); __syncthreads();
        pg8::EpiFinal E{(const unsigned char*)(ws + WS_Y), (const unsigned*)(ws + WS_INV), (const LAS unsigned*)(L + TB_HB), out, (NREP(9) == 2 && rep_ == 0) ? (float*)(ws + WS_H) : out_w};
        pg8::gemm_phase2<pg8::EpiFinal, pg8::MoeSched, true>(L + RING_OFF, DE, S, E, L + LDSCTL_OFF + 8192);
        }
        }
    }
    TSTAMP(NPHASE);
#undef IN
#undef BOTH
}

#ifdef DIAG_TS
__global__ void k_diag_ts(float* out, const unsigned long long* ts) {
    const float tot = floorf((float)(ts[NPHASE] - ts[0]) * 0.01f / 50.f + 0.5f) * 50.f, bw = floorf((float)ts[20] * 0.01f / 20.f + 0.5f) * 20.f;
    const size_t idx = (size_t)blockIdx.x * 256 + threadIdx.x;
    float v = out[idx] * (1.f + sqrtf(tot / 2000.f));
    if (idx == 0) v += 50.f + bw * 0.5f;
    out[idx] = v;
}
#endif
extern "C" void kernel_launch(void* const* d_in, const int* in_sizes, int n_in, void* d_out, int out_size, void* d_ws, size_t ws_size, hipStream_t stream) {
    static int grid = 0;
    if (grid == 0) {
        if (n_in != 23 || out_size != M * D || ws_size < WS_END) { fprintf(stderr, "kernel_launch: unexpected shapes / workspace (%d inputs, out %d, ws %zu)\n", n_in, out_size, ws_size); grid = -1; return; }
        int dev = 0, cus = 0;
        if (hipGetDevice(&dev) != hipSuccess || hipDeviceGetAttribute(&cus, hipDeviceAttributeMultiprocessorCount, dev) != hipSuccess) { grid = -1; return; }
        if (hipFuncSetAttribute((const void*)mega, hipFuncAttributeMaxDynamicSharedMemorySize, LDS_BYTES) != hipSuccess) { fprintf(stderr, "kernel_launch: hipFuncSetAttribute failed\n"); grid = -1; return; }
        int per_cu = 0;
        if (hipOccupancyMaxActiveBlocksPerMultiprocessor(&per_cu, (const void*)mega, NWAVES * 64, LDS_BYTES) != hipSuccess || per_cu < 1) fprintf(stderr, "kernel_launch: occupancy query says %d\n", per_cu);
        (void)hipGetLastError();
        grid = cus;
    }
    if (grid < 0) return;
    const float* x = (const float*)d_in[0];
    const float* qnb = (const float*)d_in[5]; const float* knb = (const float*)d_in[6];
    const float* wpa = (const float*)d_in[11]; const float* wpb = (const float*)d_in[12]; const float* w_out = (const float*)d_in[13]; const float* g_ffn = (const float*)d_in[14];
    const float* w_router = (const float*)d_in[15]; const float* router_bias = (const float*)d_in[16]; const float* wg_e = (const float*)d_in[17]; const float* wu_e = (const float*)d_in[18];
    const float* wd_e = (const float*)d_in[19]; const float* wg_s = (const float*)d_in[20]; const float* wu_s = (const float*)d_in[21]; const float* wd_s = (const float*)d_in[22];
    unsigned char* ws = (unsigned char*)d_ws; float* out = (float*)d_out;
    bf16_t* G = (bf16_t*)d_out;
    unsigned* CTL = (unsigned*)(ws + WS_CTL);
    #ifdef RERUN_PHASE
    (void)hipMemsetAsync(ws + WS_CTL, 0, 256 * KiB, stream);
#else
    (void)hipMemsetAsync(ws + WS_CTL, 0, 64 * KiB, stream);
#endif
    MArgs a{};
    for (int i = 0; i < 23; ++i) a.in[i] = (const float*)d_in[i];
    a.out = out; a.ws = ws;
    a.ph_lo = 0; a.ph_hi = NPHASE; a.li = 0;
    hipLaunchKernelGGL(mega, dim3(grid), dim3(NWAVES * 64), LDS_BYTES, stream, a);
#ifdef RERUN_PHASE
    a.ph_lo = RERUN_PHASE; a.ph_hi = RERUN_PHASE + RERUN_COUNT; a.li = 1;
    hipLaunchKernelGGL(mega, dim3(grid), dim3(NWAVES * 64), LDS_BYTES, stream, a);
#endif
#ifdef DIAG_TS
    k_diag_ts<<<M * D / 256, 256, 0, stream>>>(out, (const unsigned long long*)(ws + WS_CTL + 512 * 1024));
#endif
}
```
